# Optimizing an MI355X kernel written in HIP

```python
import math
import jax
import jax.numpy as jnp
from jax import lax
import numpy as np

D_MODEL = 1024
BATCH = 2
SEQ = 8192
DEPTH = 4

GRID_W = 64
CTX_LEN = 256
N_MIXERS = 4
NORM_EPS = 1e-6

MB_D_INNER = 2 * D_MODEL
MB_HEAD_DIM = 64
MB_HEADS = MB_D_INNER // MB_HEAD_DIM
MB_GROUPS = 4
MB_HPG = MB_HEADS // MB_GROUPS
MB_STATE = 128
MB_CONV = 5
MB_CHUNK = 128
MB_XBC = MB_D_INNER + 2 * MB_GROUPS * MB_STATE
MB_IN = MB_D_INNER + MB_XBC + 2 * MB_HEADS

RW_HEAD = 64
RW_HEADS = D_MODEL // RW_HEAD
RW_DECAY_LORA = 64
RW_ICLR_LORA = 64
RW_GATE_LORA = 128
RW_DECAY_SCALE = 0.606531
RW_LN_EPS = 64e-5

POOL_WINDOWS = (2, 4, 8, 16)
POOL_GROUP = D_MODEL // len(POOL_WINDOWS)

AT_HEAD = 64
AT_HEADS = D_MODEL // AT_HEAD
AT_KV_HEADS = 4
AT_GROUP = AT_HEADS // AT_KV_HEADS
AT_BLOCK = 128
ROPE_THETA = 10000.0

FF_DENSE = 2816
N_EXPERTS = 8
TOP_K = 2
FF_EXPERT = 3584

kernel_name = 'hybrid_ssd_rwkv7_pool_gqa_moe_dit'


def _rmsnorm(x, g, eps=NORM_EPS):
    xf = x.astype(jnp.float32)
    y = xf * lax.rsqrt(jnp.mean(xf * xf, axis=-1, keepdims=True) + eps)
    return (y * g.astype(jnp.float32)).astype(x.dtype)


def _flip(t):
    return jnp.flip(t, axis=1)


def _dwconv_centred(u, w, b):
    ch = u.shape[-1]
    pad = (w.shape[0] - 1) // 2
    y = lax.conv_general_dilated(u, w[:, None, :].astype(u.dtype), window_strides=(1,),
                                 padding=[(pad, pad)], dimension_numbers=('NWC', 'WIO', 'NWC'),
                                 feature_group_count=ch)
    return y + b


def _ssd_scan(x, dt, a_neg, bm, cm, s0, need_y):
    f32 = jnp.float32
    b, L, G, E, P = x.shape
    N = bm.shape[-1]
    nc = L // MB_CHUNK
    x = x.astype(f32).reshape(b, nc, MB_CHUNK, G, E, P)
    dt = dt.astype(f32).reshape(b, nc, MB_CHUNK, G, E)
    bm = bm.astype(f32).reshape(b, nc, MB_CHUNK, G, N)
    cm = cm.astype(f32).reshape(b, nc, MB_CHUNK, G, N)
    cum = jnp.cumsum(dt * a_neg, axis=2)
    last = cum[:, :, -1]
    xdt = x * (jnp.exp(last[:, :, None] - cum) * dt)[..., None]
    chunk_states = jnp.einsum('bcqgn,bcqgep->bcgepn', bm, xdt)

    def step(s, inp):
        st, dec = inp
        return s * dec[..., None, None] + st, s

    s_fin, s_prev = lax.scan(step, s0.astype(f32),
                             (jnp.moveaxis(chunk_states, 1, 0), jnp.moveaxis(jnp.exp(last), 1, 0)))
    if not need_y:
        return None, s_fin
    s_prev = jnp.moveaxis(s_prev, 0, 1)
    pos = jnp.arange(MB_CHUNK)
    lower = (pos[:, None] >= pos[None, :])[:, :, None, None]
    seg = cum[:, :, :, None] - cum[:, :, None, :]
    decay = jnp.exp(jnp.where(lower, seg, -jnp.inf))
    cb = jnp.einsum('bcign,bcjgn->bcijg', cm, bm)
    w = cb[..., None] * decay * dt[:, :, None]
    y = jnp.einsum('bcijge,bcjgep->bcigep', w, x)
    y = y + jnp.einsum('bcign,bcgepn->bcigep', cm, s_prev) * jnp.exp(cum)[..., None]
    return y.reshape(b, L, G, E, P), s_fin


def _mamba_project(u, in_w, conv_w, conv_b, dt_bias):
    b, L, _ = u.shape
    zxd = u @ in_w
    z = zxd[..., :MB_D_INNER]
    xbc = jax.nn.silu(_dwconv_centred(zxd[..., MB_D_INNER:MB_D_INNER + MB_XBC], conv_w, conv_b))
    dt_raw = zxd[..., MB_D_INNER + MB_XBC:].reshape(b, L, 2, MB_HEADS)
    gn = MB_GROUPS * MB_STATE
    xs = xbc[..., :MB_D_INNER].reshape(b, L, MB_GROUPS, MB_HPG, MB_HEAD_DIM)
    bm = xbc[..., MB_D_INNER:MB_D_INNER + gn].reshape(b, L, MB_GROUPS, MB_STATE)
    cm = xbc[..., MB_D_INNER + gn:].reshape(b, L, MB_GROUPS, MB_STATE)
    dt = jax.nn.softplus(dt_raw.astype(jnp.float32) + dt_bias.astype(jnp.float32))
    return z, xs, bm, cm, dt.reshape(b, L, 2, MB_GROUPS, MB_HPG)


def _mamba_mixer(h, hc, want_ctx, in_w, conv_w, conv_b, dt_bias, a_log, d_skip, norm_g, out_w):
    f32 = jnp.float32
    a_neg = -jnp.exp(a_log.astype(f32)).reshape(2, MB_GROUPS, MB_HPG)
    s0 = jnp.zeros((h.shape[0], MB_GROUPS, MB_HPG, MB_HEAD_DIM, MB_STATE), f32)

    def bidir(u, init_f, init_b, need_y):
        z, xs, bm, cm, dt = _mamba_project(u, in_w, conv_w, conv_b, dt_bias)
        y_f, s_f = _ssd_scan(xs, dt[:, :, 0], a_neg[0], bm, cm, init_f, need_y)
        y_b, s_b = _ssd_scan(_flip(xs), _flip(dt[:, :, 1]), a_neg[1], _flip(bm), _flip(cm), init_b, need_y)
        if not need_y:
            return None, s_f, s_b
        y = y_f + _flip(y_b) + xs.astype(f32) * d_skip.astype(f32).reshape(MB_GROUPS, MB_HPG, 1)
        y = y.reshape(u.shape[0], u.shape[1], MB_D_INNER).astype(u.dtype)
        return _rmsnorm(y * jax.nn.silu(z), norm_g) @ out_w, s_f, s_b

    yc, sc_f, sc_b = bidir(hc, s0, s0, want_ctx)
    y, _, _ = bidir(h, sc_f, sc_b, True)
    return y, yc


def _centred_shift(u):
    prev = jnp.pad(u, ((0, 0), (1, 0), (0, 0)))[:, :-1]
    nxt = jnp.pad(u, ((0, 0), (0, 1), (0, 0)))[:, 1:]
    return 0.5 * (prev + nxt) - u


def _heads(t):
    return t.reshape(t.shape[0], t.shape[1], RW_HEADS, RW_HEAD)


def _rwkv_features(u, mix, rkv_w, w0, w1, w2, a0, a1, a2, g1, g2, k_k, k_a):
    f32 = jnp.float32
    xx = _centred_shift(u)
    xr, xw, xk, xv, xa, xg = [u + xx * mix[j] for j in range(6)]
    r = xr @ rkv_w[0]
    k = xk @ rkv_w[1]
    v = xv @ rkv_w[2]
    g = jax.nn.sigmoid(xg @ g1) @ g2
    kk = _heads((k * k_k).astype(f32))
    kk = kk / jnp.maximum(jnp.sqrt(jnp.sum(kk * kk, axis=-1, keepdims=True)), 1e-12)
    logw, iclr, kd = [], [], []
    for d in range(2):
        logw.append(_heads(-RW_DECAY_SCALE * jax.nn.sigmoid((w0[d] + jnp.tanh(xw @ w1[d]) @ w2[d]).astype(f32))))
        a = jax.nn.sigmoid((a0[d] + (xa @ a1[d]) @ a2[d]).astype(f32))
        iclr.append(_heads(a))
        kd.append(_heads(k.astype(f32) * (1.0 + (a - 1.0) * k_a.astype(f32))))
    return _heads(r.astype(f32)), _heads(v.astype(f32)), g, kk, logw, iclr, kd


def _rwkv_scan(r, logw, k, v, kk, a, s0, need_y):
    f32 = jnp.float32
    tm = lambda t: jnp.moveaxis(t.astype(f32), 1, 0)
    seq = (tm(r), tm(jnp.exp(logw)), tm(k), tm(v), tm(kk), tm(kk * a))

    def step(S, inp):
        r_t, w_t, k_t, v_t, kk_t, b_t = inp
        sa = jnp.einsum('bhvk,bhk->bhv', S, kk_t)
        S = S * w_t[:, :, None, :] - sa[..., None] * b_t[:, :, None, :] + v_t[..., None] * k_t[:, :, None, :]
        return S, (jnp.einsum('bhvk,bhk->bhv', S, r_t) if need_y else None)

    s_fin, ys = lax.scan(step, s0, seq)
    return (jnp.moveaxis(ys, 0, 1) if need_y else None), s_fin


def _rwkv_mixer(h, hc, want_ctx, mix, rkv_w, w0, w1, w2, a0, a1, a2, g1, g2, k_k, k_a,
                r_k, ln_g, ln_b, out_w):
    f32 = jnp.float32
    s0 = jnp.zeros((h.shape[0], RW_HEADS, RW_HEAD, RW_HEAD), f32)

    def bidir(u, inits, need_y):
        r, v, g, kk, logw, iclr, kd = _rwkv_features(u, mix, rkv_w, w0, w1, w2, a0, a1, a2, g1, g2, k_k, k_a)
        ys, states = [], []
        for d in range(2):
            f = (lambda t: t) if d == 0 else _flip
            y_d, s_d = _rwkv_scan(f(r), f(logw[d]), f(kd[d]), f(v), f(kk), f(iclr[d]), inits[d], need_y)
            ys.append(f(y_d) if need_y else None)
            states.append(s_d)
        if not need_y:
            return None, states
        y = ys[0] + ys[1]
        mu = jnp.mean(y, axis=-1, keepdims=True)
        var = jnp.mean(jnp.square(y - mu), axis=-1, keepdims=True)
        yn = (y - mu) * lax.rsqrt(var + RW_LN_EPS) * ln_g.astype(f32).reshape(RW_HEADS, RW_HEAD) \
            + ln_b.astype(f32).reshape(RW_HEADS, RW_HEAD)
        bonus = jnp.sum(r * r_k.astype(f32) * (0.5 * (kd[0] + kd[1])), axis=-1, keepdims=True) * v
        o = (yn + bonus).reshape(u.shape).astype(u.dtype) * g
        return o @ out_w, states

    yc, sc = bidir(hc, [s0, s0], want_ctx)
    y, _ = bidir(h, sc, True)
    return y, yc


def _pool_mixer(u, w, scale):
    b, L, _ = u.shape
    cs = jnp.cumsum(u.astype(jnp.float32), axis=1)
    cs = jnp.concatenate([jnp.zeros_like(cs[:, :1]), cs], axis=1)
    t = jnp.arange(L)
    means = []
    for gi, win in enumerate(POOL_WINDOWS):
        lo = jnp.clip(t - win // 2, 0, L)
        hi = jnp.clip(t + win // 2, 0, L)
        csg = cs[:, :, gi * POOL_GROUP:(gi + 1) * POOL_GROUP]
        cnt = (hi - lo).astype(jnp.float32)[None, :, None]
        means.append((csg[:, hi] - csg[:, lo]) / cnt)
    pooled = jnp.concatenate(means, axis=-1).astype(u.dtype) - u
    y = jnp.einsum('blgc,gcd->blgd', pooled.reshape(b, L, len(POOL_WINDOWS), POOL_GROUP), w)
    return y.reshape(b, L, -1) * scale


def _axial_rope(x, rows, cols):
    f32 = jnp.float32
    half = x.shape[-1] // 2
    quarter = half // 2
    inv = ROPE_THETA ** (-jnp.arange(quarter, dtype=f32) / quarter)

    def rot(xp, pos):
        ang = pos.astype(f32)[:, None] * inv
        cos = jnp.cos(ang)[None, :, None, :].astype(x.dtype)
        sin = jnp.sin(ang)[None, :, None, :].astype(x.dtype)
        x1, x2 = xp[..., :quarter], xp[..., quarter:]
        return jnp.concatenate([x1 * cos - x2 * sin, x2 * cos + x1 * sin], axis=-1)

    return jnp.concatenate([rot(x[..., :half], rows), rot(x[..., half:], cols)], axis=-1)


def _gqa_attend(q, k, v):
    s = jnp.einsum('bqkgd,bskd->bkgqs', q, k).astype(jnp.float32)
    p = jax.nn.softmax(s, axis=-1).astype(v.dtype)
    return jnp.einsum('bkgqs,bskd->bqkgd', p, v)


def _attn_mixer(h, hc, want_ctx, rows, cols, qkv_w, q_g, k_g, out_w):
    nq = AT_HEADS * AT_HEAD
    nk = AT_KV_HEADS * AT_HEAD
    scale = AT_HEAD ** -0.5

    def proj(u):
        b, L, _ = u.shape
        qkv = u @ qkv_w
        q = _rmsnorm(qkv[..., :nq].reshape(b, L, AT_HEADS, AT_HEAD), q_g)
        k = _rmsnorm(qkv[..., nq:nq + nk].reshape(b, L, AT_KV_HEADS, AT_HEAD), k_g)
        v = qkv[..., nq + nk:].reshape(b, L, AT_KV_HEADS, AT_HEAD)
        return q, k, v

    qc, kc, vc = proj(hc)
    q, k, v = proj(h)
    q = _axial_rope(q, rows, cols) * scale
    k = _axial_rope(k, rows, cols)
    k_all = jnp.concatenate([kc, k], axis=1)
    v_all = jnp.concatenate([vc, v], axis=1)
    b, L = h.shape[:2]
    nblk = L // AT_BLOCK
    qb = jnp.moveaxis(q.reshape(b, nblk, AT_BLOCK, AT_KV_HEADS, AT_GROUP, AT_HEAD), 1, 0)
    o = lax.map(lambda blk: _gqa_attend(blk, k_all, v_all), qb)
    y = jnp.moveaxis(o, 0, 1).reshape(b, L, nq) @ out_w
    yc = None
    if want_ctx:
        bc, lc = hc.shape[:2]
        oc = _gqa_attend(qc.reshape(bc, lc, AT_KV_HEADS, AT_GROUP, AT_HEAD) * scale, kc, vc)
        yc = oc.reshape(bc, lc, nq) @ out_w
    return y, yc


def _swiglu(u, w_in, w_out):
    gu = u @ w_in
    f = w_out.shape[0]
    return (jax.nn.silu(gu[..., :f]) * gu[..., f:]) @ w_out


def _moe(u, router_w, w_in, w_out):
    logits = (u @ router_w).astype(jnp.float32)
    top_v, top_i = lax.top_k(logits, TOP_K)
    wts = jax.nn.softmax(top_v, axis=-1)
    gates = jnp.einsum('btk,btke->bte', wts, jax.nn.one_hot(top_i, N_EXPERTS, dtype=jnp.float32)).astype(u.dtype)
    out = jnp.zeros_like(u)
    for e in range(N_EXPERTS):
        out = out + gates[..., e:e + 1] * _swiglu(u, w_in[e], w_out[e])
    return out


def setup_inputs(seed: int = 0) -> dict:
    key = jax.random.key(seed)
    keys = iter(jax.random.split(key, 64))
    f32 = jnp.float32
    D = D_MODEL

    def nrm(shape, s):
        return jax.random.normal(next(keys), shape, f32) * s

    def gain(shape):
        return 1.0 + nrm(shape, 0.05)

    na, nb, npool, nattn = [len(range(k, DEPTH, N_MIXERS)) for k in range(N_MIXERS)]
    n_dense = len(range(0, DEPTH, 2))
    n_moe = len(range(1, DEPTH, 2))
    dt0 = jnp.exp(jax.random.uniform(next(keys), (na, 2, MB_HEADS), f32, math.log(1e-3), math.log(1e-1)))
    return {
        'x': nrm((BATCH, SEQ, D), 1.0),
        'c': nrm((BATCH, D), 1.0),
        'ctx': nrm((BATCH, CTX_LEN, D), 1.0),
        'c_ctx': nrm((D,), 1.0),
        'mod_w': nrm((DEPTH, D, 6 * D), 0.5 * D ** -0.5),
        'mod_b': nrm((DEPTH, 6 * D), 0.02),
        'norm1_g': gain((DEPTH, D)),
        'norm2_g': gain((DEPTH, D)),
        'final_g': gain((D,)),
        'mb_in_w': nrm((na, D, MB_IN), D ** -0.5),
        'mb_conv_w': nrm((na, MB_CONV, MB_XBC), MB_CONV ** -0.5),
        'mb_conv_b': nrm((na, MB_XBC), 0.02),
        'mb_dt_bias': dt0 + jnp.log(-jnp.expm1(-dt0)),
        'mb_a_log': jnp.log(jax.random.uniform(next(keys), (na, 2, MB_HEADS), f32, 1.0, 16.0)),
        'mb_d': gain((na, MB_HEADS)),
        'mb_norm_g': gain((na, MB_D_INNER)),
        'mb_out_w': nrm((na, MB_D_INNER, D), MB_D_INNER ** -0.5),
        'rw_mix': jax.random.uniform(next(keys), (nb, 6, D), f32),
        'rw_rkv_w': nrm((nb, 3, D, D), D ** -0.5),
        'rw_w0': nrm((nb, 2, D), 1.0),
        'rw_w1': nrm((nb, 2, D, RW_DECAY_LORA), D ** -0.5),
        'rw_w2': nrm((nb, 2, RW_DECAY_LORA, D), 0.5 * RW_DECAY_LORA ** -0.5),
        'rw_a0': nrm((nb, 2, D), 0.5),
        'rw_a1': nrm((nb, 2, D, RW_ICLR_LORA), D ** -0.5),
        'rw_a2': nrm((nb, 2, RW_ICLR_LORA, D), 0.5 * RW_ICLR_LORA ** -0.5),
        'rw_g1': nrm((nb, D, RW_GATE_LORA), D ** -0.5),
        'rw_g2': nrm((nb, RW_GATE_LORA, D), RW_GATE_LORA ** -0.5),
        'rw_k_k': 0.85 + nrm((nb, D), 0.05),
        'rw_k_a': gain((nb, D)),
        'rw_r_k': nrm((nb, RW_HEADS, RW_HEAD), 0.1),
        'rw_ln_g': gain((nb, D)),
        'rw_ln_b': nrm((nb, D), 0.02),
        'rw_out_w': nrm((nb, D, D), D ** -0.5),
        'pl_w': nrm((npool, len(POOL_WINDOWS), POOL_GROUP, POOL_GROUP), POOL_GROUP ** -0.5),
        'pl_scale': gain((npool, D)),
        'at_qkv_w': nrm((nattn, D, (AT_HEADS + 2 * AT_KV_HEADS) * AT_HEAD), D ** -0.5),
        'at_q_g': gain((nattn, AT_HEAD)),
        'at_k_g': gain((nattn, AT_HEAD)),
        'at_out_w': nrm((nattn, AT_HEADS * AT_HEAD, D), (AT_HEADS * AT_HEAD) ** -0.5),
        'ff_in_w': nrm((n_dense, D, 2 * FF_DENSE), D ** -0.5),
        'ff_out_w': nrm((n_dense, FF_DENSE, D), FF_DENSE ** -0.5),
        'moe_router_w': nrm((n_moe, D, N_EXPERTS), D ** -0.5),
        'moe_in_w': nrm((n_moe, N_EXPERTS, D, 2 * FF_EXPERT), D ** -0.5),
        'moe_out_w': nrm((n_moe, N_EXPERTS, FF_EXPERT, D), FF_EXPERT ** -0.5),
    }


def reference(x, c, ctx, c_ctx, mod_w, mod_b, norm1_g, norm2_g, final_g,
              mb_in_w, mb_conv_w, mb_conv_b, mb_dt_bias, mb_a_log, mb_d, mb_norm_g, mb_out_w,
              rw_mix, rw_rkv_w, rw_w0, rw_w1, rw_w2, rw_a0, rw_a1, rw_a2, rw_g1, rw_g2,
              rw_k_k, rw_k_a, rw_r_k, rw_ln_g, rw_ln_b, rw_out_w,
              pl_w, pl_scale, at_qkv_w, at_q_g, at_k_g, at_out_w,
              ff_in_w, ff_out_w, moe_router_w, moe_in_w, moe_out_w):
    b, L, _ = x.shape
    n_rows = L // GRID_W
    rows = jnp.repeat(jnp.arange(n_rows, dtype=jnp.int32), GRID_W)
    cols = jnp.arange(L, dtype=jnp.int32) % GRID_W
    n_ctx = ctx.shape[1]
    s_lat = jax.nn.silu(c)[:, None, :]
    s_ctx = jax.nn.silu(c_ctx)
    xc = ctx
    for i in range(DEPTH):
        last = i == DEPTH - 1
        kind = i % N_MIXERS
        j = i // N_MIXERS
        m = jnp.split(s_lat @ mod_w[i] + mod_b[i], 6, axis=-1)
        h = _rmsnorm(x, norm1_g[i]) * (1 + m[1]) + m[0]
        need_hc = (not last) or kind != 2
        mc, hc = None, None
        if need_hc:
            mc = jnp.split(s_ctx @ mod_w[i] + mod_b[i], 6, axis=-1)
            hc = _rmsnorm(xc, norm1_g[i]) * (1 + mc[1]) + mc[0]
        if kind == 0:
            y, yc = _mamba_mixer(h, hc, not last, mb_in_w[j], mb_conv_w[j], mb_conv_b[j], mb_dt_bias[j],
                                 mb_a_log[j], mb_d[j], mb_norm_g[j], mb_out_w[j])
        elif kind == 1:
            y, yc = _rwkv_mixer(h, hc, not last, rw_mix[j], rw_rkv_w[j], rw_w0[j], rw_w1[j], rw_w2[j],
                                rw_a0[j], rw_a1[j], rw_a2[j], rw_g1[j], rw_g2[j], rw_k_k[j], rw_k_a[j],
                                rw_r_k[j], rw_ln_g[j], rw_ln_b[j], rw_out_w[j])
        elif kind == 2:
            y = _pool_mixer(h, pl_w[j], pl_scale[j])
            yc = None if last else _pool_mixer(hc, pl_w[j], pl_scale[j])
        else:
            y, yc = _attn_mixer(h, hc, not last, rows, cols, at_qkv_w[j], at_q_g[j], at_k_g[j], at_out_w[j])
        x = x + m[2] * y
        h2 = _rmsnorm(x, norm2_g[i]) * (1 + m[4]) + m[3]
        if not last:
            xc = xc + mc[2] * yc
            h2c = _rmsnorm(xc, norm2_g[i]) * (1 + mc[4]) + mc[3]
            hcat = jnp.concatenate([h2c, h2], axis=1)
        else:
            hcat = h2
        if i % 2 == 0:
            f = _swiglu(hcat, ff_in_w[i // 2], ff_out_w[i // 2])
        else:
            f = _moe(hcat, moe_router_w[i // 2], moe_in_w[i // 2], moe_out_w[i // 2])
        if last:
            x = x + m[5] * f
        else:
            xc = xc + mc[5] * f[:, :n_ctx]
            x = x + m[5] * f[:, n_ctx:]
    return _rmsnorm(x, final_g)
```

```cpp
#include <hip/hip_runtime.h>
#include <hip/hip_bf16.h>
#include <cstdio>
#include <cstdint>
#include <cmath>

#define LAS __attribute__((address_space(3)))
#define GAS __attribute__((address_space(1)))
typedef unsigned short bf16_t;
typedef short bf16x8 __attribute__((ext_vector_type(8)));
typedef short s16x4 __attribute__((ext_vector_type(4)));
typedef float f32x4 __attribute__((ext_vector_type(4)));
typedef float f32x2 __attribute__((ext_vector_type(2)));
typedef unsigned u32x4 __attribute__((ext_vector_type(4)));
typedef unsigned u32x2 __attribute__((ext_vector_type(2)));

constexpr int DM = 1024, NB = 2, TL = 8192, TC = 256;
constexpr int RC = NB * TC, RL = NB * TL, RT = RC + RL;
constexpr float NORM_EPS = 1e-6f;
constexpr int MB_DI = 2048, MB_XBC = 3072, MB_NIN = 5184, MB_NPAD = 5376, MB_CH = 128, MB_NSC = RT / MB_CH;
constexpr int FFD = 2816, FFE = 3584, NEXP = 8;
constexpr int MOE_MAXT = 140;
constexpr int KVL = TC + TL;

constexpr size_t MiB = (size_t)1 << 20;
constexpr size_t WS_CTL = 0, CTL_ZERO_BYTES = 1 * MiB;
constexpr size_t WS_MOD = 4 * MiB;
constexpr size_t WS_ROPE = 4 * MiB + 512 * 1024;
constexpr size_t WS_SEL = 5 * MiB;
constexpr size_t WS_WTS = WS_SEL + 128 * 1024;
constexpr size_t WS_POS = WS_WTS + 256 * 1024;
constexpr size_t WS_CNT = WS_POS + 256 * 1024;
constexpr size_t W_MBIN = 8 * MiB, W_MBOUT = 19 * MiB, W_RWBIG = 23 * MiB  , W_RWL2 = 37 * MiB  , W_RWOUT = 40 * MiB, W_POOL = 42 * MiB, W_QKV = 43 * MiB, W_ATOUT = 46 * MiB;
constexpr size_t W_FFIN = 48 * MiB, W_FFOUT = 70 * MiB, W_MOEIN = 82 * MiB, W_MOEOUT = 306 * MiB;
constexpr size_t WS_XW = 420 * MiB, WS_H = 486 * MiB, WS_SCR = 552 * MiB, WS_END = 1640 * MiB;
constexpr size_t S_Z = 0, S_XBCP = 66 * MiB, S_XBC = 165 * MiB, S_DT = 264 * MiB, S_ST = 270 * MiB, S_DTOT = 402 * MiB, S_YG = 403 * MiB, S_SSQ = 469 * MiB, S_SSQC = 470 * MiB;
constexpr size_t S_HID = 0;
constexpr size_t S_RKV = 0, S_X6 = 100 * MiB, S_L1 = 300 * MiB, S_WD = 320 * MiB, S_AD = 452 * MiB  , S_BON2 = 456 * MiB, S_GG = 520 * MiB, S_YY = 555 * MiB, S_OO = 100 * MiB;
constexpr size_t S_AG = 0, S_HM = 70 * MiB, S_YS = 315 * MiB, S_PARTM = 385 * MiB;
constexpr int PARTM_ROWS = (MOE_MAXT - 128) * 256;
constexpr size_t S_WY = 704 * MiB;
constexpr size_t S_PARTC = 1036 * MiB;
constexpr size_t S_QKV = 0, S_QB = 50 * MiB, S_KB = 82 * MiB, S_VB = 91 * MiB, S_AO = 100 * MiB;
constexpr int CW_BAR = 4096;

constexpr int RING_BYTES = 143360;
constexpr int LDSCTL_OFF = RING_BYTES, MISC_OFF = LDSCTL_OFF + 320;
constexpr int LDS_BYTES = 147456;
constexpr int NWAVES = 8;

#define RLX_AGENT __ATOMIC_RELAXED, __HIP_MEMORY_SCOPE_AGENT
#define LDS_WAIT() asm volatile("s_waitcnt lgkmcnt(0)" ::: "memory")
typedef __bf16 bf16x2_hw __attribute__((ext_vector_type(2)));
__device__ __forceinline__ unsigned pk2(float lo, float hi) { const f32x2 v = {lo, hi}; const bf16x2_hw b = __builtin_convertvector(v, bf16x2_hw); return __builtin_bit_cast(unsigned, b); }
__device__ __forceinline__ unsigned f2bf(float f) { return pk2(f, f) & 0xffffu; }
__device__ __forceinline__ float bf2f(unsigned short b) { return __builtin_bit_cast(float, (unsigned)b << 16); }
__device__ __forceinline__ float bflo(unsigned w) { return __builtin_bit_cast(float, w << 16); }
__device__ __forceinline__ float bfhi(unsigned w) { return __builtin_bit_cast(float, w & 0xffff0000u); }
__device__ __forceinline__ float wave_sum(float v) {
#define WS_DPP(x, ctrl) __builtin_bit_cast(float, __builtin_amdgcn_update_dpp(0, __builtin_bit_cast(int, x), ctrl, 0xf, 0xf, false))
    v += WS_DPP(v, 0xB1); v += WS_DPP(v, 0x4E); v += WS_DPP(v, 0x141); v += WS_DPP(v, 0x140);
#undef WS_DPP
    const float a = __builtin_bit_cast(float, __builtin_amdgcn_readlane(__builtin_bit_cast(int, v), 0)), b = __builtin_bit_cast(float, __builtin_amdgcn_readlane(__builtin_bit_cast(int, v), 16)),
                c = __builtin_bit_cast(float, __builtin_amdgcn_readlane(__builtin_bit_cast(int, v), 32)), d = __builtin_bit_cast(float, __builtin_amdgcn_readlane(__builtin_bit_cast(int, v), 48));
    return (a + b) + (c + d);
}
__device__ __forceinline__ float sigmoidf_(float x) { return __builtin_amdgcn_rcpf(1.f + __expf(-x)); }
__device__ __forceinline__ float siluf_(float x) { return x * __builtin_amdgcn_rcpf(1.f + __expf(-x)); }
__device__ __forceinline__ void unpack8(const u32x4 w, float* v) {
    v[0] = bflo(w.x); v[1] = bfhi(w.x); v[2] = bflo(w.y); v[3] = bfhi(w.y); v[4] = bflo(w.z); v[5] = bfhi(w.z); v[6] = bflo(w.w); v[7] = bfhi(w.w);
}
__device__ __forceinline__ u32x4 pack8(const float* v) { u32x4 w; w.x = pk2(v[0], v[1]); w.y = pk2(v[2], v[3]); w.z = pk2(v[4], v[5]); w.w = pk2(v[6], v[7]); return w; }
__device__ __forceinline__ f32x4 ld_x4(const bf16_t* p) { const u32x2 w = *(const u32x2*)p; return (f32x4){bflo(w.x), bfhi(w.x), bflo(w.y), bfhi(w.y)}; }
__device__ __forceinline__ void st_x4(bf16_t* p, const f32x4 v) { u32x2 w; w.x = pk2(v[0], v[1]); w.y = pk2(v[2], v[3]); *(u32x2*)p = w; }
__device__ __forceinline__ int row_sample(int row) { return row < RC ? 0 : 1 + ((row - RC) >> 13); }

#define XB_TMO      128
#define XB_XCNT(j)  (256  + 64 * (j))
#define XB_XSUB(j)  (1280 + 64 * (j))
#define XB_XGEN(j)  (2304 + 64 * (j))
#define XB_TOP      3328
#define XB_TOPGEN   3392
#define XCD_BAR_WORDS 3456
#define XB_SPIN_CAP (1u << 22)
__device__ __forceinline__ unsigned xb_ld(unsigned* p)              { return __hip_atomic_load(p, __ATOMIC_RELAXED, __HIP_MEMORY_SCOPE_AGENT); }
__device__ __forceinline__ unsigned xb_add(unsigned* p, unsigned v) { return __hip_atomic_fetch_add(p, v, __ATOMIC_RELAXED, __HIP_MEMORY_SCOPE_AGENT); }
__device__ __forceinline__ unsigned xb_xcc_id() { return (unsigned)__builtin_amdgcn_s_getreg((3 << 11) | 20) & 0xFu; }
#define XB_SPIN(cond, bar) do { unsigned _sp = 0; while (cond) { __builtin_amdgcn_s_sleep(1); \
    if ((++_sp & 255u) == 0u) { if (xb_ld(&(bar)[XB_TMO])) break; if (_sp > XB_SPIN_CAP) { atomicAdd(&(bar)[XB_TMO], 1u); break; } } } } while (0)
struct XcdBarrier { unsigned* bar; unsigned x; volatile LAS unsigned* st; };
__device__ __forceinline__ XcdBarrier xcd_barrier_post(unsigned* bar, volatile LAS unsigned* st) {
    XcdBarrier b; b.bar = bar; b.x = xb_xcc_id(); b.st = st;
    if (threadIdx.x == 0) (void)xb_add(&bar[XB_XCNT(b.x)], 1u);
    return b;
}
__device__ __forceinline__ void xcd_barrier_complete(unsigned* bar, unsigned x, unsigned& nloc, unsigned& nx) {
    const unsigned G = gridDim.x * gridDim.y * gridDim.z;
    unsigned sum, cnt, mine, sp = 0u;
    for (;;) {
        sum = 0u; cnt = 0u; mine = 0u;
#pragma unroll
        for (unsigned j = 0; j < 16; ++j) { const unsigned c = xb_ld(&bar[XB_XCNT(j)]); sum += c; cnt += (c > 0u) ? 1u : 0u; mine = (j == x) ? c : mine; }
        if (sum == G) break;
        __builtin_amdgcn_s_sleep(1);
        if ((++sp & 255u) == 0u) { if (xb_ld(&bar[XB_TMO])) break; if (sp > XB_SPIN_CAP) { atomicAdd(&bar[XB_TMO], 1u); break; } }
    }
    nloc = mine > 0u ? mine : 1u; nx = cnt > 0u ? cnt : 1u;
}
__device__ __forceinline__ void xcd_barrier(const XcdBarrier& b) {
    asm volatile("s_waitcnt vmcnt(0)" ::: "memory");
    __syncthreads();
    if (threadIdx.x == 0) {
        unsigned* bar = b.bar;
        __builtin_amdgcn_s_waitcnt(0);
        unsigned nloc = b.st[0], nx = b.st[1];
        if (nloc == 0u) { xcd_barrier_complete(bar, b.x, nloc, nx); b.st[0] = nloc; b.st[1] = nx; }
        const unsigned old = xb_add(&bar[XB_XSUB(b.x)], 1u);
        const unsigned gen = old / nloc;
        if (old + 1u == (gen + 1u) * nloc) {
            __builtin_amdgcn_fence(__ATOMIC_RELEASE, "agent");
            asm volatile("s_waitcnt vmcnt(0)" ::: "memory");
            const unsigned og = xb_add(&bar[XB_TOP], 1u);
            const unsigned tg = og / nx;
            if (og + 1u == (tg + 1u) * nx) xb_add(&bar[XB_TOPGEN], 1u);
            else XB_SPIN(xb_ld(&bar[XB_TOPGEN]) == tg, bar);
            __builtin_amdgcn_fence(__ATOMIC_ACQUIRE, "agent");
            xb_add(&bar[XB_XGEN(b.x)], 1u);
            asm volatile("s_waitcnt vmcnt(0)" ::: "memory");
        } else {
            XB_SPIN(xb_ld(&bar[XB_XGEN(b.x)]) == gen, bar);
            __builtin_amdgcn_fence(__ATOMIC_ACQUIRE, "agent");
            asm volatile("s_waitcnt vmcnt(0)" ::: "memory");
        }
    }
    __syncthreads();
}

namespace pg8 {
constexpr int BM = 256, BK = 64, HALF = 128, HTB = HALF * BK * 2, STAGE_BYTES = 8 * HTB, NXCD = 8, WGM = 8;
__host__ __device__ __forceinline__ int lds_byte(int r, int c) { const int st = (r >> 4) * 2 + (c >> 5), rr = r & 15, cc = c & 31, ob = rr * 64 + cc * 2; return st * 1024 + (ob ^ (((ob >> 9) & 1) << 5)); }
__host__ __device__ __forceinline__ void stage_rc(int b, int& R, int& C) { const int st = b / 1024, sb = b % 1024, swz = sb ^ (((sb >> 9) & 1) << 5); R = (st >> 1) * 16 + swz / 64; C = (st & 1) * 32 + (swz % 64) / 2; }
__host__ __device__ __forceinline__ int perm32(int rho) { const int n = rho >> 4, i = rho & 15; return 8 * (i >> 2) + 4 * n + (i & 3); }

struct Unit { int pm, pn; size_t aoff, boff; int nt, ks; };
__device__ __forceinline__ void tile_of(int wgid, int nM, int nN, int& pm, int& pn) {
    const int nwg = nM * nN;
    { const int q = nwg / NXCD, r = nwg % NXCD, xcd = wgid % NXCD, off = wgid / NXCD; wgid = (xcd < r ? xcd * (q + 1) : r * (q + 1) + (xcd - r) * q) + off; }
    const int nig = WGM * nN, gid = wgid / nig, fm = gid * WGM, gsz = (nM - fm) < WGM ? (nM - fm) : WGM;
    pm = fm + ((wgid % nig) % gsz); pn = (wgid % nig) / gsz;
}
struct SchedStd {
    int nM, nN, G, c; size_t a_tile, b_tile, a_add; int a_div; int nt;
    __device__ __forceinline__ bool next(int i, Unit& u) const {
        const long L = (long)i * G + c; if (L >= (long)nM * nN) return false;
        tile_of((int)L, nM, nN, u.pm, u.pn); u.nt = nt; u.ks = -1;
        u.aoff = (size_t)u.pm * a_tile + (size_t)(u.pn / a_div) * a_add; u.boff = (size_t)u.pn * b_tile; return true;
    }
};
struct SchedMoe {
    int nM, nN, G, c; size_t a_tile, b_tile, b_exp; int ts[NEXP]; int nt; int tail; size_t a_kpair;
    __device__ __forceinline__ bool next(int i, Unit& u) const {
        const int L = i * G + c; size_t koff = 0, koffA = 0; u.nt = nt; u.ks = -1;
        if (!tail) { if (L >= nM * nN) return false; tile_of(L, nM, nN, u.pm, u.pn); }
        else {
            const int nFull = nM < 128 ? nM : 128, fullU = nFull * nN;
            if (L < fullU) tile_of(L, nFull, nN, u.pm, u.pn);
            else { const int tailU = (nM - nFull) * nN; if (tailU <= 0) return false; int S = 256 / tailU; S = S > 7 ? 7 : (S < 1 ? 1 : S);
                const int q = L - fullU; if (q >= tailU * S) return false;
                const int ks = q / tailU, tu = q % tailU, np = nt / 2, p0 = ks * np / S, p1 = (ks + 1) * np / S;
                u.pm = nFull + tu / nN; u.pn = tu % nN; u.ks = ks; u.nt = 2 * (p1 - p0); koff = (size_t)p0 * 256; koffA = (size_t)p0 * a_kpair; }
        }
        int e = 0;
#pragma unroll
        for (int j = 0; j < NEXP - 1; ++j) e += (u.pm >= ts[j]) ? 1 : 0;
        u.aoff = (size_t)u.pm * a_tile + koffA; u.boff = (size_t)e * b_exp + (size_t)u.pn * b_tile + koff; return true;
    }
};
struct SchedRw {
    int G, c;
    __device__ __forceinline__ bool next(int i, Unit& u) const {
        const int L = i * G + c; if (L >= (RT / 256) * 15) return false;
        tile_of(L, RT / 256, 15, u.pm, u.pn); u.nt = DM / 64; u.ks = -1;
        const int g4 = u.pn >> 2, ai = u.pn < 12 ? (g4 == 0 ? 0 : g4 + 1) : (u.pn == 12 ? 1 : u.pn - 9);
        u.aoff = (size_t)ai * RT * DM * 2 + (size_t)u.pm * 256 * DM * 2; u.boff = (size_t)u.pn * 256 * DM * 2; return true;
    }
};
struct SchedCtx {
    int G, c; size_t a_tile, b_tile; int nt; size_t a_ks;
    __device__ __forceinline__ bool next(int i, Unit& u) const {
        const int L = i * G + c;
        if (L < 256) { tile_of(L, 64, 4, u.pm, u.pn); u.pm += 2; u.nt = nt; u.ks = -1; u.aoff = (size_t)u.pm * a_tile; u.boff = (size_t)u.pn * b_tile; return true; }
        const int q = L - 256, S = nt / 4; if (q >= 8 * S) return false;
        const int ks = q >> 3, r = q & 7; u.pm = r >> 2; u.pn = r & 3; u.nt = 4; u.ks = ks;
        u.aoff = (size_t)u.pm * a_tile + (size_t)ks * a_ks; u.boff = (size_t)u.pn * b_tile + (size_t)ks * 512; return true;
    }
};

__device__ __forceinline__ unsigned cvt_pk_bf16(float lo, float hi) { unsigned r; asm volatile("v_cvt_pk_bf16_f32 %0, %1, %2" : "=v"(r) : "v"(lo), "v"(hi)); return r; }

template <class Epi, class Sched, bool ALIGN_EPI>
__device__ __forceinline__ void gemm_phase(LAS unsigned char* lds, const bf16_t* Abase, const bf16_t* Bbase, int lda  , int ldb, const Sched& S, const Epi& E) {
    const int tid = threadIdx.x, wid = __builtin_amdgcn_readfirstlane(tid >> 6), lane = tid & 63, wr = wid >> 2, wc = wid & 3, fr = lane & 15, fq = lane >> 4;
    unsigned voffA[2], voffB[2];
    const int lda_e = lda <= 0 ? BK : lda;
#pragma unroll
    for (int i = 0; i < 2; ++i) { int R, C; stage_rc(tid * 16 + i * 8192, R, C); const int Rb = (R & ~31) + perm32(R & 31);
        voffA[i] = (unsigned)(R * lda_e + C) * 2u; voffB[i] = (unsigned)(Rb * ldb + C) * 2u; }
    const bool a_blk = lda <= 0; if (a_blk) lda = BK;
    const size_t kstepA = a_blk ? (size_t)BM * BK * 2 : (size_t)(BK * 2), kstep = (size_t)(BK * 2);
    const size_t hstepA = (size_t)HALF * lda * 2, hstepB = (size_t)HALF * ldb * 2;
    const unsigned ldsw = (unsigned)wid * 1024u;
    const int aoff = lds_byte(wr * 64 + fr, fq * 8), boff = lds_byte(wc * 32 + fr, fq * 8);
#define PG8_SA(b, h) (((b) * 2 + (h)) * HTB)
#define PG8_SB(b, h) ((4 + (b) * 2 + (h)) * HTB)
#define PG8_STAGE(bufoff, gbase, voff) do { _Pragma("unroll") for (int _i = 0; _i < 2; ++_i) \
        __builtin_amdgcn_global_load_lds((const unsigned*)((const char*)(gbase) + (voff)[_i]), (LAS unsigned*)(lds + (bufoff) + ldsw + _i * 8192), 16, 0, 0); } while (0)
#define PG8_LDA(dst, b, h) do { _Pragma("unroll") for (int m = 0; m < 4; ++m) _Pragma("unroll") for (int k = 0; k < 2; ++k) dst[m][k] = *(const LAS bf16x8*)(lds + PG8_SA(b, h) + aoff + m * 2048 + k * 1024); } while (0)
#define PG8_LDB(dst, b, h) do { _Pragma("unroll") for (int n = 0; n < 2; ++n) _Pragma("unroll") for (int k = 0; k < 2; ++k) dst[n][k] = *(const LAS bf16x8*)(lds + PG8_SB(b, h) + boff + n * 2048 + k * 1024); } while (0)
#define PG8_MMA(ai, bj, At, Bt) do { __builtin_amdgcn_s_setprio(1); _Pragma("unroll") for (int m = 0; m < 4; ++m) _Pragma("unroll") for (int n = 0; n < 2; ++n) _Pragma("unroll") for (int k = 0; k < 2; ++k) \
        acc[ai][bj][m][n] = __builtin_amdgcn_mfma_f32_16x16x32_bf16(Bt[n][k], At[m][k], acc[ai][bj][m][n], 0, 0, 0); __builtin_amdgcn_s_setprio(0); } while (0)
#define PG8_WAIT_V(n) asm volatile("s_waitcnt vmcnt(" #n ")" ::: "memory")
#define PG8_WAIT_L(n) asm volatile("s_waitcnt lgkmcnt(" #n ")" ::: "memory")
#define PG8_BAR __builtin_amdgcn_s_barrier()
#define PG8_SCHED __builtin_amdgcn_sched_barrier(0)
    Unit cur, nxt; int ui = 0;
    if (!S.next(0, cur)) return;
    f32x4 acc[2][2][4][2];
#pragma unroll
    for (int a = 0; a < 2; ++a)
#pragma unroll
        for (int b = 0; b < 2; ++b)
#pragma unroll
            for (int m = 0; m < 4; ++m)
#pragma unroll
                for (int n = 0; n < 2; ++n) acc[a][b][m][n] = (f32x4){0.f, 0.f, 0.f, 0.f};
    bf16x8 At[4][2], B0[2][2], B1[2][2];
    const char* cA = (const char*)Abase + cur.aoff; const char* cB = (const char*)Bbase + cur.boff;
    PG8_STAGE(PG8_SB(0, 0), cB, voffB); PG8_STAGE(PG8_SB(0, 1), cB + hstepB, voffB); PG8_STAGE(PG8_SA(0, 0), cA, voffA); PG8_STAGE(PG8_SA(0, 1), cA + hstepA, voffA);
    if (wr == 1) PG8_BAR;
    PG8_WAIT_V(2); PG8_BAR;
    PG8_STAGE(PG8_SB(1, 0), cB + kstep, voffB); PG8_STAGE(PG8_SA(1, 0), cA + kstepA, voffA); PG8_STAGE(PG8_SB(1, 1), cB + hstepB + kstep, voffB);
    PG8_WAIT_V(6); PG8_BAR;
    for (;;) {
        const bool has_next = S.next(ui + 1, nxt);
        const char* nA = has_next ? (const char*)Abase + nxt.aoff : cA; const char* nB = has_next ? (const char*)Bbase + nxt.boff : cB;
        const int nt = cur.nt;
#pragma unroll 1
        for (int t = 0; t < nt; t += 2) {
            const bool last = (t == nt - 2);
            const char* a1 = cA + (size_t)(t + 1) * kstepA;
            const char* a2 = last ? nA : cA + (size_t)(t + 2) * kstepA; const char* b2 = last ? nB : cB + (size_t)(t + 2) * kstep;
            const char* a3 = a2 + kstepA; const char* b3 = b2 + kstep;
            PG8_LDB(B0, 0, 0); PG8_LDB(B1, 0, 1); PG8_SCHED; PG8_LDA(At, 0, 0); PG8_STAGE(PG8_SA(1, 1), a1 + hstepA, voffA);
            PG8_WAIT_V(8); PG8_WAIT_L(0); PG8_BAR; PG8_MMA(0, 0, At, B0); PG8_MMA(0, 1, At, B1); PG8_BAR; PG8_SCHED;
            PG8_LDA(At, 0, 1); PG8_STAGE(PG8_SB(0, 0), b2, voffB); PG8_STAGE(PG8_SB(0, 1), b2 + hstepB, voffB); PG8_STAGE(PG8_SA(0, 0), a2, voffA);
            PG8_WAIT_V(8); PG8_WAIT_L(0); PG8_BAR; PG8_MMA(1, 0, At, B0); PG8_MMA(1, 1, At, B1); PG8_BAR; PG8_SCHED;
            PG8_LDB(B0, 1, 0); PG8_LDB(B1, 1, 1); PG8_SCHED; PG8_LDA(At, 1, 0); PG8_STAGE(PG8_SA(0, 1), a2 + hstepA, voffA);
            PG8_WAIT_V(8); PG8_WAIT_L(0); PG8_BAR; PG8_MMA(0, 0, At, B0); PG8_MMA(0, 1, At, B1); PG8_BAR; PG8_SCHED;
            PG8_LDA(At, 1, 1); PG8_STAGE(PG8_SB(1, 0), b3, voffB); PG8_STAGE(PG8_SB(1, 1), b3 + hstepB, voffB); PG8_STAGE(PG8_SA(1, 0), a3, voffA);
            PG8_WAIT_V(8); PG8_WAIT_L(0); PG8_BAR; PG8_MMA(1, 0, At, B0); PG8_MMA(1, 1, At, B1); PG8_BAR; PG8_SCHED;
        }
        if constexpr (ALIGN_EPI) { if (wr == 0) PG8_BAR; }
        E(acc, cur, wr, wc, fr, fq);
        if (!has_next) break;
#pragma unroll
        for (int a = 0; a < 2; ++a)
#pragma unroll
            for (int b = 0; b < 2; ++b)
#pragma unroll
                for (int m = 0; m < 4; ++m)
#pragma unroll
                    for (int n = 0; n < 2; ++n) acc[a][b][m][n] = (f32x4){0.f, 0.f, 0.f, 0.f};
        cur = nxt; cA = nA; cB = nB; ++ui;
        if constexpr (ALIGN_EPI) { if (wr == 1) PG8_BAR; }
    }
    PG8_WAIT_V(0);
    if constexpr (!ALIGN_EPI) { if (wr == 0) PG8_BAR; }
    PG8_BAR;
#undef PG8_SA
#undef PG8_SB
#undef PG8_STAGE
#undef PG8_LDA
#undef PG8_LDB
#undef PG8_MMA
#undef PG8_WAIT_V
#undef PG8_WAIT_L
#undef PG8_BAR
#undef PG8_SCHED
}

#define EPI_BEGIN _Pragma("unroll") for (int ai = 0; ai < 2; ++ai) _Pragma("unroll") for (int m = 0; m < 4; ++m) { const int rl = ai * 128 + wr * 64 + m * 16 + fr; \
    _Pragma("unroll") for (int bj = 0; bj < 2; ++bj) { const int cl = bj * 128 + wc * 32 + 8 * fq; const f32x4 v0 = acc[ai][bj][m][0], v1 = acc[ai][bj][m][1];
#define EPI_END } asm volatile("" ::: "memory"); }

struct EpiBf16 {
    bf16_t* O; int ldc; float* PART; int part_row0; size_t part_stride;
    __device__ __forceinline__ void operator()(const f32x4 (&acc)[2][2][4][2], const Unit& u, int wr, int wc, int fr, int fq) const {
        if (u.ks < 0) {
        EPI_BEGIN
            u32x4 w; w.x = cvt_pk_bf16(v0[0], v0[1]); w.y = cvt_pk_bf16(v0[2], v0[3]); w.z = cvt_pk_bf16(v1[0], v1[1]); w.w = cvt_pk_bf16(v1[2], v1[3]);
            *(u32x4*)(O + (size_t)(u.pm * BM + rl) * ldc + u.pn * BM + cl) = w;
        EPI_END
        } else {
        EPI_BEGIN
            float* o = PART + (size_t)u.ks * part_stride + (size_t)(u.pm * BM + rl - part_row0) * 1024 + u.pn * BM + cl;
            *(f32x4*)o = v0; *(f32x4*)(o + 4) = v1;
        EPI_END
        }
    }
};
struct EpiSwiglu {
    bf16_t* O; int ldc; int nkb;
    __device__ __forceinline__ void operator()(const f32x4 (&acc)[2][2][4][2], const Unit& u, int wr, int wc, int fr, int fq) const {
        EPI_BEGIN
            u32x2 w; w.x = cvt_pk_bf16(siluf_(v0[0]) * v0[1], siluf_(v0[2]) * v0[3]); w.y = cvt_pk_bf16(siluf_(v1[0]) * v1[1], siluf_(v1[2]) * v1[3]);
            const int hc = (u.pn * BM + cl) >> 1;
            bf16_t* o = nkb ? O + ((((size_t)u.pm * nkb + (hc >> 6)) * BM + rl) << 6) + (hc & 63) : O + (size_t)(u.pm * BM + rl) * ldc + hc;
            *(u32x2*)o = w;
        EPI_END
    }
};
struct EpiRes {
    bf16_t* XW; const float* xin_x; const float* xin_c; const float* gate;
    const float* ssq; const float* colscale; int row_base; int xin_mode; float* PART;
    __device__ __forceinline__ void operator()(const f32x4 (&acc)[2][2][4][2], const Unit& u, int wr, int wc, int fr, int fq) const {
        if (u.ks >= 0) {
        EPI_BEGIN
            float* o = PART + ((size_t)u.ks * RC + (u.pm * BM + rl)) * DM + u.pn * BM + cl;
            *(f32x4*)o = v0; *(f32x4*)(o + 4) = v1;
        EPI_END
            return;
        }
        const float* gp = gate + (size_t)row_sample(row_base + u.pm * BM) * 6144 + u.pn * BM + wc * 32 + 8 * fq;
        f32x4 gq[2][2], cq[2][2];
#pragma unroll
        for (int bj = 0; bj < 2; ++bj) { gq[bj][0] = *(const f32x4*)(gp + bj * 128); gq[bj][1] = *(const f32x4*)(gp + bj * 128 + 4);
            if (colscale) { const float* cp = colscale + u.pn * BM + wc * 32 + 8 * fq + bj * 128; cq[bj][0] = *(const f32x4*)cp; cq[bj][1] = *(const f32x4*)(cp + 4); }
            else { cq[bj][0] = (f32x4){1.f, 1.f, 1.f, 1.f}; cq[bj][1] = cq[bj][0]; } }
        if (xin_mode == 0 && !ssq) {
#pragma unroll
            for (int ai = 0; ai < 2; ++ai) {
                u32x4 xr[4][2];
#pragma unroll
                for (int m = 0; m < 4; ++m)
#pragma unroll
                    for (int bj = 0; bj < 2; ++bj) xr[m][bj] = *(const u32x4*)(XW + (size_t)(row_base + u.pm * BM + ai * 128 + wr * 64 + m * 16 + fr) * DM + u.pn * BM + bj * 128 + wc * 32 + 8 * fq);
#pragma unroll
                for (int m = 0; m < 4; ++m)
#pragma unroll
                    for (int bj = 0; bj < 2; ++bj) {
                        bf16_t* xo = XW + (size_t)(row_base + u.pm * BM + ai * 128 + wr * 64 + m * 16 + fr) * DM + u.pn * BM + bj * 128 + wc * 32 + 8 * fq;
                        float t8[8]; unpack8(xr[m][bj], t8);
                        const f32x4 x0 = (f32x4){t8[0], t8[1], t8[2], t8[3]} + gq[bj][0] * (acc[ai][bj][m][0] * cq[bj][0]), x1 = (f32x4){t8[4], t8[5], t8[6], t8[7]} + gq[bj][1] * (acc[ai][bj][m][1] * cq[bj][1]);
                        u32x4 w_; w_.x = cvt_pk_bf16(x0[0], x0[1]); w_.y = cvt_pk_bf16(x0[2], x0[3]); w_.z = cvt_pk_bf16(x1[0], x1[1]); w_.w = cvt_pk_bf16(x1[2], x1[3]);
                        *(u32x4*)xo = w_;
                    }
                asm volatile("" ::: "memory");
            }
            return;
        }
#pragma unroll
        for (int ai = 0; ai < 2; ++ai)
#pragma unroll
            for (int m = 0; m < 4; ++m) {
                const int rl = ai * 128 + wr * 64 + m * 16 + fr, row = row_base + u.pm * BM + rl;
                float rs = 1.f;
                if (ssq) { const f32x4 q = *(const f32x4*)(ssq + (size_t)row * 4); rs = __builtin_amdgcn_rsqf(((q[0] + q[1]) + (q[2] + q[3])) * (1.f / 2048.f) + NORM_EPS); }
#pragma unroll
                for (int bj = 0; bj < 2; ++bj) {
                    const int col = u.pn * BM + bj * 128 + wc * 32 + 8 * fq;
                    const f32x4 a0 = acc[ai][bj][m][0] * rs * cq[bj][0], a1 = acc[ai][bj][m][1] * rs * cq[bj][1];
                    bf16_t* xo = XW + (size_t)row * DM + col;
                    f32x4 x0, x1;
                    if (xin_mode == 0) { float t8[8]; unpack8(*(const u32x4*)xo, t8); x0 = (f32x4){t8[0], t8[1], t8[2], t8[3]}; x1 = (f32x4){t8[4], t8[5], t8[6], t8[7]}; }
                    else { const float* xi = row < RC ? xin_c + (size_t)row * DM + col : xin_x + (size_t)(row - RC) * DM + col; x0 = *(const f32x4*)xi; x1 = *(const f32x4*)(xi + 4); }
                    x0 = x0 + gq[bj][0] * a0; x1 = x1 + gq[bj][1] * a1;
                    u32x4 w_; w_.x = cvt_pk_bf16(x0[0], x0[1]); w_.y = cvt_pk_bf16(x0[2], x0[3]); w_.z = cvt_pk_bf16(x1[0], x1[1]); w_.w = cvt_pk_bf16(x1[2], x1[3]);
                    *(u32x4*)xo = w_;
                }
                if (m & 1) asm volatile("" ::: "memory");
            }
    }
};
__device__ __forceinline__ float softplusf_(float x) { return x > 20.f ? x : log1pf(__expf(x)); }
struct EpiMbIn {
    bf16_t* Z; bf16_t* XBCP; float* DT; const float* dt_bias;
    __device__ __forceinline__ void operator()(const f32x4 (&acc)[2][2][4][2], const Unit& u, int wr, int wc, int fr, int fq) const {
        EPI_BEGIN
            const int row = u.pm * BM + rl, col = u.pn * BM + cl;
            if (col < MB_DI + MB_XBC) {
                u32x4 w; w.x = cvt_pk_bf16(v0[0], v0[1]); w.y = cvt_pk_bf16(v0[2], v0[3]); w.z = cvt_pk_bf16(v1[0], v1[1]); w.w = cvt_pk_bf16(v1[2], v1[3]);
                bf16_t* o = (col < MB_DI) ? Z + (size_t)row * MB_DI + col : XBCP + (size_t)row * MB_XBC + (col - MB_DI);
                *(u32x4*)o = w;
            } else if (col < MB_NIN) {
                const int c = col - (MB_DI + MB_XBC);
                const f32x4 b0 = *(const f32x4*)(dt_bias + c), b1 = *(const f32x4*)(dt_bias + c + 4);
                f32x4 o0, o1;
#pragma unroll
                for (int j = 0; j < 4; ++j) { o0[j] = softplusf_(v0[j] + b0[j]); o1[j] = softplusf_(v1[j] + b1[j]); }
                *(f32x4*)(DT + (size_t)row * 64 + c) = o0; *(f32x4*)(DT + (size_t)row * 64 + c + 4) = o1;
            }
        EPI_END
    }
};
struct EpiRwBig {
    bf16_t* RKV; bf16_t* L1;
    __device__ __forceinline__ void operator()(const f32x4 (&acc)[2][2][4][2], const Unit& u, int wr, int wc, int fr, int fq) const {
        EPI_BEGIN
            const int row = u.pm * BM + rl, col = u.pn * BM + cl;
            if (col < 3072) {
                bf16_t* o = RKV + (size_t)(col >> 10) * RT * DM + (size_t)row * DM + (col & 1023);
                u32x4 w; w.x = cvt_pk_bf16(v0[0], v0[1]); w.y = cvt_pk_bf16(v0[2], v0[3]); w.z = cvt_pk_bf16(v1[0], v1[1]); w.w = cvt_pk_bf16(v1[2], v1[3]);
                *(u32x4*)o = w;
            } else {
                const int c = col - 3072, tile = c >> 8, cc = c & 255;
                if (cc < 128) {
                    float t[8];
#pragma unroll
                    for (int j = 0; j < 4; ++j) { t[j] = v0[j]; t[4 + j] = v1[j]; }
                    if (tile == 0) {
#pragma unroll
                        for (int j = 0; j < 8; ++j) t[j] = tanhf(t[j]);
                    } else if (tile == 2) {
#pragma unroll
                        for (int j = 0; j < 8; ++j) t[j] = sigmoidf_(t[j]);
                    }
                    u32x4 w; w.x = cvt_pk_bf16(t[0], t[1]); w.y = cvt_pk_bf16(t[2], t[3]); w.z = cvt_pk_bf16(t[4], t[5]); w.w = cvt_pk_bf16(t[6], t[7]);
                    *(u32x4*)(L1 + (size_t)row * 384 + tile * 128 + cc) = w;
                }
            }
        EPI_END
    }
};
struct EpiRwL2 {
    float* WD; bf16_t* AD; bf16_t* GG; const float* w0; const float* a0;
    __device__ __forceinline__ void operator()(const f32x4 (&acc)[2][2][4][2], const Unit& u, int wr, int wc, int fr, int fq) const {
        EPI_BEGIN
            const int row = u.pm * BM + rl, col = u.pn * BM + cl, seg = col >> 10, c = col & 1023;
            if (seg < 4) {
                const float* bp = (seg < 2 ? w0 : a0) + (seg & 1) * DM + c;
                const f32x4 b0 = *(const f32x4*)bp, b1 = *(const f32x4*)(bp + 4); f32x4 o0, o1;
#pragma unroll
                for (int j = 0; j < 4; ++j) { const float s0 = sigmoidf_(v0[j] + b0[j]), s1 = sigmoidf_(v1[j] + b1[j]);
                    o0[j] = seg < 2 ? -0.606531f * s0 : s0; o1[j] = seg < 2 ? -0.606531f * s1 : s1; }
                if (seg < 2) { float* o = WD + (size_t)(seg & 1) * RT * DM + (size_t)row * DM + c; *(f32x4*)o = o0; *(f32x4*)(o + 4) = o1; }
                else { u32x4 w; w.x = cvt_pk_bf16(o0[0], o0[1]); w.y = cvt_pk_bf16(o0[2], o0[3]); w.z = cvt_pk_bf16(o1[0], o1[1]); w.w = cvt_pk_bf16(o1[2], o1[3]);
                    *(u32x4*)(AD + (size_t)(seg & 1) * RT * DM + (size_t)row * DM + c) = w; }
            } else {
                u32x4 w; w.x = cvt_pk_bf16(v0[0], v0[1]); w.y = cvt_pk_bf16(v0[2], v0[3]); w.z = cvt_pk_bf16(v1[0], v1[1]); w.w = cvt_pk_bf16(v1[2], v1[3]);
                *(u32x4*)(GG + (size_t)row * DM + c) = w;
            }
        EPI_END
    }
};
}

namespace attn_body {
using bf16 = __hip_bfloat16;
using f32x16 = __attribute__((ext_vector_type(16))) float;
constexpr int D = 64, DMQ = 1024, DKV = 256;
constexpr int NW = 8, QBLK = 32, QB = QBLK * NW, KVBLK = 64;
__device__ __forceinline__ int crow(int r, int hi) { return (r & 3) + 8 * (r >> 2) + 4 * hi; }
#define SBAR() __builtin_amdgcn_sched_barrier(0)
constexpr int NSLOT = 3, SLOTB = 8192;
constexpr int LDS_K = 0, LDS_V = NSLOT * SLOTB, LDS_WS = 2 * NSLOT * SLOTB, LDS_OST = LDS_WS + NW * 64 * 4, ATTN_LDS_BYTES = LDS_OST + NW * 4096;
constexpr float C2 = 0.125f * 1.4426950408889634f;
__device__ __forceinline__ void glds16(const void* gsrc, unsigned lds_dst) { unsigned keep;
    asm volatile("s_mov_b32 %0, m0\n\ts_mov_b32 m0, %2\n\ts_nop 0\n\tglobal_load_lds_dwordx4 %1, off\n\ts_mov_b32 m0, %0" : "=&s"(keep) : "v"(gsrc), "s"(lds_dst) : "memory"); }
__device__ __forceinline__ float max3f(float a, float b, float c) { float r; asm("v_max3_f32 %0, %1, %2, %3" : "=v"(r) : "v"(a), "v"(b), "v"(c)); return r; }
__device__ __forceinline__ float max2f(float a, float b) { float r; asm("v_max_f32_e32 %0, %1, %2" : "=v"(r) : "v"(a), "v"(b)); return r; }
__device__ __forceinline__ float fadd_s(float a, float b) { float r; asm("v_add_f32_e32 %0, %1, %2" : "=v"(r) : "v"(a), "v"(b)); return r; }
__device__ __forceinline__ float fsub_s(float a, float b) { float r; asm("v_sub_f32_e32 %0, %1, %2" : "=v"(r) : "v"(a), "v"(b)); return r; }
typedef float f32x2_t __attribute__((ext_vector_type(2))); typedef __bf16 bf16x2_t __attribute__((ext_vector_type(2)));
__device__ __forceinline__ unsigned cvtpk_s(float lo, float hi) { f32x2_t v = {lo, hi}; bf16x2_t b = __builtin_convertvector(v, bf16x2_t); return __builtin_bit_cast(unsigned, b); }
#define WAIT_BAR(N) asm volatile("s_waitcnt vmcnt(" #N ") lgkmcnt(0)\n\ts_barrier" ::: "memory")
__device__ __forceinline__ void qkt(f32x16& p0, f32x16& p1, const char* Kslot, const bf16x8* qr, const f32x16& negm, int r32, int hi) {
    const char* kb = Kslot + hi * 1024 + r32 * 16;
#pragma unroll
    for (int d0 = 0; d0 < 4; ++d0) {
        const bf16x8 b0 = *reinterpret_cast<const bf16x8*>(kb + d0 * 2048);
        const bf16x8 b1 = *reinterpret_cast<const bf16x8*>(kb + d0 * 2048 + 512);
        if (d0 == 0) { p0 = __builtin_amdgcn_mfma_f32_32x32x16_bf16(b0, qr[0], negm, 0, 0, 0); p1 = __builtin_amdgcn_mfma_f32_32x32x16_bf16(b1, qr[0], negm, 0, 0, 0); }
        else { p0 = __builtin_amdgcn_mfma_f32_32x32x16_bf16(b0, qr[d0], p0, 0, 0, 0); p1 = __builtin_amdgcn_mfma_f32_32x32x16_bf16(b1, qr[d0], p1, 0, 0, 0); } }
}
typedef __attribute__((address_space(3))) const char* lds_cptr;
typedef short v4i16_t __attribute__((ext_vector_type(4)));
__device__ __forceinline__ void kload8(bf16x8* kf, lds_cptr kp) {
    kf[0] = *(const LAS bf16x8*)(kp);        kf[1] = *(const LAS bf16x8*)(kp + 512);
    kf[2] = *(const LAS bf16x8*)(kp + 2048); kf[3] = *(const LAS bf16x8*)(kp + 2560);
    kf[4] = *(const LAS bf16x8*)(kp + 4096); kf[5] = *(const LAS bf16x8*)(kp + 4608);
    kf[6] = *(const LAS bf16x8*)(kp + 6144); kf[7] = *(const LAS bf16x8*)(kp + 6656);
}
__device__ __forceinline__ void kload2(bf16x8* kf, lds_cptr kp, int j) { kf[2 * j] = *(const LAS bf16x8*)(kp + j * 2048); kf[2 * j + 1] = *(const LAS bf16x8*)(kp + j * 2048 + 512); }
__device__ __forceinline__ s16x4 vtr(lds_cptr p) { return __builtin_bit_cast(s16x4, __builtin_amdgcn_ds_read_tr16_b64_v4i16((LAS v4i16_t*)p)); }
__device__ __forceinline__ float rowmax(const f32x16& p0, const f32x16& p1) {
    float a = max3f(p0[0], p0[1], p1[0]), b = max3f(p0[2], p0[3], p1[1]); a = max3f(a, p1[2], p1[3]);
#pragma unroll
    for (int r = 4; r < 16; r += 4) { a = max3f(a, p0[r], p0[r + 1]); b = max3f(b, p0[r + 2], p0[r + 3]); a = max3f(a, p1[r], p1[r + 1]); b = max3f(b, p1[r + 2], p1[r + 3]); }
    const float m = max2f(a, b);
    auto rr = __builtin_amdgcn_permlane32_swap(__float_as_uint(m), __float_as_uint(m), false, false);
    return max2f(__uint_as_float(rr[0]), __uint_as_float(rr[1]));
}
__device__ __forceinline__ void pv(f32x16* o, int vb, bf16x8 pa0, bf16x8 pa1, bf16x8 pa2, bf16x8 pa3) {
#pragma unroll
    for (int d0 = 0; d0 < 2; ++d0) { s16x4 lo[4], hi[4];
#pragma unroll
        for (int ks = 0; ks < 4; ++ks) {
            asm volatile("ds_read_b64_tr_b16 %0,%1 offset:%c2" : "=&v"(lo[ks]) : "v"(vb), "i"(d0 * 4096 + ks * 1024) : "memory");
            asm volatile("ds_read_b64_tr_b16 %0,%1 offset:%c2" : "=&v"(hi[ks]) : "v"(vb), "i"(d0 * 4096 + ks * 1024 + 512) : "memory"); }
        asm volatile("s_waitcnt lgkmcnt(0)" ::: "memory"); SBAR();
#define PK(k) (bf16x8){lo[k][0], lo[k][1], lo[k][2], lo[k][3], hi[k][0], hi[k][1], hi[k][2], hi[k][3]}
        o[d0] = __builtin_amdgcn_mfma_f32_32x32x16_bf16(pa0, PK(0), o[d0], 0, 0, 0);
        o[d0] = __builtin_amdgcn_mfma_f32_32x32x16_bf16(pa1, PK(1), o[d0], 0, 0, 0);
        o[d0] = __builtin_amdgcn_mfma_f32_32x32x16_bf16(pa2, PK(2), o[d0], 0, 0, 0);
        o[d0] = __builtin_amdgcn_mfma_f32_32x32x16_bf16(pa3, PK(3), o[d0], 0, 0, 0);
#undef PK
    }
}
template <int THRL> __device__ __forceinline__ void attn_unit(int b, int h, int qb, const bf16* Q  , const float* qgain, const float* rope, const bf16* __restrict__ K, const bf16* __restrict__ V, bf16* O, char* shm) {
    const int tid = threadIdx.x, lane = tid & 63, r32 = lane & 31, hi = lane >> 5; const int wid = __builtin_amdgcn_readfirstlane(tid >> 6);
    const long rowbase = (long)b * TL; const int q0 = qb * QB;
    const bf16* Qw = Q + ((long)RC + rowbase + q0 + wid * QBLK) * 1536 + h * D;
    const bf16* Kh = K + (long)b * KVL * DKV + (h >> 2) * D, *Vh = V + (long)b * KVL * DKV + (h >> 2) * D;
    const unsigned lds0 = (unsigned)(uintptr_t)shm;
    float* wsf = (float*)(shm + LDS_WS) + wid * 64;
    const bf16* ksrc = Kh + (long)lane * DKV + wid * 8;
    const bf16* vsrc = Vh + (long)(16 * (wid & 3) + (lane >> 2)) * DKV + (wid >> 2) * 32 + (lane & 3) * 8;
    const unsigned kdst = lds0 + LDS_K + wid * 1024, vdst = lds0 + LDS_V + wid * 1024;
#define DMA_K(t, slot) glds16(ksrc + (long)(t) * KVBLK * DKV, (unsigned)__builtin_amdgcn_readfirstlane(kdst + (slot)))
#define DMA_V(t, slot) glds16(vsrc + (long)(t) * KVBLK * DKV, (unsigned)__builtin_amdgcn_readfirstlane(vdst + (slot)))
    const int vb0 = (int)(lds0 + LDS_V) + ((lane >> 4) & 1) * 32 + (lane & 3) * 8 + (4 * hi + ((lane & 15) >> 2)) * 64;
    const char* Kbase = shm + LDS_K; bf16x8 kf[8];
    const lds_cptr shm3 = (lds_cptr)shm; const lds_cptr kp0 = shm3 + LDS_K + hi * 1024 + r32 * 16; const lds_cptr vp0 = shm3 + LDS_V + ((lane >> 4) & 1) * 32 + (lane & 3) * 8 + (4 * hi + ((lane & 15) >> 2)) * 64;
    constexpr int NT = KVL / KVBLK;
    DMA_K(0, 0); DMA_V(0, 0); DMA_K(1, SLOTB);
    bf16x8 qr[4];
#pragma unroll
    for (int d0 = 0; d0 < 4; ++d0) qr[d0] = *reinterpret_cast<const bf16x8*>(&Qw[(long)r32 * 1536 + d0 * 16 + hi * 8]);
    {
        float qf[4][8]; float ss = 0.f;
#pragma unroll
        for (int d0 = 0; d0 < 4; ++d0)
#pragma unroll
            for (int k = 0; k < 8; ++k) { qf[d0][k] = __uint_as_float(((unsigned)(unsigned short)qr[d0][k]) << 16); ss += qf[d0][k] * qf[d0][k]; }
        { auto rr = __builtin_amdgcn_permlane32_swap(__float_as_uint(ss), __float_as_uint(ss), false, false); ss = __uint_as_float(rr[0]) + __uint_as_float(rr[1]); }
        const float rstd = __builtin_amdgcn_rsqf(ss * (1.f / 64.f) + 1e-6f);
        const int tq = q0 + wid * QBLK + r32, prow = tq >> 6, pcol = tq & 63;
#pragma unroll
        for (int d0 = 0; d0 < 4; ++d0)
#pragma unroll
            for (int k = 0; k < 8; ++k) qf[d0][k] *= rstd * qgain[16 * d0 + 8 * hi + k];
#pragma unroll
        for (int hf = 0; hf < 2; ++hf) { const float* cs = rope + (hf ? pcol : prow) * 16 + 8 * hi; const float* sn = cs + 2048;
#pragma unroll
            for (int k = 0; k < 8; ++k) { const float c_ = cs[k], s_ = sn[k], x1 = qf[2 * hf][k], x2 = qf[2 * hf + 1][k];
                qf[2 * hf][k] = x1 * c_ - x2 * s_; qf[2 * hf + 1][k] = x2 * c_ + x1 * s_; } }
#pragma unroll
        for (int d0 = 0; d0 < 4; ++d0) { u32x4 pw;
            pw.x = cvtpk_s(qf[d0][0] * C2, qf[d0][1] * C2); pw.y = cvtpk_s(qf[d0][2] * C2, qf[d0][3] * C2); pw.z = cvtpk_s(qf[d0][4] * C2, qf[d0][5] * C2); pw.w = cvtpk_s(qf[d0][6] * C2, qf[d0][7] * C2);
            qr[d0] = __builtin_bit_cast(bf16x8, pw); }
    }
    constexpr float M0 = 12.f;
    float l_reg = 0.f; f32x16 o[2]; o[0] = f32x16{}; o[1] = f32x16{}; f32x16 negm;
    _Pragma("unroll") for (int r = 0; r < 16; ++r) negm[r] = -M0;
    asm volatile("" : "+v"(negm));
#define START(P0, P1) do { _Pragma("unroll") for (int r = 0; r < 16; ++r) P0[r] = __builtin_amdgcn_exp2f(P0[r]); } while (0)
#define RESC() do { } while (0)
    f32x16 pA0, pA1, pB0, pB1;
    int sl_prev = 0, sl_cur = 0, sl_next = SLOTB;
#define ROT() do { sl_prev = sl_cur; sl_cur = sl_next; sl_next = (sl_next == (NSLOT - 1) * SLOTB) ? 0 : sl_next + SLOTB; } while (0)
    DMA_K(2, 2 * SLOTB);
    WAIT_BAR(3);
    qkt(pA0, pA1, Kbase, qr, negm, r32, hi); asm volatile("s_nop 15\n\ts_nop 7" : "+v"(pA0), "+v"(pA1));
    START(pA0, pA1);
    _Pragma("unroll") for (int r = 0; r < 16; ++r) pA1[r] = __builtin_amdgcn_exp2f(pA1[r]);
    WAIT_BAR(0);
    DMA_K(3, 0); DMA_V(1, SLOTB);
    ROT();
    kload8(kf, kp0 + sl_cur);
    WAIT_BAR(2);
    s16x4 vlo[8], vhi[8]; u32x4 pw0, pw1, pw2, pw3;
#define PKW(P, B) cvtpk_s(P[B], P[B + 1])
#define PAF(k) __builtin_bit_cast(bf16x8, pw##k)
#define VFR(i) (bf16x8){vlo[i][0], vlo[i][1], vlo[i][2], vlo[i][3], vhi[i][0], vhi[i][1], vhi[i][2], vhi[i][3]}
#define PIN(x) asm volatile("" : "+v"(x))
#define MX3(a, b, c) __builtin_fmaxf(__builtin_fmaxf((a), (b)), (c))
#define GAPA(MF, A0, A1, A2, A3, W0, W1, PW) do { MF; sacc += A0; sacc += A1; sacc += A2; sacc += A3; PIN(sacc); W0; W1; PIN(PW); SBAR(); } while (0)
#define EX(v) __builtin_amdgcn_exp2f(v)
#define GAPB(MF, X, B) do { MF; X[B] = EX(X[B]); X[B + 1] = EX(X[B + 1]); X[B + 2] = EX(X[B + 2]); X[B + 3] = EX(X[B + 3]); PIN(X); SBAR(); } while (0)
#define VRD(i) do { vlo[i] = vtr(vp_ + (((i) >> 2) * 4096 + ((i) & 3) * 1024)); vhi[i] = vtr(vp_ + (((i) >> 2) * 4096 + ((i) & 3) * 1024 + 512)); } while (0)
#define KRD(G, j) do { if (G) { kload2(kf, kp0 + sl_next, j); SBAR(); } } while (0)
#define STEP(C0, C1, P0, P1, t, GK, GV, GL) do { SBAR(); \
    const lds_cptr vp_ = vp0 + sl_prev; \
    VRD(0); SBAR(); float sacc = (P0[0] + P0[1]); \
    GAPA(C0 = __builtin_amdgcn_mfma_f32_32x32x16_bf16(kf[0], qr[0], negm, 0, 0, 0), P0[2], P0[3], P0[4], P0[5],     pw0[0] = PKW(P0, 0), pw0[1] = PKW(P0, 2), pw0); \
    VRD(4); SBAR(); GAPA(C1 = __builtin_amdgcn_mfma_f32_32x32x16_bf16(kf[1], qr[0], negm, 0, 0, 0), P0[6], P0[7], P0[8], P0[9],     pw0[2] = PKW(P0, 4), pw0[3] = PKW(P0, 6), pw0); \
    VRD(1); SBAR(); GAPA(C0 = __builtin_amdgcn_mfma_f32_32x32x16_bf16(kf[2], qr[1], C0, 0, 0, 0),   P0[10], P0[11], P0[12], P0[13], pw1[0] = PKW(P0, 8), pw1[1] = PKW(P0, 10), pw1); \
    VRD(5); SBAR(); GAPA(C1 = __builtin_amdgcn_mfma_f32_32x32x16_bf16(kf[3], qr[1], C1, 0, 0, 0),   P0[14], P0[15], P1[0], P1[1],   pw1[2] = PKW(P0, 12), pw1[3] = PKW(P0, 14), pw1); \
    VRD(2); SBAR(); GAPA(C0 = __builtin_amdgcn_mfma_f32_32x32x16_bf16(kf[4], qr[2], C0, 0, 0, 0),   P1[2], P1[3], P1[4], P1[5],     pw2[0] = PKW(P1, 0), pw2[1] = PKW(P1, 2), pw2); \
    VRD(6); SBAR(); GAPA(C1 = __builtin_amdgcn_mfma_f32_32x32x16_bf16(kf[5], qr[2], C1, 0, 0, 0),   P1[6], P1[7], P1[8], P1[9],     pw2[2] = PKW(P1, 4), pw2[3] = PKW(P1, 6), pw2); \
    VRD(3); SBAR(); GAPA(C0 = __builtin_amdgcn_mfma_f32_32x32x16_bf16(kf[6], qr[3], C0, 0, 0, 0),   P1[10], P1[11], P1[12], P1[13], pw3[0] = PKW(P1, 8), pw3[1] = PKW(P1, 10), pw3); \
    VRD(7); SBAR(); GAPA(C1 = __builtin_amdgcn_mfma_f32_32x32x16_bf16(kf[7], qr[3], C1, 0, 0, 0),   P1[14], P1[15], 0.f, 0.f,       pw3[2] = PKW(P1, 12), pw3[3] = PKW(P1, 14), pw3); \
    l_reg += sacc; \
    if (GK) { DMA_K((t) + 3, sl_cur); } if (GV) { DMA_V((t) + 1, sl_next); } \
    SBAR(); \
    GAPB(o[0] = __builtin_amdgcn_mfma_f32_32x32x16_bf16(PAF(0), VFR(0), o[0], 0, 0, 0), C0, 0); \
    GAPB(o[1] = __builtin_amdgcn_mfma_f32_32x32x16_bf16(PAF(0), VFR(4), o[1], 0, 0, 0), C0, 4); \
    KRD(GL, 0); GAPB(o[0] = __builtin_amdgcn_mfma_f32_32x32x16_bf16(PAF(1), VFR(1), o[0], 0, 0, 0), C0, 8); \
    KRD(GL, 1); GAPB(o[1] = __builtin_amdgcn_mfma_f32_32x32x16_bf16(PAF(1), VFR(5), o[1], 0, 0, 0), C0, 12); \
    KRD(GL, 2); GAPB(o[0] = __builtin_amdgcn_mfma_f32_32x32x16_bf16(PAF(2), VFR(2), o[0], 0, 0, 0), C1, 0); \
    KRD(GL, 3); GAPB(o[1] = __builtin_amdgcn_mfma_f32_32x32x16_bf16(PAF(2), VFR(6), o[1], 0, 0, 0), C1, 4); \
    GAPB(o[0] = __builtin_amdgcn_mfma_f32_32x32x16_bf16(PAF(3), VFR(3), o[0], 0, 0, 0), C1, 8); \
    GAPB(o[1] = __builtin_amdgcn_mfma_f32_32x32x16_bf16(PAF(3), VFR(7), o[1], 0, 0, 0), C1, 12); \
    } while (0)
    int t = 1;
    for (; t + 5 < NT; t += 2) {
        STEP(pB0, pB1, pA0, pA1, t, true, true, true);     WAIT_BAR(2); RESC(); ROT();
        STEP(pA0, pA1, pB0, pB1, t + 1, true, true, true); WAIT_BAR(2); RESC(); ROT();
    }
#define ENDW(tt) do { if ((tt) + 3 < NT) { WAIT_BAR(2); } else if ((tt) + 2 < NT) { WAIT_BAR(1); } else { WAIT_BAR(0); } } while (0)
    for (; t + 1 < NT; t += 2) {
        STEP(pB0, pB1, pA0, pA1, t, (t + 3 < NT), (t + 1 < NT), (t + 1 < NT));         ENDW(t);     RESC(); ROT();
        STEP(pA0, pA1, pB0, pB1, t + 1, (t + 4 < NT), (t + 2 < NT), (t + 2 < NT));     ENDW(t + 1); RESC(); ROT();
    }
    STEP(pB0, pB1, pA0, pA1, NT - 1, false, false, false); RESC();
    { float sacc = pB0[0] + pB0[1]; _Pragma("unroll") for (int r = 2; r < 16; ++r) sacc += pB0[r]; _Pragma("unroll") for (int r = 0; r < 16; ++r) sacc += pB1[r]; l_reg += sacc;
      pw0 = (u32x4){PKW(pB0, 0), PKW(pB0, 2), PKW(pB0, 4), PKW(pB0, 6)}; pw1 = (u32x4){PKW(pB0, 8), PKW(pB0, 10), PKW(pB0, 12), PKW(pB0, 14)}; pw2 = (u32x4){PKW(pB1, 0), PKW(pB1, 2), PKW(pB1, 4), PKW(pB1, 6)}; pw3 = (u32x4){PKW(pB1, 8), PKW(pB1, 10), PKW(pB1, 12), PKW(pB1, 14)};
      SBAR(); pv(o, vb0 + sl_cur, PAF(0), PAF(1), PAF(2), PAF(3)); }
#undef PKW
#undef PAF
#undef VFR
#undef PIN
#undef MX3
#undef GAPA
#undef GAPB
#undef EX
#undef VRD
#undef KRD
#undef STEP
#undef ENDW
    { auto rr = __builtin_amdgcn_permlane32_swap(__float_as_uint(l_reg), __float_as_uint(l_reg), false, false); l_reg = __uint_as_float(rr[0]) + __uint_as_float(rr[1]); }
    if (hi == 0) wsf[32 + r32] = l_reg; asm volatile("s_waitcnt lgkmcnt(0)" ::: "memory");
    float rli[16];
#pragma unroll
    for (int r = 0; r < 16; ++r) rli[r] = __builtin_amdgcn_rcpf(wsf[32 + crow(r, hi)]);
    bf16* Ow = O + (rowbase + q0 + wid * QBLK) * DMQ + h * D;
    { bf16* stg = (bf16*)(shm + LDS_OST) + wid * 2048;
#pragma unroll
      for (int r = 0; r < 16; ++r) { const int orow = crow(r, hi);
#pragma unroll
          for (int d0 = 0; d0 < 2; ++d0) stg[orow * 64 + d0 * 32 + r32] = __float2bfloat16(o[d0][r] * rli[r]); }
      asm volatile("s_waitcnt lgkmcnt(0)" ::: "memory");
#pragma unroll
      for (int i = 0; i < 4; ++i) { const int row = i * 8 + (lane >> 3), ch = lane & 7; const u32x4 v = *(const u32x4*)(stg + row * 64 + ch * 8); *(u32x4*)(Ow + (long)row * DMQ + ch * 8) = v; } }
    asm volatile("s_waitcnt lgkmcnt(0)\n\ts_barrier" ::: "memory");
#undef DMA_K
#undef DMA_V
#undef START
#undef RESC
#undef ROT
}
#undef SBAR
#undef WAIT_BAR
}

struct Args { const float* in[44]; float* out; unsigned char* ws; int ph_lo, ph_hi, li, pad; };
enum { I_X = 0, I_C, I_CTX, I_CCTX, I_MODW, I_MODB, I_N1G, I_N2G, I_FG, I_MBIN, I_MBCW, I_MBCB, I_MBDTB, I_MBALOG, I_MBD, I_MBNG, I_MBOUT,
       I_RWMIX, I_RWRKV, I_RWW0, I_RWW1, I_RWW2, I_RWA0, I_RWA1, I_RWA2, I_RWG1, I_RWG2, I_RWKK, I_RWKA, I_RWRK, I_RWLNG, I_RWLNB, I_RWOUT,
       I_PLW, I_PLS, I_ATQKV, I_ATQG, I_ATKG, I_ATOUT, I_FFIN, I_FFOUT, I_MOER, I_MOEIN, I_MOEOUT };

struct Frame {
    LAS unsigned char* lds; unsigned char* ws; const float* const* in; float* out;
    int tid, lane, wave, G, vcu;
};
#define WSP(T, off) ((T*)(F.ws + (off)))
#define SCR(T, off) ((T*)(F.ws + WS_SCR + (off)))

constexpr int NL_GS = 0, NL_SH = 3 * DM * 4, NL_X = 6 * DM * 4;
__device__ __forceinline__ void stage_norm_params(const Frame& F, const float* g, const float* MOD, int which) {
    LAS float* GS = (LAS float*)(F.lds + NL_GS); LAS float* SH = (LAS float*)(F.lds + NL_SH);
    for (int i = F.tid; i < 3 * DM; i += NWAVES * 64) { const int s = i >> 10, c = i & 1023; const float* shift = MOD + (size_t)s * 6144 + (which ? 3 : 0) * DM;
        GS[i] = g[c] * (shift[DM + c] + 1.0f); SH[i] = shift[c]; }
}
struct XRow { f32x4 f[4]; u32x2 r[4]; };
__device__ __forceinline__ void xrow_load(const Frame& F, int src_inputs, int row, int lane, XRow& x) {
    if (src_inputs) { const float* xr = row < RC ? F.in[I_CTX] + (size_t)row * DM : F.in[I_X] + (size_t)(row - RC) * DM;
#pragma unroll
        for (int j = 0; j < 4; ++j) x.f[j] = *(const f32x4*)(xr + 4 * lane + 256 * j);
    } else { const bf16_t* xr = WSP(bf16_t, WS_XW) + (size_t)row * DM;
#pragma unroll
        for (int j = 0; j < 4; ++j) x.r[j] = *(const u32x2*)(xr + 4 * lane + 256 * j); }
}
__device__ __forceinline__ void xrow_get(int src_inputs, const XRow& x, f32x4 (&v)[4]) {
#pragma unroll
    for (int j = 0; j < 4; ++j) v[j] = src_inputs ? x.f[j] : (f32x4){bflo(x.r[j].x), bfhi(x.r[j].x), bflo(x.r[j].y), bfhi(x.r[j].y)};
}
__device__ __forceinline__ void norm_regs(f32x4 (&v)[4], LAS const float* GSs, LAS const float* SHs, int lane) {
    float s = 0.f;
#pragma unroll
    for (int j = 0; j < 4; ++j) s += (v[j][0] * v[j][0] + v[j][1] * v[j][1]) + (v[j][2] * v[j][2] + v[j][3] * v[j][3]);
    const float rstd = __builtin_amdgcn_rsqf(wave_sum(s) * (1.f / DM) + NORM_EPS);
#pragma unroll
    for (int j = 0; j < 4; ++j) { const int c = 4 * lane + 256 * j; v[j] = v[j] * rstd * *(LAS const f32x4*)(GSs + c) + *(LAS const f32x4*)(SHs + c); }
}
__device__ __forceinline__ void store_row_bf16(bf16_t* o, int lane, const f32x4 (&v)[4]) {
#pragma unroll
    for (int j = 0; j < 4; ++j) { u32x2 w; w.x = pk2(v[j][0], v[j][1]); w.y = pk2(v[j][2], v[j][3]); *(u32x2*)(o + 4 * lane + 256 * j) = w; }
}
__device__ __forceinline__ void route_row(const Frame& F, LAS const float* rw, int row, const f32x4 (&v)[4]) {
    float lg[8];
#pragma unroll
    for (int e = 0; e < 8; ++e) lg[e] = 0.f;
#pragma unroll
    for (int j = 0; j < 4; ++j)
#pragma unroll
        for (int i = 0; i < 4; ++i) { const f32x4 w0 = *(LAS const f32x4*)(rw + (((4 * j + i) * 2 + 0) * 64 + F.lane) * 4), w1 = *(LAS const f32x4*)(rw + (((4 * j + i) * 2 + 1) * 64 + F.lane) * 4);
#pragma unroll
            for (int e = 0; e < 4; ++e) { lg[e] += v[j][i] * w0[e]; lg[4 + e] += v[j][i] * w1[e]; } }
#pragma unroll
    for (int e = 0; e < 8; ++e) lg[e] = wave_sum(lg[e]);
    if (F.lane == 0) {
        int e0 = 0; float m0 = lg[0];
#pragma unroll
        for (int e = 1; e < 8; ++e) if (lg[e] > m0) { m0 = lg[e]; e0 = e; }
        int e1 = -1; float m1 = -INFINITY;
#pragma unroll
        for (int e = 0; e < 8; ++e) if (e != e0 && lg[e] > m1) { m1 = lg[e]; e1 = e; }
        if (e1 < 0) { e1 = (e0 == 0) ? 1 : 0; m1 = m0; }
        const float p1 = __expf(m1 - m0), inv = 1.f / (1.f + p1);
        WSP(int, WS_SEL)[row] = e0 | (e1 << 8);
        WSP(float, WS_WTS)[2 * row] = inv; WSP(float, WS_WTS)[2 * row + 1] = p1 * inv;
    }
}
struct CtxFix { const float* gate; const float* ssq; int xin_inputs; int S; };
template <int MODE>
__device__ __forceinline__ void p_norm(const Frame& F, int layer, int which, int src_inputs, int row_lo, const CtxFix fx = CtxFix{nullptr, nullptr, 0, 0}) {
    const float* g = F.in[which ? I_N2G : I_N1G] + layer * DM;
    const float* MOD = WSP(float, WS_MOD) + (size_t)layer * 3 * 6144;
    bf16_t* H = WSP(bf16_t, WS_H);
    LAS const float* GS = (LAS const float*)(F.lds + NL_GS); LAS const float* SH = (LAS const float*)(F.lds + NL_SH); LAS float* RW8 = (LAS float*)(F.lds + NL_X);
    stage_norm_params(F, g, MOD, which);
    if (MODE == 2) { const float* rw = F.in[I_MOER] + (size_t)(layer >> 1) * DM * 8;
        for (int i = F.tid; i < DM * 8; i += NWAVES * 64) { const int c = i >> 3, e8 = i & 7, j = c >> 8, l = (c & 255) >> 2, q = c & 3; RW8[(((4 * j + q) * 2 + (e8 >> 2)) * 64 + l) * 4 + (e8 & 3)] = rw[i]; } }
    __syncthreads();
    const int gw = F.vcu * NWAVES + F.wave, NGW = F.G * NWAVES;
    auto process = [&](const XRow& xr, int row) {
        const int s = row_sample(row);
        f32x4 v[4]; xrow_get(src_inputs, xr, v);
        if (fx.S > 0 && row < RC) {
            const float* PART = SCR(float, S_PARTC); bf16_t* XW = WSP(bf16_t, WS_XW);
            float rs = 1.f;
            if (fx.ssq) { f32x4 q = (f32x4){0.f, 0.f, 0.f, 0.f};
#pragma unroll
                for (int k = 0; k < 8; ++k) q += *(const f32x4*)(fx.ssq + (size_t)row * 32 + 4 * k);
                rs = __builtin_amdgcn_rsqf(((q[0] + q[1]) + (q[2] + q[3])) * (1.f / 2048.f) + NORM_EPS); }
#pragma unroll
            for (int j = 0; j < 4; ++j) { const int c = 4 * F.lane + 256 * j; f32x4 a = (f32x4){0.f, 0.f, 0.f, 0.f};
                for (int ks = 0; ks < fx.S; ++ks) a += *(const f32x4*)(PART + ((size_t)ks * RC + row) * DM + c);
                const f32x4 xi = fx.xin_inputs ? *(const f32x4*)(F.in[I_CTX] + (size_t)row * DM + c) : v[j];
                v[j] = xi + *(const f32x4*)(fx.gate + c) * a * rs; st_x4(XW + (size_t)row * DM + c, v[j]); }
        }
        norm_regs(v, GS + s * DM, SH + s * DM, F.lane);
        store_row_bf16(H + (size_t)row * DM, F.lane, v);
        if (MODE == 2) route_row(F, RW8, row, v);
    };
    XRow b0, b1, b2, b3;
    int row = row_lo + gw;
    if (row < RT) xrow_load(F, src_inputs, row, F.lane, b0);
    if (row + NGW < RT) xrow_load(F, src_inputs, row + NGW, F.lane, b1);
    if (row + 2 * NGW < RT) xrow_load(F, src_inputs, row + 2 * NGW, F.lane, b2);
    for (; row < RT; row += 4 * NGW) {
        if (row + 3 * NGW < RT) xrow_load(F, src_inputs, row + 3 * NGW, F.lane, b3);
        process(b0, row);
        if (row + NGW >= RT) break;
        if (row + 4 * NGW < RT) xrow_load(F, src_inputs, row + 4 * NGW, F.lane, b0);
        process(b1, row + NGW);
        if (row + 2 * NGW >= RT) break;
        if (row + 5 * NGW < RT) xrow_load(F, src_inputs, row + 5 * NGW, F.lane, b1);
        process(b2, row + 2 * NGW);
        if (row + 3 * NGW >= RT) break;
        if (row + 6 * NGW < RT) xrow_load(F, src_inputs, row + 6 * NGW, F.lane, b2);
        process(b3, row + 3 * NGW);
    }
}
__device__ __forceinline__ void p_norm_rw(const Frame& F, int layer) {
    const float* g = F.in[I_N1G] + layer * DM;
    const float* MOD = WSP(float, WS_MOD) + (size_t)layer * 3 * 6144;
    bf16_t* X6 = SCR(bf16_t, S_X6);
    LAS const float* GS = (LAS const float*)(F.lds + NL_GS); LAS const float* SH = (LAS const float*)(F.lds + NL_SH); LAS float* MIX = (LAS float*)(F.lds + NL_X);
    stage_norm_params(F, g, MOD, 0);
    for (int i = F.tid; i < 6 * DM; i += NWAVES * 64) MIX[i] = F.in[I_RWMIX][i];
    __syncthreads();
    const int gw = F.vcu * NWAVES + F.wave, NGW = F.G * NWAVES;
    const int n4 = ((RT / 4) / NGW) * NGW, nitems = n4 + (RT - 4 * n4);
    for (int idx = gw; idx < nitems; idx += NGW) {
        const int r0 = idx < n4 ? 4 * idx : 4 * n4 + (idx - n4), nr = idx < n4 ? 4 : 1;
        const int s_ = row_sample(r0);
        const int start = r0 < RC ? (r0 & ~(TC - 1)) : RC + ((r0 - RC) & ~(TL - 1)), len = r0 < RC ? TC : TL, t0 = r0 - start;
        XRow xr[6]; unsigned okm = 0u;
#pragma unroll
        for (int q = 0; q < 6; ++q) { const int t = t0 - 1 + q; const bool ok = (q <= nr + 1) && t >= 0 && t < len; if (ok) { okm |= 1u << q; xrow_load(F, 0, r0 - 1 + q, F.lane, xr[q]); } }
        f32x4 hp[4], hc[4], hn[4];
#define NRW_ROW(dst, q) do { if ((okm >> (q)) & 1u) { xrow_get(0, xr[q], dst); norm_regs(dst, GS + s_ * DM, SH + s_ * DM, F.lane); } \
            else { _Pragma("unroll") for (int j = 0; j < 4; ++j) dst[j] = (f32x4){0.f, 0.f, 0.f, 0.f}; } } while (0)
        NRW_ROW(hp, 0); NRW_ROW(hc, 1);
#pragma unroll
        for (int i = 0; i < 4; ++i) {
            if (i < nr) {
                NRW_ROW(hn, i + 2);
                f32x4 xx[4];
#pragma unroll
                for (int j = 0; j < 4; ++j) xx[j] = (hp[j] + hn[j]) * 0.5f - hc[j];
#pragma unroll
                for (int m = 0; m < 6; ++m) { f32x4 o[4];
#pragma unroll
                    for (int j = 0; j < 4; ++j) o[j] = hc[j] + xx[j] * *(LAS const f32x4*)(MIX + m * DM + 4 * F.lane + 256 * j);
                    store_row_bf16(X6 + (size_t)m * RT * DM + (size_t)(r0 + i) * DM, F.lane, o); }
#pragma unroll
                for (int j = 0; j < 4; ++j) { hp[j] = hc[j]; hc[j] = hn[j]; }
            }
        }
#undef NRW_ROW
    }
}

__device__ __forceinline__ void p_mb_conv(const Frame& F) {
    const bf16_t* P = SCR(bf16_t, S_XBCP); bf16_t* O = SCR(bf16_t, S_XBC);
    const float* cw = F.in[I_MBCW]; const float* cb = F.in[I_MBCB];
    constexpr int NCH = MB_XBC / 8, NSTRIP = RT / 16;
    for (int i = blockIdx.x * (NWAVES * 64) + F.tid; i < NSTRIP * NCH; i += F.G * NWAVES * 64) {
        const int strip = i / NCH, c = (i % NCH) * 8, row0 = strip * 16;
        const int start = row0 < RC ? (row0 & ~(TC - 1)) : RC + ((row0 - RC) & ~(TL - 1)), len = row0 < RC ? TC : TL, t0 = row0 - start;
        float w[5][8], bias[8];
#pragma unroll
        for (int j = 0; j < 5; ++j) { const f32x4 w0 = *(const f32x4*)(cw + j * MB_XBC + c), w1 = *(const f32x4*)(cw + j * MB_XBC + c + 4);
#pragma unroll
            for (int k = 0; k < 4; ++k) { w[j][k] = w0[k]; w[j][4 + k] = w1[k]; } }
        { const f32x4 b0 = *(const f32x4*)(cb + c), b1 = *(const f32x4*)(cb + c + 4);
#pragma unroll
          for (int k = 0; k < 4; ++k) { bias[k] = b0[k]; bias[4 + k] = b1[k]; } }
        u32x4 raw[20];
#pragma unroll
        for (int r = 0; r < 20; ++r) { const int tt = t0 + r - 2; raw[r] = (tt >= 0 && tt < len) ? *(const u32x4*)(P + (size_t)(start + tt) * MB_XBC + c) : (u32x4){0u, 0u, 0u, 0u}; }
#pragma unroll
        for (int r = 0; r < 16; ++r) {
            float acc[8];
#pragma unroll
            for (int k = 0; k < 8; ++k) acc[k] = bias[k];
#pragma unroll
            for (int j = 0; j < 5; ++j) { float x[8]; unpack8(raw[r + j], x);
#pragma unroll
                for (int k = 0; k < 8; ++k) acc[k] += w[j][k] * x[k]; }
#pragma unroll
            for (int k = 0; k < 8; ++k) acc[k] = siluf_(acc[k]);
            *(u32x4*)(O + (size_t)(row0 + r) * MB_XBC + c) = pack8(acc);
        }
    }
}
__device__ __forceinline__ int sc_row0(int sc) { return sc < 4 ? (sc >> 1) * TC + (sc & 1) * MB_CH : RC + ((sc - 4) >> 6) * TL + ((sc - 4) & 63) * MB_CH; }
__device__ __forceinline__ bf16x8 tr_frag(LAS const unsigned char* base, int ldb, int k0, int n0, int lane) {
    const int g = lane >> 4, q = (lane & 15) >> 2, p = lane & 3;
    LAS const unsigned char* a = base + (k0 + 8 * g + q) * ldb + (n0 + 4 * p) * 2;
    typedef short v4i16_t __attribute__((ext_vector_type(4)));
    const v4i16_t lo = __builtin_amdgcn_ds_read_tr16_b64_v4i16((LAS v4i16_t*)a);
    const v4i16_t hi = __builtin_amdgcn_ds_read_tr16_b64_v4i16((LAS v4i16_t*)(a + 4 * ldb));
    return (bf16x8){lo[0], lo[1], lo[2], lo[3], hi[0], hi[1], hi[2], hi[3]};
}
struct MbScanIn { float dv[4], al[2]; };
__device__ __forceinline__ void mb_scans_load(const Frame& F, int row0, int g, MbScanIn& m) {
    const float* DT = SCR(float, S_DT);
#pragma unroll
    for (int k = 0; k < 4; ++k) { const int i = F.tid + k * (NWAVES * 64), q = i >> 4, p = i & 15; m.dv[k] = DT[(size_t)(row0 + q) * 64 + (p >> 3) * 32 + g * 8 + (p & 7)]; }
#pragma unroll
    for (int pp = 0; pp < 2; ++pp) { const int p = F.wave * 2 + pp, d = p >> 3, hd = g * 8 + (p & 7); m.al[pp] = F.in[I_MBALOG][d * 32 + hd]; }
}
__device__ __forceinline__ void mb_scans(const Frame& F, const MbScanIn& m, LAS float* dts, LAS float* cum, LAS float* tot) {
#pragma unroll
    for (int k = 0; k < 4; ++k) { const int i = F.tid + k * (NWAVES * 64), q = i >> 4, p = i & 15; dts[p * 128 + q] = m.dv[k]; }
    __syncthreads();
#pragma unroll
    for (int pp = 0; pp < 2; ++pp) {
        const int p = F.wave * 2 + pp, d = p >> 3;
        const float a = -__expf(m.al[pp]);
        const float v0 = dts[p * 128 + 2 * F.lane] * a, v1 = dts[p * 128 + 2 * F.lane + 1] * a;
        float inc = v0 + v1;
#pragma unroll
        for (int o = 1; o < 64; o <<= 1) { const float t = __shfl_up(inc, o); if (F.lane >= o) inc += t; }
        const float total = __shfl(inc, 63), exc = inc - (v0 + v1);
        if (d == 0) { cum[p * 128 + 2 * F.lane] = exc + v0; cum[p * 128 + 2 * F.lane + 1] = inc; }
        else { cum[p * 128 + 2 * F.lane] = total - exc; cum[p * 128 + 2 * F.lane + 1] = total - exc - v0; }
        if (F.lane == 0) tot[p] = total;
    }
    __syncthreads();
}
__device__ __forceinline__ void p_mb_states(const Frame& F) {
    const bf16_t* XBC = SCR(bf16_t, S_XBC); bf16_t* ST = SCR(bf16_t, S_ST); float* DTOT = SCR(float, S_DTOT);
    LAS unsigned char* bmS = F.lds;
    LAS unsigned char* xwS = F.lds + 34816;
    LAS float* dts = (LAS float*)(F.lds + 34816 + 4 * 18432);
    LAS float* cum = dts + 2048; LAS float* tot = cum + 2048;
    const int lane = F.lane, fr = lane & 15, fq = lane >> 4, tid = F.tid;
    for (int u = blockIdx.x; u < 512 + 128; u += F.G) {
        int sc, g, e_lo, e_hi;
        if (u < 512) { sc = 4 + (u >> 2); g = u & 3; e_lo = 0; e_hi = 8; }
        else { const int v = u - 512; sc = v >> 5; g = (v >> 3) & 3; e_lo = v & 7; e_hi = e_lo + 1; }
        const int row0 = sc_row0(sc);
        u32x4 pX[2];
#define MBS_PREFETCH(e_) do { _Pragma("unroll") for (int i = 0; i < 2; ++i) { const int idx = tid + i * 512; pX[i] = *(const u32x4*)(XBC + (size_t)(row0 + (idx >> 3)) * MB_XBC + (g * 8 + (e_)) * 64 + (idx & 7) * 8); } } while (0)
        MbScanIn msi; mb_scans_load(F, row0, g, msi);
        u32x4 bmr[4];
#pragma unroll
        for (int k = 0; k < 4; ++k) { const int i = tid + k * (NWAVES * 64), q = i >> 4, ch = i & 15; bmr[k] = *(const u32x4*)(XBC + (size_t)(row0 + q) * MB_XBC + MB_DI + g * 128 + ch * 8); }
        MBS_PREFETCH(e_lo);
#pragma unroll
        for (int k = 0; k < 4; ++k) { const int i = tid + k * (NWAVES * 64), q = i >> 4, ch = i & 15; *(LAS u32x4*)(bmS + q * 272 + ch * 16) = bmr[k]; }
        mb_scans(F, msi, dts, cum, tot);
        if (tid < 16 && (tid & 7) >= e_lo && (tid & 7) < e_hi) DTOT[(size_t)sc * 64 + (tid >> 3) * 32 + g * 8 + (tid & 7)] = tot[tid];
        for (int i = tid; i < 2048; i += NWAVES * 64) { const int p = i >> 7; dts[i] = __expf(tot[p] - cum[i]) * dts[i]; }
        __syncthreads();
        bf16x8 af[4];
#pragma unroll
        for (int kk = 0; kk < 4; ++kk) af[kk] = tr_frag(bmS, 272, 32 * kk, 16 * F.wave, lane);
        for (int e = e_lo; e < e_hi; ++e) {
            const int hd = g * 8 + e;
            LAS unsigned char* xw = xwS + (e & 1) * 2 * 18432;
#pragma unroll
            for (int i = 0; i < 2; ++i) { const int idx = tid + i * 512, q = idx >> 3, ch = idx & 7; float x[8], y[8];
                unpack8(pX[i], x); const float wf_ = dts[e * 128 + q], wb_ = dts[(8 + e) * 128 + q];
#pragma unroll
                for (int k = 0; k < 8; ++k) { y[k] = x[k] * wb_; x[k] *= wf_; }
                *(LAS u32x4*)(xw + q * 144 + ch * 16) = pack8(x); *(LAS u32x4*)(xw + 18432 + q * 144 + ch * 16) = pack8(y); }
            __syncthreads();
            if (e + 1 < e_hi) MBS_PREFETCH(e + 1);
#pragma unroll
            for (int d = 0; d < 2; ++d) {
                bf16_t* so = ST + (((size_t)sc * 2 + d) * 32 + hd) * 8192;
#pragma unroll
                for (int pt = 0; pt < 4; ++pt) {
                    f32x4 acc = (f32x4){0.f, 0.f, 0.f, 0.f};
#pragma unroll
                    for (int kk = 0; kk < 4; ++kk) acc = __builtin_amdgcn_mfma_f32_16x16x32_bf16(af[kk], tr_frag(xw + d * 18432, 144, 32 * kk, 16 * pt, lane), acc, 0, 0, 0);
                    u32x2 w_; w_.x = pk2(acc[0], acc[1]); w_.y = pk2(acc[2], acc[3]);
                    *(u32x2*)(so + (size_t)(16 * pt + fr) * 128 + 16 * F.wave + 4 * fq) = w_;
                }
            }
        }
#undef MBS_PREFETCH
        __syncthreads();
    }
}
__device__ __forceinline__ void p_mb_carry(const Frame& F) {
    bf16_t* ST = SCR(bf16_t, S_ST); const float* DTOT = SCR(float, S_DTOT);
    for (int i = blockIdx.x * (NWAVES * 64) + F.tid; i < 2 * 2 * 32 * 1024; i += F.G * NWAVES * 64) {
        const int e8 = i & 1023, hd = (i >> 10) & 31, d = (i >> 15) & 1, b = i >> 16;
        float S[8];
#pragma unroll
        for (int k = 0; k < 8; ++k) S[k] = 0.f;
        for (int s0 = 0; s0 < 66; s0 += 6) {
            bf16_t* p[6]; u32x4 raw[6]; float dec[6];
#pragma unroll
            for (int k = 0; k < 6; ++k) { const int step = s0 + k; int sc;
                if (d == 0) sc = step < 2 ? 2 * b + step : 4 + b * 64 + (step - 2);
                else sc = step < 2 ? 2 * b + 1 - step : 4 + b * 64 + 63 - (step - 2);
                p[k] = ST + (((size_t)sc * 2 + d) * 32 + hd) * 8192 + e8 * 8; raw[k] = *(const u32x4*)p[k]; dec[k] = DTOT[(size_t)sc * 64 + d * 32 + hd]; }
#pragma unroll
            for (int k = 0; k < 6; ++k) { float st[8]; unpack8(raw[k], st); const float dd = __expf(dec[k]);
                *(u32x4*)p[k] = pack8(S);
#pragma unroll
                for (int q = 0; q < 8; ++q) S[q] = S[q] * dd + st[q]; }
        }
    }
}
__device__ __forceinline__ void p_mb_out(const Frame& F) {
    const bf16_t* XBC = SCR(bf16_t, S_XBC); const bf16_t* ST = SCR(bf16_t, S_ST); const bf16_t* Z = SCR(bf16_t, S_Z);
    bf16_t* YG = SCR(bf16_t, S_YG); float* SSQ = SCR(float, S_SSQ); float* SSQC = SCR(float, S_SSQC);
    LAS unsigned char* cmS = F.lds;
    LAS unsigned char* zS = F.lds; LAS unsigned char* ygS = F.lds + 17408;
    LAS unsigned char* bmS = F.lds + 34816;
    LAS unsigned char* sFS = bmS; LAS unsigned char* sBS = bmS + 17408;
    LAS unsigned char* WS_ = F.lds + 2 * 34816 + F.wave * 4352;
    LAS unsigned char* xS = F.lds + 3 * 34816;
    LAS float* dts = (LAS float*)(F.lds + 3 * 34816 + 18432);
    LAS float* cum = dts + 2048; LAS float* tot = cum + 2048;
    const int lane = F.lane, fr = lane & 15, fq = lane >> 4, w = F.wave, tid = F.tid;
    for (int u = blockIdx.x; u < 512 + 128; u += F.G) {
        int sc, g, e_lo, e_hi;
        if (u < 512) { sc = 4 + (u >> 2); g = u & 3; e_lo = 0; e_hi = 8; }
        else { const int v = u - 512; sc = v >> 5; g = (v >> 3) & 3; e_lo = v & 7; e_hi = e_lo + 1; }
        const int row0 = sc_row0(sc);
        __syncthreads();
        MbScanIn msi; mb_scans_load(F, row0, g, msi);
        const float Dall = F.in[I_MBD][g * 8 + (lane & 7)];
        u32x4 bmr[4], cmr[4];
#pragma unroll
        for (int k = 0; k < 4; ++k) { const int i = tid + k * (NWAVES * 64), q = i >> 4, ch = i & 15; const bf16_t* src = XBC + (size_t)(row0 + q) * MB_XBC + MB_DI + g * 128 + ch * 8;
            bmr[k] = *(const u32x4*)src; cmr[k] = *(const u32x4*)(src + 512); }
        u32x4 pS[4], pX[2], pZ[2];
#define MBO_PREFETCH(e_) do { const int hd_ = g * 8 + (e_); \
            _Pragma("unroll") for (int i = 0; i < 4; ++i) { const int idx = tid + (i & 1) * 512; pS[i] = *(const u32x4*)(ST + (((size_t)sc * 2 + (i >> 1)) * 32 + hd_) * 8192 + (size_t)idx * 8); } \
            _Pragma("unroll") for (int i = 0; i < 2; ++i) { const int idx = tid + i * 512, q = idx >> 3, ch = idx & 7; \
                pX[i] = *(const u32x4*)(XBC + (size_t)(row0 + q) * MB_XBC + hd_ * 64 + ch * 8); pZ[i] = *(const u32x4*)(Z + (size_t)(row0 + q) * MB_DI + hd_ * 64 + ch * 8); } } while (0)
        MBO_PREFETCH(e_lo);
#pragma unroll
        for (int k = 0; k < 4; ++k) { const int i = tid + k * (NWAVES * 64), q = i >> 4, ch = i & 15; *(LAS u32x4*)(bmS + q * 272 + ch * 16) = bmr[k]; *(LAS u32x4*)(cmS + q * 272 + ch * 16) = cmr[k]; }
        mb_scans(F, msi, dts, cum, tot);
        bf16x8 cf[4];
#pragma unroll
        for (int kk = 0; kk < 4; ++kk) cf[kk] = *(LAS const bf16x8*)(cmS + (16 * w + fr) * 272 + (32 * kk + 8 * fq) * 2);
        f32x4 cb[8];
#pragma unroll
        for (int jt = 0; jt < 8; ++jt) { cb[jt] = (f32x4){0.f, 0.f, 0.f, 0.f};
#pragma unroll
            for (int kk = 0; kk < 4; ++kk) cb[jt] = __builtin_amdgcn_mfma_f32_16x16x32_bf16(*(LAS const bf16x8*)(bmS + (16 * jt + fr) * 272 + (32 * kk + 8 * fq) * 2), cf[kk], cb[jt], 0, 0, 0); }
        float ssq = 0.f;
        const int irow = 16 * w + fr;
        __syncthreads();
        for (int e = e_lo; e < e_hi; ++e) {
            const int hd = g * 8 + e;
#pragma unroll
            for (int i = 0; i < 4; ++i) { const int idx = tid + (i & 1) * 512; *(LAS u32x4*)((i >> 1 ? sBS : sFS) + (idx >> 4) * 272 + (idx & 15) * 16) = pS[i]; }
#pragma unroll
            for (int i = 0; i < 2; ++i) { const int idx = tid + i * 512, q = idx >> 3, ch = idx & 7; *(LAS u32x4*)(xS + q * 144 + ch * 16) = pX[i]; *(LAS u32x4*)(zS + q * 136 + ch * 16) = pZ[i]; }
            __syncthreads();
            if (e + 1 < e_hi) MBO_PREFETCH(e + 1);
            const float Dsk = __int_as_float(__builtin_amdgcn_readlane(__float_as_int(Dall), e));
            const LAS float* cf_ = cum + e * 128; const LAS float* cr_ = cum + (8 + e) * 128; const LAS float* df_ = dts + e * 128; const LAS float* db_ = dts + (8 + e) * 128;
            const float ci_f = cf_[irow], ci_r = cr_[irow];
#pragma unroll
            for (int jt = 0; jt < 8; ++jt) { const int j4 = 16 * jt + 4 * fq;
                f32x4 val;
                if (jt != w) { const bool fwd = jt < w;
                    const f32x4 cj = *(const LAS f32x4*)((fwd ? cf_ : cr_) + j4), dj = *(const LAS f32x4*)((fwd ? df_ : db_) + j4); const float ci = fwd ? ci_f : ci_r;
#pragma unroll
                    for (int r = 0; r < 4; ++r) val[r] = cb[jt][r] * __expf(ci - cj[r]) * dj[r];
                } else { const f32x4 cjf = *(const LAS f32x4*)(cf_ + j4), cjr = *(const LAS f32x4*)(cr_ + j4), djf = *(const LAS f32x4*)(df_ + j4), djb = *(const LAS f32x4*)(db_ + j4);
#pragma unroll
                    for (int r = 0; r < 4; ++r) { const int j = j4 + r; const bool lo = j < irow;
                        val[r] = cb[jt][r] * __expf(lo ? ci_f - cjf[r] : ci_r - cjr[r]) * (lo ? djf[r] : djb[r]);
                        if (j == irow) val[r] = cb[jt][r] * (djf[r] + djb[r]) + Dsk; } }
                u32x2 w_; w_.x = pk2(val[0], val[1]); w_.y = pk2(val[2], val[3]);
                *(LAS u32x2*)(WS_ + fr * 272 + j4 * 2) = w_; }
            bf16x8 wf[4];
#pragma unroll
            for (int kk = 0; kk < 4; ++kk) wf[kk] = *(LAS const bf16x8*)(WS_ + fr * 272 + (32 * kk + 8 * fq) * 2);
            const float ef = __expf(ci_f), er = __expf(ci_r);
#pragma unroll
            for (int pt = 0; pt < 4; ++pt) {
                f32x4 y = (f32x4){0.f, 0.f, 0.f, 0.f}, t1 = y, t2 = y;
#pragma unroll
                for (int kk = 0; kk < 4; ++kk) {
                    y = __builtin_amdgcn_mfma_f32_16x16x32_bf16(tr_frag(xS, 144, 32 * kk, 16 * pt, lane), wf[kk], y, 0, 0, 0);
                    t1 = __builtin_amdgcn_mfma_f32_16x16x32_bf16(*(LAS const bf16x8*)(sFS + (16 * pt + fr) * 272 + (32 * kk + 8 * fq) * 2), cf[kk], t1, 0, 0, 0);
                    t2 = __builtin_amdgcn_mfma_f32_16x16x32_bf16(*(LAS const bf16x8*)(sBS + (16 * pt + fr) * 272 + (32 * kk + 8 * fq) * 2), cf[kk], t2, 0, 0, 0); }
                const u32x2 zz = *(LAS const u32x2*)(zS + irow * 136 + (16 * pt + 4 * fq) * 2);
                const f32x4 zf = (f32x4){bflo(zz.x), bfhi(zz.x), bflo(zz.y), bfhi(zz.y)};
                f32x4 o;
#pragma unroll
                for (int r = 0; r < 4; ++r) { o[r] = (y[r] + ef * t1[r] + er * t2[r]) * siluf_(zf[r]); ssq += o[r] * o[r]; }
                u32x2 w_; w_.x = pk2(o[0], o[1]); w_.y = pk2(o[2], o[3]);
                *(LAS u32x2*)(ygS + irow * 136 + (16 * pt + 4 * fq) * 2) = w_;
            }
            __syncthreads();
#pragma unroll
            for (int i = 0; i < 2; ++i) { const int idx = tid + i * 512, q = idx >> 3, ch = idx & 7;
                *(u32x4*)(YG + (size_t)(row0 + q) * MB_DI + hd * 64 + ch * 8) = *(LAS const u32x4*)(ygS + q * 136 + ch * 16); }
        }
#undef MBO_PREFETCH
        { float s_ = ssq; s_ += __shfl_xor(s_, 16); s_ += __shfl_xor(s_, 32);
          if (fq == 0) { if (u < 512) SSQ[(size_t)(row0 + irow) * 4 + g] = s_; else SSQC[(size_t)(row0 + irow) * 32 + g * 8 + e_lo] = s_; } }
    }
}


template <int CTRL> __device__ __forceinline__ float dpp_f(float v) { return __builtin_bit_cast(float, __builtin_amdgcn_update_dpp(0, __builtin_bit_cast(int, v), CTRL, 0xf, 0xf, false)); }
__device__ __forceinline__ float red8(float v) { v += dpp_f<0xB1>(v); v += dpp_f<0x4E>(v); v += dpp_f<0x141>(v); return v; }
__device__ __forceinline__ float red16(float v);
__device__ __forceinline__ float wave_sum_fast(float v) {
    v = red16(v);
    const float a = __builtin_bit_cast(float, __builtin_amdgcn_readlane(__builtin_bit_cast(int, v), 0)), b = __builtin_bit_cast(float, __builtin_amdgcn_readlane(__builtin_bit_cast(int, v), 16)),
                c = __builtin_bit_cast(float, __builtin_amdgcn_readlane(__builtin_bit_cast(int, v), 32)), d = __builtin_bit_cast(float, __builtin_amdgcn_readlane(__builtin_bit_cast(int, v), 48));
    return (a + b) + (c + d);
}
__device__ __forceinline__ float red16(float v) { v += dpp_f<0xB1>(v); v += dpp_f<0x4E>(v); v += dpp_f<0x141>(v); v += dpp_f<0x140>(v); return v; }
#ifndef CVT_REP
#define CVT_REP 1
#endif
constexpr int RW_TS = 32;
constexpr int N_MOEIN_IT = 16 * 224, N_MOEOUT_IT = 56 * 32;
__device__ __forceinline__ void p_rw_l2(const Frame& F) {
    const bf16_t* L1 = SCR(bf16_t, S_L1); const bf16_t* W2 = WSP(bf16_t, W_RWL2);
    float* WD = SCR(float, S_WD); bf16_t* AD = SCR(bf16_t, S_AD); bf16_t* GG = SCR(bf16_t, S_GG);
    const int gw = F.vcu * NWAVES + F.wave, NGW = F.G * NWAVES, lane = F.lane, fr = lane & 15, fq = lane >> 4;
    for (int it = gw; it < 2 * (RT / 16); it += NGW) {
        const int rt = it >> 1, nb0 = (it & 1) * 32, seg = 4, row = rt * 16 + fr;
        const int K = seg < 4 ? 64 : 128, koff = seg < 4 ? seg * 64 : 256;
        const bf16_t* Wseg = W2 + (seg < 4 ? (size_t)seg * 1024 * 64 : (size_t)4 * 1024 * 64);
        bf16x8 af[4];
#pragma unroll
        for (int kk = 0; kk < 4; ++kk) af[kk] = (kk * 32 < K) ? *(const bf16x8*)(L1 + (size_t)row * 384 + koff + 32 * kk + 8 * fq) : (bf16x8){0, 0, 0, 0, 0, 0, 0, 0};
        const float* bias = seg < 2 ? F.in[I_RWW0] + seg * DM : (seg < 4 ? F.in[I_RWA0] + (seg - 2) * DM : nullptr);
#pragma unroll 1
        for (int nb = nb0; nb < nb0 + 32; nb += 8) {
            bf16x8 wf[8][4];
#pragma unroll
            for (int u = 0; u < 8; ++u) { const bf16_t* wr = Wseg + (size_t)(16 * (nb + u) + fr) * K + 8 * fq;
                wf[u][0] = *(const bf16x8*)(wr); wf[u][1] = *(const bf16x8*)(wr + 32);
                if (seg == 4) { wf[u][2] = *(const bf16x8*)(wr + 64); wf[u][3] = *(const bf16x8*)(wr + 96); } }
#pragma unroll
            for (int u = 0; u < 8; ++u) {
                const int nt = nb + u;
                f32x4 acc = (f32x4){0.f, 0.f, 0.f, 0.f};
                acc = __builtin_amdgcn_mfma_f32_16x16x32_bf16(wf[u][0], af[0], acc, 0, 0, 0);
                acc = __builtin_amdgcn_mfma_f32_16x16x32_bf16(wf[u][1], af[1], acc, 0, 0, 0);
                if (seg == 4) { acc = __builtin_amdgcn_mfma_f32_16x16x32_bf16(wf[u][2], af[2], acc, 0, 0, 0); acc = __builtin_amdgcn_mfma_f32_16x16x32_bf16(wf[u][3], af[3], acc, 0, 0, 0); }
                const int c = 16 * nt + 4 * fq;
                if (seg < 4) { const f32x4 bb = *(const f32x4*)(bias + c); f32x4 o;
#pragma unroll
                    for (int i = 0; i < 4; ++i) { const float sg = sigmoidf_(acc[i] + bb[i]); o[i] = seg < 2 ? -0.606531f * sg : sg; }
                    if (seg < 2) *(f32x4*)(WD + (size_t)seg * RT * DM + (size_t)row * DM + c) = o;
                    else { u32x2 w_; w_.x = pk2(o[0], o[1]); w_.y = pk2(o[2], o[3]); *(u32x2*)(AD + (size_t)(seg - 2) * RT * DM + (size_t)row * DM + c) = w_; }
                } else { u32x2 w_; w_.x = pk2(acc[0], acc[1]); w_.y = pk2(acc[2], acc[3]); *(u32x2*)(GG + (size_t)row * DM + c) = w_; }
            }
        }
    }
}

constexpr int WY_C = 64, WY_NCH = (TC + TL) / WY_C, WY_LD = 144, WY_IMG = 64 * WY_LD, WY_FRAGS = 40, WY_ITEM = WY_FRAGS * 1024;
__device__ __forceinline__ int wy_row0(int b, int d, int c) {
    return c < TC / WY_C ? b * TC + (d ? TC - 1 - c * WY_C : c * WY_C) : RC + b * TL + (d ? TL - 1 - (c - TC / WY_C) * WY_C : (c - TC / WY_C) * WY_C);
}
template <int CTRL> __device__ __forceinline__ float dpp0_f(float v) { return __builtin_bit_cast(float, __builtin_amdgcn_update_dpp(0, __builtin_bit_cast(int, v), CTRL, 0xf, 0xf, true)); }
template <bool ATR, bool BTR>
__device__ __forceinline__ void wy_mm2(f32x4 (&acc)[2], LAS const unsigned char* X, LAS const unsigned char* Y, int mt, int nt0, int lane) {
    const int fr = lane & 15, fq = lane >> 4;
#pragma unroll
    for (int kk = 0; kk < 2; ++kk) {
        const bf16x8 a = ATR ? tr_frag(X, WY_LD, 32 * kk, 16 * mt, lane) : *(LAS const bf16x8*)(X + (16 * mt + fr) * WY_LD + (32 * kk + 8 * fq) * 2);
#pragma unroll
        for (int q = 0; q < 2; ++q) {
            const bf16x8 bb = BTR ? tr_frag(Y, WY_LD, 32 * kk, 16 * (nt0 + q), lane) : *(LAS const bf16x8*)(Y + (16 * (nt0 + q) + fr) * WY_LD + (32 * kk + 8 * fq) * 2);
            acc[q] = __builtin_amdgcn_mfma_f32_16x16x32_bf16(a, bb, acc[q], 0, 0, 0);
        }
    }
}
__device__ __forceinline__ void wy_put2(LAS unsigned char* img, const f32x4 (&acc)[2], int mt, int nt0, int lane) {
    const int fr = lane & 15, fq = lane >> 4;
#pragma unroll
    for (int q = 0; q < 2; ++q) { u32x2 w_; w_.x = pk2(acc[q][0], acc[q][1]); w_.y = pk2(acc[q][2], acc[q][3]);
        *(LAS u32x2*)(img + (16 * (nt0 + q) + fr) * WY_LD + (16 * mt + 4 * fq) * 2) = w_; }
}
struct CvtJob { const float* W; bf16_t* WT; int ldw, ldt, k0, n0, inter_half, drow0; const float* ksc; };
__device__ __forceinline__ CvtJob moe_cvt_job(const Frame& F, int it) {
    const int per = N_MOEIN_IT + N_MOEOUT_IT, le = it / per, r = it % per; CvtJob j; j.drow0 = 0; j.ksc = nullptr;
    if (r < N_MOEIN_IT) { j.W = F.in[I_MOEIN] + (size_t)le * DM * 2 * FFE; j.ldw = 2 * FFE; j.k0 = 64 * (r / 224); j.n0 = 32 * (r % 224); j.WT = WSP(bf16_t, W_MOEIN) + (size_t)le * 2 * FFE * DM; j.ldt = DM; j.inter_half = FFE; }
    else { const int rr = r - N_MOEIN_IT; j.W = F.in[I_MOEOUT] + (size_t)le * FFE * DM; j.ldw = DM; j.k0 = 64 * (rr / 32); j.n0 = 32 * (rr % 32); j.WT = WSP(bf16_t, W_MOEOUT) + (size_t)le * DM * FFE; j.ldt = FFE; j.inter_half = 0; }
    return j;
}
__device__ __forceinline__ void cvt_load(const CvtJob& j, float (&tv)[32], int lane) {
#pragma unroll
    for (int i = 0; i < 32; ++i) { const int kk = 2 * i + (lane >> 5); tv[i] = __builtin_nontemporal_load(j.W + (size_t)(j.k0 + kk) * j.ldw + j.n0 + (lane & 31)); }
}
__device__ __forceinline__ void cvt_finish(const CvtJob& j, const float (&tv)[32], LAS unsigned char* img, int lane) {
#pragma unroll
    for (int i = 0; i < 32; ++i) { const int kk = 2 * i + (lane >> 5); float v = tv[i]; if (j.ksc) v *= j.ksc[j.k0 + kk]; *(LAS bf16_t*)(img + kk * 72 + (lane & 31) * 2) = (bf16_t)f2bf(v); }
    LDS_WAIT(); asm volatile("" ::: "memory");
    const int fr = lane & 15, fq = lane >> 4;
#pragma unroll
    for (int c = 0; c < 2; ++c) { const int gn = j.n0 + 16 * c + fr; const int drow = j.drow0 + (j.inter_half ? (gn < j.inter_half ? 2 * gn : 2 * (gn - j.inter_half) + 1) : gn);
#pragma unroll
        for (int kk = 0; kk < 2; ++kk) { const bf16x8 v = tr_frag(img, 72, 32 * kk, 16 * c, lane);
            *(bf16x8*)(j.WT + (size_t)drow * j.ldt + j.k0 + 32 * kk + 8 * fq) = v; } }
    LDS_WAIT(); asm volatile("" ::: "memory");
}
namespace pro {
constexpr int N_MBIN = 16 * 162, N_MBOUT = 32 * 32, N_RKV = 16 * 32, N_W1 = 16 * 2, N_G1 = 16 * 4, N_SQ = 16 * 32, N_PL = 4 * 8, N_QKV = 16 * 48, N_FFIN = 16 * 176, N_FFOUT = 44 * 32;
constexpr int NITEMS = N_MBIN + N_MBOUT + 3 * N_RKV + 4 * N_W1 + N_G1 + 4 * 32 + 2 * 32 + N_SQ + 4 * N_PL + N_QKV + N_SQ + 2 * N_FFIN + 2 * N_FFOUT;
}
__device__ __forceinline__ CvtJob pro_cvt_job(const Frame& F, int r) {
    using namespace pro;
    const float* const* in = F.in; CvtJob j; j.inter_half = 0; j.drow0 = 0; j.ksc = nullptr;
#define PSET(Wp, LDW, K0, N0, WTp, LDT) do { j.W = (Wp); j.ldw = (LDW); j.k0 = (K0); j.n0 = (N0); j.WT = (WTp); j.ldt = (LDT); } while (0)
#define PJ(cnt, ...) if (r < (cnt)) { __VA_ARGS__; return j; } r -= (cnt);
    PJ(N_MBIN, PSET(in[I_MBIN], MB_NIN, 64 * (r / 162), 32 * (r % 162), WSP(bf16_t, W_MBIN), DM))
    PJ(N_MBOUT, PSET(in[I_MBOUT], DM, 64 * (r / 32), 32 * (r % 32), WSP(bf16_t, W_MBOUT), MB_DI); j.ksc = in[I_MBNG])
    PJ(3 * N_RKV, { const int q = r / N_RKV, rr = r % N_RKV; PSET(in[I_RWRKV] + (size_t)q * DM * DM, DM, 64 * (rr / 32), 32 * (rr % 32), WSP(bf16_t, W_RWBIG), DM); j.drow0 = q * 1024; })
    PJ(4 * N_W1, { const int q = r / N_W1, rr = r % N_W1; const int isa = q >> 1, d = q & 1;
        PSET(in[isa ? I_RWA1 : I_RWW1] + (size_t)d * DM * 64, 64, 64 * (rr / 2), 32 * (rr % 2), WSP(bf16_t, W_RWBIG), DM); j.drow0 = 3072 + isa * 256 + d * 64; })
    PJ(N_G1, PSET(in[I_RWG1], 128, 64 * (r / 4), 32 * (r % 4), WSP(bf16_t, W_RWBIG), DM); j.drow0 = 3584)
    PJ(4 * 32, { const int seg = r / 32, nb = r % 32; PSET(in[seg < 2 ? I_RWW2 : I_RWA2] + (size_t)(seg & 1) * 64 * DM, DM, 0, 32 * nb, WSP(bf16_t, W_RWL2) + (size_t)seg * 1024 * 64, 64); })
    PJ(2 * 32, PSET(in[I_RWG2], DM, 64 * (r / 32), 32 * (r % 32), WSP(bf16_t, W_RWL2) + (size_t)4 * 1024 * 64, 128))
    PJ(N_SQ, PSET(in[I_RWOUT], DM, 64 * (r / 32), 32 * (r % 32), WSP(bf16_t, W_RWOUT), DM))
    PJ(4 * N_PL, { const int gi = r / N_PL, rr = r % N_PL; PSET(in[I_PLW] + (size_t)gi * 65536, 256, 64 * (rr / 8), 32 * (rr % 8), WSP(bf16_t, W_POOL), 256); j.drow0 = gi * 256; })
    PJ(N_QKV, PSET(in[I_ATQKV], 1536, 64 * (r / 48), 32 * (r % 48), WSP(bf16_t, W_QKV), DM))
    PJ(N_SQ, PSET(in[I_ATOUT], DM, 64 * (r / 32), 32 * (r % 32), WSP(bf16_t, W_ATOUT), DM))
    PJ(2 * N_FFIN, { const int l = r / N_FFIN, rr = r % N_FFIN; PSET(in[I_FFIN] + (size_t)l * DM * 2 * FFD, 2 * FFD, 64 * (rr / 176), 32 * (rr % 176), WSP(bf16_t, W_FFIN) + (size_t)l * 2 * FFD * DM, DM); j.inter_half = FFD; })
    { const int l = r / N_FFOUT, rr = r % N_FFOUT; PSET(in[I_FFOUT] + (size_t)l * FFD * DM, DM, 64 * (rr / 32), 32 * (rr % 32), WSP(bf16_t, W_FFOUT) + (size_t)l * DM * FFD, FFD); }
    return j;
#undef PJ
#undef PSET
}
template <int PART>
__device__ __forceinline__ void p_prologue(const Frame& F) {
    const float* const* in = F.in;
    if (PART == 0) {
    {
        LAS float* sv = (LAS float*)F.lds;
        LAS float* part = (LAS float*)(F.lds + 16384);
        for (int i = F.tid; i < 3 * DM; i += NWAVES * 64) { const int s = i >> 10, k = i & 1023; const float cv = (s == 0) ? in[I_CCTX][k] : in[I_C][(s - 1) * DM + k]; sv[i] = siluf_(cv); }
        __syncthreads();
        float* MOD = WSP(float, WS_MOD);
        const int c4 = F.lane & 7, kb = F.wave * 128 + (F.lane >> 3);
        f32x4 w[16], wn[16];
        int it = blockIdx.x;
#define MOD_LOAD(dst, item) do { const float* W_ = in[I_MODW] + (size_t)((item) / 192) * DM * 6144 + ((item) % 192) * 32 + 4 * c4; \
        _Pragma("unroll") for (int i = 0; i < 16; ++i) dst[i] = __builtin_nontemporal_load((const f32x4*)(W_ + (size_t)(kb + 8 * i) * 6144)); } while (0)
        if (it < 4 * 192) MOD_LOAD(w, it);
        for (; it < 4 * 192; it += F.G) {
            const int layer = it / 192, cg = it % 192; const bool hn = it + F.G < 4 * 192;
            if (hn) MOD_LOAD(wn, it + F.G);
            f32x4 a0 = (f32x4){0.f, 0.f, 0.f, 0.f}, a1 = a0, a2 = a0;
#pragma unroll
            for (int i = 0; i < 16; ++i) { const int k = kb + 8 * i; a0 += w[i] * sv[k]; a1 += w[i] * sv[DM + k]; a2 += w[i] * sv[2 * DM + k]; }
#pragma unroll
            for (int m = 8; m < 64; m <<= 1)
#pragma unroll
                for (int q = 0; q < 4; ++q) { a0[q] += __shfl_xor(a0[q], m); a1[q] += __shfl_xor(a1[q], m); a2[q] += __shfl_xor(a2[q], m); }
            if (F.lane < 8) { *(LAS f32x4*)(part + (F.wave * 3 + 0) * 32 + 4 * c4) = a0; *(LAS f32x4*)(part + (F.wave * 3 + 1) * 32 + 4 * c4) = a1; *(LAS f32x4*)(part + (F.wave * 3 + 2) * 32 + 4 * c4) = a2; }
            __syncthreads();
            if (F.tid < 96) { const int s = F.tid >> 5, col = F.tid & 31; float sum = in[I_MODB][layer * 6144 + cg * 32 + col];
#pragma unroll
                for (int wv = 0; wv < 8; ++wv) sum += part[(wv * 3 + s) * 32 + col];
                MOD[((size_t)layer * 3 + s) * 6144 + cg * 32 + col] = sum; }
            __syncthreads();
            if (hn) {
#pragma unroll
                for (int i = 0; i < 16; ++i) w[i] = wn[i]; }
        }
#undef MOD_LOAD
    }
    {
        float* RP = WSP(float, WS_ROPE);
        for (int i = blockIdx.x * (NWAVES * 64) + F.tid; i < 2048; i += F.G * NWAVES * 64) {
            const int pos = i >> 4, f = i & 15; const float inv = powf(10000.f, -(float)f / 16.f); const float ang = (float)pos * inv;
            RP[i] = (float)cos((double)ang); RP[2048 + i] = (float)sin((double)ang); }
    }
    }
    if (PART == 1)
    {
        LAS unsigned char* img = F.lds + F.wave * 16384;
        const int gw = F.vcu * NWAVES + F.wave, NGW = F.G * NWAVES, lane = F.lane;
        float ta[32], tb[32];
        int it = gw;
        if (it < pro::NITEMS) {
            CvtJob ja = pro_cvt_job(F, it), jb = ja; cvt_load(ja, ta, lane);
            for (;;) {
                const int i1 = it + NGW; const bool h1 = i1 < pro::NITEMS;
                if (h1) { jb = pro_cvt_job(F, i1); cvt_load(jb, tb, lane); }
                cvt_finish(ja, ta, img, lane);
                if (!h1) break;
                const int i2 = i1 + NGW; const bool h2 = i2 < pro::NITEMS;
                if (h2) { ja = pro_cvt_job(F, i2); cvt_load(ja, ta, lane); }
                cvt_finish(jb, tb, img, lane);
                if (!h2) break;
                it = i2;
            }
        }
    }
}

constexpr int WY_PREP_CVT = 64 * WY_NCH * 8;
#define WY_BAR() asm volatile("s_waitcnt lgkmcnt(0)\n\ts_barrier" ::: "memory")
__device__ __forceinline__ void p_wy_prep(const Frame& F) {
    const bf16_t* RKV = SCR(bf16_t, S_RKV);
    unsigned char* WYB = SCR(unsigned char, S_WY);
#define WIMG(i) (F.lds + (i) * WY_IMG)
    LAS float* lwS = (LAS float*)(F.lds + 11 * WY_IMG);
    LAS float* gCs = lwS + 64 * 65;
    const int tid = F.tid, lane = F.lane, w = F.wave, fr = lane & 15, fq = lane >> 4;
    const int t = tid >> 3, cc = tid & 7;
    const int mt = w >> 1, nt0 = 2 * (w & 1);
    const size_t PL = (size_t)RT * DM;
    const bf16_t* L1 = SCR(bf16_t, S_L1); const bf16_t* W2 = WSP(bf16_t, W_RWL2);
    LAS float* aS = gCs + 64;
    LAS float* hpS = aS + 64 * 65; LAS f32x4* hpS4 = (LAS f32x4*)hpS;
    u32x4 pfb[7];
#define WY_PREFETCH(item_) do { const int ch_ = (item_) / WY_NCH, c_ = (item_) % WY_NCH, b_ = ch_ >> 5, h_ = (ch_ >> 1) & 15, d_ = ch_ & 1; \
        const size_t row_ = (size_t)(wy_row0(b_, d_, c_) + (d_ ? -t : t)), o_ = row_ * DM + h_ * 64 + 8 * cc; \
        pfb[0] = *(const u32x4*)(RKV + o_); pfb[1] = *(const u32x4*)(RKV + PL + o_); pfb[2] = *(const u32x4*)(RKV + 2 * PL + o_); \
        pfb[3] = *(const u32x4*)(L1 + row_ * 384 + d_ * 64 + 8 * cc); pfb[4] = *(const u32x4*)(L1 + row_ * 384 + 128 + d_ * 64 + 8 * cc); \
        pfb[5] = *(const u32x4*)(W2 + ((size_t)d_ * 1024 + h_ * 64 + t) * 64 + 8 * cc); pfb[6] = *(const u32x4*)(W2 + ((size_t)(2 + d_) * 1024 + h_ * 64 + t) * 64 + 8 * cc); } while (0)
    if ((int)blockIdx.x < 64 * WY_NCH) WY_PREFETCH((int)blockIdx.x);
    for (int item = blockIdx.x; item < 64 * WY_NCH; item += F.G) {
        const int chain = item / WY_NCH, c = item % WY_NCH, b = chain >> 5, h = (chain >> 1) & 15, d = chain & 1;
        unsigned char* ob = WYB + (size_t)item * WY_ITEM;
        float wbv[2], abv[2];
#pragma unroll
        for (int q = 0; q < 2; ++q) { const int ch = 16 * (nt0 + q) + fr; wbv[q] = F.in[I_RWW0][d * DM + h * 64 + ch]; abv[q] = F.in[I_RWA0][d * DM + h * 64 + ch]; }
        if (tid < 48) { const int q_ = tid >> 4; hpS4[tid] = *(const f32x4*)(F.in[q_ == 0 ? I_RWKK : (q_ == 1 ? I_RWKA : I_RWRK)] + h * 64 + 4 * (tid & 15)); }
        const CvtJob cj = moe_cvt_job(F, item * 8 + w); float ctv[32];
        cvt_load(cj, ctv, lane);
        WY_BAR();
        float r8[8], k8[8], v8[8], lw8[8], a8[8];
        unpack8(pfb[0], r8); unpack8(pfb[1], k8); unpack8(pfb[2], v8);
        *(LAS u32x4*)(WIMG(6) + t * WY_LD + cc * 16) = pfb[3]; *(LAS u32x4*)(WIMG(7) + t * WY_LD + cc * 16) = pfb[4];
        *(LAS u32x4*)(WIMG(8) + t * WY_LD + cc * 16) = pfb[5]; *(LAS u32x4*)(WIMG(9) + t * WY_LD + cc * 16) = pfb[6];
        WY_BAR();
        { f32x4 la[2] = {(f32x4){0.f, 0.f, 0.f, 0.f}, (f32x4){0.f, 0.f, 0.f, 0.f}}, aa[2] = {(f32x4){0.f, 0.f, 0.f, 0.f}, (f32x4){0.f, 0.f, 0.f, 0.f}};
          wy_mm2<false, false>(la, WIMG(6), WIMG(8), mt, nt0, lane); wy_mm2<false, false>(aa, WIMG(7), WIMG(9), mt, nt0, lane);
#pragma unroll
          for (int q = 0; q < 2; ++q) { const int ch = 16 * (nt0 + q) + fr; const float wb = wbv[q], ab = abv[q];
#pragma unroll
              for (int i = 0; i < 4; ++i) { const int tt = 16 * mt + 4 * fq + i; lwS[tt * 65 + ch] = -0.606531f * sigmoidf_(la[q][i] + wb); aS[tt * 65 + ch] = sigmoidf_(aa[q][i] + ab); } } }
        WY_BAR();
#pragma unroll
        for (int q = 0; q < 8; ++q) { lw8[q] = lwS[t * 65 + 8 * cc + q]; a8[q] = aS[t * 65 + 8 * cc + q]; }
        { const int row = wy_row0(b, d, c) + (d ? -t : t);
          float p1 = 0.f, p2 = 0.f;
#pragma unroll
          for (int q = 0; q < 8; ++q) { const float rkk = r8[q] * hpS[128 + 8 * cc + q] * k8[q]; p1 += rkk; p2 += rkk * hpS[64 + 8 * cc + q] * (a8[q] - 1.f); }
          p1 = red8(p1); p2 = red8(p2);
          if (cc == 0) { SCR(float, S_BON2)[((size_t)d * RT + row) * 16 + h] = p2; if (d == 0) SCR(float, S_AD)[(size_t)row * 16 + h] = p1; } }
        WY_BAR();
#pragma unroll
        for (int q = 0; q < 8; ++q) { const int ch = 8 * w + q; float x = lwS[lane * 65 + ch];
            x += dpp0_f<0x111>(x); x += dpp0_f<0x112>(x); x += dpp0_f<0x114>(x); x += dpp0_f<0x118>(x);
            const float t0 = __builtin_bit_cast(float, __builtin_amdgcn_readlane(__builtin_bit_cast(int, x), 15)), t1 = __builtin_bit_cast(float, __builtin_amdgcn_readlane(__builtin_bit_cast(int, x), 31)),
                        t2 = __builtin_bit_cast(float, __builtin_amdgcn_readlane(__builtin_bit_cast(int, x), 47));
            x += (fq == 1) ? t0 : (fq == 2) ? (t0 + t1) : (fq == 3) ? ((t0 + t1) + t2) : 0.f;
            lwS[lane * 65 + ch] = x; }
        WY_BAR();
        {
            float kx[8], ss = 0.f;
#pragma unroll
            for (int q = 0; q < 8; ++q) { kx[q] = k8[q] * hpS[8 * cc + q]; ss += kx[q] * kx[q]; }
            const float inv = 1.0f / fmaxf(sqrtf(red8(ss)), 1e-12f);
            float oA[8], oBt[8], oKt[8], oRt[8], oBc[8], oKc[8];
#pragma unroll
            for (int q = 0; q < 8; ++q) { const float lg = lwS[t * 65 + 8 * cc + q], lgC = lwS[63 * 65 + 8 * cc + q];
                const float kkv = kx[q] * inv, bv = kkv * a8[q], kd = k8[q] * (1.f + (a8[q] - 1.f) * hpS[64 + 8 * cc + q]);
                const float ginv = __expf(-lg), gc = __expf(lgC - lg);
                oA[q] = __expf(lg - lw8[q]) * kkv; oBt[q] = bv * ginv; oKt[q] = kd * ginv; oRt[q] = __expf(lg) * r8[q]; oBc[q] = bv * gc; oKc[q] = kd * gc;
                if (t == 63) gCs[8 * cc + q] = __expf(lgC); }
            *(LAS u32x4*)(WIMG(0) + t * WY_LD + cc * 16) = pack8(oA);  *(LAS u32x4*)(WIMG(1) + t * WY_LD + cc * 16) = pack8(oBt);
            *(LAS u32x4*)(WIMG(2) + t * WY_LD + cc * 16) = pack8(oKt); *(LAS u32x4*)(WIMG(3) + t * WY_LD + cc * 16) = pack8(oRt);
            *(LAS u32x4*)(WIMG(4) + t * WY_LD + cc * 16) = pack8(oBc); *(LAS u32x4*)(WIMG(5) + t * WY_LD + cc * 16) = pack8(oKc);
#pragma unroll
            for (int q = 0; q < 8; ++q) { const int vv = 8 * cc + q;
                *(bf16_t*)(ob + (32 + 2 * (vv >> 4) + (t >> 5)) * 1024 + (((t >> 3) & 3) * 16 + (vv & 15)) * 16 + (t & 7) * 2) = (bf16_t)f2bf(v8[q]); }
        }
        WY_BAR();
        if (item + F.G < 64 * WY_NCH) WY_PREFETCH(item + F.G);
        f32x4 nb[2], nk[2], mbr[2], mkr[2], Treg[2];
#pragma unroll
        for (int q = 0; q < 2; ++q) { nb[q] = (f32x4){0.f, 0.f, 0.f, 0.f}; nk[q] = nb[q]; mbr[q] = nb[q]; mkr[q] = nb[q]; }
        wy_mm2<false, false>(nb, WIMG(1), WIMG(0), mt, nt0, lane); wy_mm2<false, false>(nk, WIMG(2), WIMG(0), mt, nt0, lane);
        wy_mm2<false, false>(mbr, WIMG(1), WIMG(3), mt, nt0, lane); wy_mm2<false, false>(mkr, WIMG(2), WIMG(3), mt, nt0, lane);
#pragma unroll
        for (int q = 0; q < 2; ++q)
#pragma unroll
            for (int i = 0; i < 4; ++i) { const int j = 16 * mt + 4 * fq + i, tt = 16 * (nt0 + q) + fr;
                nb[q][i] = (j < tt) ? -nb[q][i] : 0.f; nk[q][i] = (j < tt) ? nk[q][i] : 0.f; mbr[q][i] = (j <= tt) ? mbr[q][i] : 0.f; mkr[q][i] = (j <= tt) ? mkr[q][i] : 0.f;
                Treg[q][i] = nb[q][i] + ((j == tt) ? 1.f : 0.f); }
        WY_BAR();
        wy_put2(WIMG(8), nb, mt, nt0, lane); wy_put2(WIMG(6), nk, mt, nt0, lane); wy_put2(WIMG(7), mbr, mt, nt0, lane); wy_put2(WIMG(2), Treg, mt, nt0, lane);
        WY_BAR();
        { f32x4 p2[2] = {(f32x4){0.f, 0.f, 0.f, 0.f}, (f32x4){0.f, 0.f, 0.f, 0.f}};
          wy_mm2<true, false>(p2, WIMG(8), WIMG(8), mt, nt0, lane); wy_put2(WIMG(9), p2, mt, nt0, lane); }
        WY_BAR();
        int ts_ = 2, ps_ = 9, td_ = 1, pd_ = 8;
#pragma unroll 1
        for (int it = 1; it <= 5; ++it) {
            f32x4 tp[2] = {(f32x4){0.f, 0.f, 0.f, 0.f}, (f32x4){0.f, 0.f, 0.f, 0.f}}, pp[2] = {(f32x4){0.f, 0.f, 0.f, 0.f}, (f32x4){0.f, 0.f, 0.f, 0.f}};
            wy_mm2<true, false>(tp, WIMG(ts_), WIMG(ps_), mt, nt0, lane);
            if (it < 5) wy_mm2<true, false>(pp, WIMG(ps_), WIMG(ps_), mt, nt0, lane);
            Treg[0] += tp[0]; Treg[1] += tp[1];
            wy_put2(WIMG(td_), Treg, mt, nt0, lane);
            if (it < 5) wy_put2(WIMG(pd_), pp, mt, nt0, lane);
            WY_BAR();
            int tmp = ts_; ts_ = td_; td_ = tmp; tmp = ps_; ps_ = pd_; pd_ = tmp;
        }
        { f32x4 p1[2] = {(f32x4){0.f, 0.f, 0.f, 0.f}, (f32x4){0.f, 0.f, 0.f, 0.f}}, p2_[2] = {(f32x4){0.f, 0.f, 0.f, 0.f}, (f32x4){0.f, 0.f, 0.f, 0.f}};
          wy_mm2<true, false>(p1, WIMG(0), WIMG(1), mt, nt0, lane); wy_mm2<true, false>(p2_, WIMG(6), WIMG(1), mt, nt0, lane);
          wy_put2(WIMG(9), p1, mt, nt0, lane); wy_put2(WIMG(10), p2_, mt, nt0, lane); }
        WY_BAR();
        {
            f32x4 q1[2] = {(f32x4){0.f, 0.f, 0.f, 0.f}, (f32x4){0.f, 0.f, 0.f, 0.f}}, q2[2] = {q1[0], q1[0]}, e1[2] = {q1[0], q1[0]}, e2[2] = {q1[0], q1[0]};
            wy_mm2<true, false>(q1, WIMG(9), WIMG(7), mt, nt0, lane); wy_mm2<true, false>(q2, WIMG(10), WIMG(7), mt, nt0, lane);
            wy_mm2<true, true>(e1, WIMG(9), WIMG(4), mt, nt0, lane); wy_mm2<true, true>(e2, WIMG(10), WIMG(4), mt, nt0, lane);
#pragma unroll
            for (int q = 0; q < 2; ++q) {
                const int nt = nt0 + q, n = 16 * nt + fr;
                float o1[4], o2[4], o3[4], o4[4];
#pragma unroll
                for (int i = 0; i < 4; ++i) { const int m = 16 * mt + 4 * fq + i;
                    o1[i] = bf2f(*(LAS const bf16_t*)(WIMG(3) + n * WY_LD + m * 2)) - q1[q][i];
                    o2[i] = mkr[q][i] - q2[q][i];
                    o3[i] = ((m == n) ? gCs[m] : 0.f) - e1[q][i];
                    o4[i] = bf2f(*(LAS const bf16_t*)(WIMG(5) + m * WY_LD + n * 2)) - e2[q][i]; }
                const int offS = (2 * nt + (mt >> 1)) * 1024 + (fq * 16 + fr) * 16 + (mt & 1) * 8;
                const int offC = (2 * nt + (mt >> 1)) * 1024 + ((2 * (mt & 1) + (fq >> 1)) * 16 + fr) * 16 + (fq & 1) * 8;
                u32x2 w1, w2, w3, w4; w1.x = pk2(o1[0], o1[1]); w1.y = pk2(o1[2], o1[3]); w2.x = pk2(o2[0], o2[1]); w2.y = pk2(o2[2], o2[3]);
                w3.x = pk2(o3[0], o3[1]); w3.y = pk2(o3[2], o3[3]); w4.x = pk2(o4[0], o4[1]); w4.y = pk2(o4[2], o4[3]);
                *(u32x2*)(ob + offS) = w1; *(u32x2*)(ob + 8 * 1024 + offC) = w2; *(u32x2*)(ob + 16 * 1024 + offS) = w3; *(u32x2*)(ob + 24 * 1024 + offC) = w4;
            }
        }
        { LAS unsigned char* cimg = F.lds + (w < 6 ? w * 4608 : 6 * WY_IMG + (w - 6) * 4608);
          cvt_finish(cj, ctv, cimg, lane);
          const int extra = WY_PREP_CVT + item * 8 + w;
          if (extra < 16 * (N_MOEIN_IT + N_MOEOUT_IT)) { const CvtJob cj2 = moe_cvt_job(F, extra); cvt_load(cj2, ctv, lane); cvt_finish(cj2, ctv, cimg, lane); } }
    }
#undef WIMG
#undef WY_PREFETCH
}
__device__ __forceinline__ unsigned lds_ld_u32(unsigned addr) { unsigned v; asm volatile("ds_read_b32 %0, %1\n\ts_waitcnt lgkmcnt(0)" : "=v"(v) : "v"(addr) : "memory"); return v; }
__device__ __forceinline__ void lds_st_u32(unsigned addr, unsigned val) { asm volatile("ds_write_b32 %0, %1" :: "v"(addr), "v"(val) : "memory"); }
__device__ __forceinline__ void p_wy_seq(const Frame& F) {
    volatile LAS unsigned* flg = (volatile LAS unsigned*)(F.lds + LDSCTL_OFF + 128);
    if (F.tid < 8) flg[F.tid] = 0u;
    __syncthreads();
    if (F.wave >= 4) return;
    const unsigned fa = (unsigned)(uintptr_t)(F.lds + LDSCTL_OFF + 128);
    if (F.wave == 3) {
        constexpr int WY_PF = 8;
        const unsigned char* WYB_ = SCR(unsigned char, S_WY); int gb = 0;
        for (int unit = F.vcu; unit < 256; unit += F.G, gb += WY_NCH) {
            const int chain = unit >> 2, vb = unit & 3;
            const unsigned char* pb = WYB_ + (size_t)chain * WY_NCH * WY_ITEM + (size_t)(vb * 80 + F.lane) * 128;
            for (int c = 0; c < WY_NCH; ++c) {
                for (unsigned sp = 0; (int)lds_ld_u32(fa + 16) < gb + c - WY_PF && sp < (1u << 22); ++sp) __builtin_amdgcn_s_sleep(4);
                const unsigned char* g_ = pb + (size_t)c * WY_ITEM; unsigned t0_, t1_;
                asm volatile("global_load_dword %0, %1, off" : "=v"(t0_) : "v"(g_) : "memory");
                if (F.lane < 16) asm volatile("global_load_dword %0, %1, off" : "=v"(t1_) : "v"(g_ + 64 * 128) : "memory");
            }
        }
        asm volatile("s_waitcnt vmcnt(0)" ::: "memory");
        return;
    }
    const unsigned char* WYB = SCR(unsigned char, S_WY); float* YY = SCR(float, S_YY);
    const int lane = F.lane, fr = lane & 15, fq = lane >> 4;
    int gbase = 0;
    for (int unit = F.vcu; unit < 256; unit += F.G, gbase += WY_NCH) {
        const int chain = unit >> 2, vb = unit & 3, b = chain >> 5, h = (chain >> 1) & 15, d = chain & 1;
        const unsigned char* ib = WYB + (size_t)chain * WY_NCH * WY_ITEM + lane * 16;
        if (F.wave >= 1) {
            const int lw = F.wave - 1; int prev = -1;
            for (int c = lw; c < WY_NCH; c += 2) {
                const int gc = gbase + c;
                for (unsigned sp = 0; (int)lds_ld_u32(fa + 16) < gc - 3 && sp < (1u << 22); ++sp) __builtin_amdgcn_s_sleep(1);
                { const unsigned char* g_ = ib + (size_t)c * WY_ITEM; LAS unsigned char* l_ = F.lds + (gc & 3) * 34816;
#pragma unroll
                  for (int f = 0; f < 32; ++f) __builtin_amdgcn_global_load_lds((const unsigned*)(g_ + f * 1024), (LAS unsigned*)(l_ + f * 1024), 16, 0, 0);
#pragma unroll
                  for (int f = 0; f < 2; ++f) __builtin_amdgcn_global_load_lds((const unsigned*)(g_ + (32 + 2 * vb + f) * 1024), (LAS unsigned*)(l_ + (32 + f) * 1024), 16, 0, 0); }
                if (prev >= 0) { asm volatile("s_waitcnt vmcnt(34)" ::: "memory"); if (lane == 0) lds_st_u32(fa + 4 * (prev & 3), (unsigned)(prev + 1)); }
                prev = gc;
            }
            asm volatile("s_waitcnt vmcnt(0)" ::: "memory");
            if (prev >= 0 && lane == 0) lds_st_u32(fa + 4 * (prev & 3), (unsigned)(prev + 1));
            continue;
        }
        float* yP = YY + (size_t)d * RT * DM + h * 64 + vb * 16 + fr;
        f32x4 S[4];
#pragma unroll
        for (int k = 0; k < 4; ++k) S[k] = (f32x4){0.f, 0.f, 0.f, 0.f};
        for (int c = 0; c < WY_NCH; ++c) {
            const int gc = gbase + c;
            for (unsigned sp = 0; lds_ld_u32(fa + 4 * (gc & 3)) != (unsigned)(gc + 1) && sp < (1u << 24); ++sp) __builtin_amdgcn_s_sleep(0);
            asm volatile("" ::: "memory");
            LAS const unsigned char* lb = F.lds + (gc & 3) * 34816 + lane * 16;
            bf16x8 sf[2], vf[2];
#pragma unroll
            for (int kk = 0; kk < 2; ++kk) { u32x4 pw; pw.x = pk2(S[2 * kk][0], S[2 * kk][1]); pw.y = pk2(S[2 * kk][2], S[2 * kk][3]); pw.z = pk2(S[2 * kk + 1][0], S[2 * kk + 1][1]); pw.w = pk2(S[2 * kk + 1][2], S[2 * kk + 1][3]);
                sf[kk] = __builtin_bit_cast(bf16x8, pw); vf[kk] = *(LAS const bf16x8*)(lb + (32 + kk) * 1024); }
            const int row0 = wy_row0(b, d, c), dir = d ? -1 : 1;
            bf16x8 fg[32];
#pragma unroll
            for (int f = 0; f < 32; ++f) fg[f] = *(LAS const bf16x8*)(lb + f * 1024);
            asm volatile("s_waitcnt lgkmcnt(0)" ::: "memory");
            if (lane == 0) lds_st_u32(fa + 16, (unsigned)(gc + 1));
            __builtin_amdgcn_sched_barrier(0);
            f32x4 Sn[4], yv[4];
#pragma unroll
            for (int k = 0; k < 4; ++k) { Sn[k] = (f32x4){0.f, 0.f, 0.f, 0.f}; yv[k] = Sn[k]; }
#pragma unroll
            for (int st = 0; st < 4; ++st) {
                const bf16x8 op = (st & 1) ? vf[st >> 1] : sf[st >> 1];
#pragma unroll
                for (int kt = 0; kt < 4; ++kt) Sn[kt] = __builtin_amdgcn_mfma_f32_16x16x32_bf16(fg[((st & 1) ? 24 : 16) + 2 * kt + (st >> 1)], op, Sn[kt], 0, 0, 0);
#pragma unroll
                for (int mt = 0; mt < 4; ++mt) yv[mt] = __builtin_amdgcn_mfma_f32_16x16x32_bf16(fg[((st & 1) ? 8 : 0) + 2 * mt + (st >> 1)], op, yv[mt], 0, 0, 0);
            }
#pragma unroll
            for (int mt = 0; mt < 4; ++mt)
#pragma unroll
                for (int i = 0; i < 4; ++i) yP[(size_t)(row0 + dir * (16 * mt + 4 * fq + i)) * DM] = yv[mt][i];
#pragma unroll
            for (int kt = 0; kt < 4; ++kt) S[kt] = Sn[kt];
        }
    }
}

__device__ __forceinline__ float sum4(const f32x4 v) { return (v[0] + v[1]) + (v[2] + v[3]); }
__device__ __forceinline__ f32x4 ld_bf4(const bf16_t* p) { const u32x2 w = *(const u32x2*)p; return (f32x4){bflo(w.x), bfhi(w.x), bflo(w.y), bfhi(w.y)}; }
__device__ __forceinline__ void p_rw_combine(const Frame& F) {
    const bf16_t* RKV = SCR(bf16_t, S_RKV); const float* BON1 = SCR(float, S_AD); const float* BON2 = SCR(float, S_BON2); const float* YY = SCR(float, S_YY); const bf16_t* GG = SCR(bf16_t, S_GG); bf16_t* OO = SCR(bf16_t, S_OO);
    const int gw = F.vcu * NWAVES + F.wave, NGW = F.G * NWAVES, lane = F.lane;
    const size_t PL = (size_t)RT * DM;
    LAS float* PR = (LAS float*)F.lds;
    for (int i = F.tid; i < 4 * DM; i += NWAVES * 64) { const int q = i >> 10, c = i & 1023; PR[i] = F.in[q == 0 ? I_RWKA : (q == 1 ? I_RWRK : (q == 2 ? I_RWLNG : I_RWLNB))][c]; }
    __syncthreads();
    auto bf4 = [](const u32x2 w) { return (f32x4){bflo(w.x), bfhi(w.x), bflo(w.y), bfhi(w.y)}; };
    struct RowIn { f32x4 y0[4], y1[4]; u32x2 v_[4], gg[4]; float b1[4], b20[4], b21[4]; };
    auto rload = [&](RowIn& x, int row) {
#pragma unroll
        for (int j = 0; j < 4; ++j) {
            const size_t o = (size_t)row * DM + 256 * j + 4 * lane; const int hd = 4 * j + (lane >> 4);
            x.y0[j] = __builtin_nontemporal_load((const f32x4*)(YY + o)); x.y1[j] = __builtin_nontemporal_load((const f32x4*)(YY + PL + o));
            x.v_[j] = __builtin_nontemporal_load((const u32x2*)(RKV + 2 * PL + o));
            x.gg[j] = __builtin_nontemporal_load((const u32x2*)(GG + o));
            x.b1[j] = BON1[(size_t)row * 16 + hd]; x.b20[j] = BON2[(size_t)row * 16 + hd]; x.b21[j] = BON2[((size_t)RT + row) * 16 + hd]; }
    };
    auto process = [&](const RowIn& x, int row) {
#pragma unroll
        for (int j = 0; j < 4; ++j) {
            const int c = 256 * j + 4 * lane; const size_t o = (size_t)row * DM + c;
            const f32x4 y = x.y0[j] + x.y1[j];
            const f32x4 v = bf4(x.v_[j]);
            const f32x4 lg = *(LAS const f32x4*)(PR + 2 * DM + c), lb = *(LAS const f32x4*)(PR + 3 * DM + c);
            const float mu = red16(sum4(y)) * (1.f / 64.f); const f32x4 dy = y - mu;
            const float var = red16(sum4(dy * dy)) * (1.f / 64.f);
            const float bon = x.b1[j] + 0.5f * (x.b20[j] + x.b21[j]);
            const float rs = __builtin_amdgcn_rsqf(var + 64e-5f);
            const f32x4 res = dy * rs * lg + lb + v * bon;
            u32x2 w_; w_.x = pk2(res[0] * bflo(x.gg[j].x), res[1] * bfhi(x.gg[j].x)); w_.y = pk2(res[2] * bflo(x.gg[j].y), res[3] * bfhi(x.gg[j].y));
            *(u32x2*)(OO + o) = w_;
        }
    };
    RowIn ra, rb;
    int row = gw;
    if (row < RT) rload(ra, row);
    for (; row < RT; row += 2 * NGW) {
        if (row + NGW < RT) rload(rb, row + NGW);
        process(ra, row);
        if (row + NGW >= RT) break;
        if (row + 2 * NGW < RT) rload(ra, row + 2 * NGW);
        process(rb, row + NGW);
    }
}

__device__ __forceinline__ void p_pool(const Frame& F, bf16_t* Pout) {
    const bf16_t* H = WSP(bf16_t, WS_H);
    constexpr int SR = 22, HALO = 8, TR = SR + 2 * HALO, NSTRIP = RT / SR, NLD = (TR * 128 + NWAVES * 64 - 1) / (NWAVES * 64);
    static_assert(RT % SR == 0, "strip rows");
    LAS unsigned char* tile = F.lds;
    const int tid = F.tid, cg = tid & 127, rq = tid >> 7, c = cg * 8, hw = 1 << (cg >> 5);
    u32x4 pf[NLD];
#define POOL_LOAD(strip_) do { const int rb_ = (strip_) * SR - HALO; _Pragma("unroll") for (int k = 0; k < NLD; ++k) { const int idx = tid + k * (NWAVES * 64), j = idx >> 7, ab = rb_ + j; \
        pf[k] = (j < TR && ab >= 0 && ab < RT) ? *(const u32x4*)(H + (size_t)ab * DM + (idx & 127) * 8) : (u32x4){0u, 0u, 0u, 0u}; } } while (0)
    int strip = blockIdx.x;
    if (strip < NSTRIP) POOL_LOAD(strip);
    for (; strip < NSTRIP; strip += F.G) {
        __syncthreads();
#pragma unroll
        for (int k = 0; k < NLD; ++k) { const int idx = tid + k * (NWAVES * 64); if ((idx >> 7) < TR) *(LAS u32x4*)(tile + (size_t)idx * 16) = pf[k]; }
        __syncthreads();
        if (strip + F.G < NSTRIP) POOL_LOAD(strip + F.G);
        const int r0 = strip * SR, rb = r0 - HALO;
        for (int r = rq * 6; r < (rq * 6 + 6 < SR ? rq * 6 + 6 : SR); ++r) {
            const int row = r0 + r;
            const int start = row < RC ? (row & ~(TC - 1)) : RC + ((row - RC) & ~(TL - 1)), len = row < RC ? TC : TL, t = row - start;
            int lo = t - hw; lo = lo < 0 ? 0 : lo; int hi = t + hw; hi = hi > len ? len : hi;
            float acc[8], x[8];
#pragma unroll
            for (int k = 0; k < 8; ++k) acc[k] = 0.f;
            for (int tt = lo; tt < hi; ++tt) { unpack8(*(LAS const u32x4*)(tile + (size_t)(start + tt - rb) * 2048 + cg * 16), x);
#pragma unroll
                for (int k = 0; k < 8; ++k) acc[k] += x[k]; }
            const float inv = 1.f / (float)(hi - lo);
            unpack8(*(LAS const u32x4*)(tile + (size_t)(row - rb) * 2048 + cg * 16), x);
            float o[8];
#pragma unroll
            for (int k = 0; k < 8; ++k) o[k] = acc[k] * inv - x[k];
            *(u32x4*)(Pout + (size_t)row * DM + c) = pack8(o);
        }
    }
#undef POOL_LOAD
}

__device__ __forceinline__ void qk_head8(float (&x)[8], const f32x4 g0, const f32x4 g1, LAS const float* RP, int cc, bool lat, int t, float outscale) {
    float ss = 0.f;
#pragma unroll
    for (int k = 0; k < 8; ++k) ss += x[k] * x[k];
    const float rstd = __builtin_amdgcn_rsqf(red8(ss) * (1.f / 64.f) + NORM_EPS);
#pragma unroll
    for (int k = 0; k < 4; ++k) { x[k] *= rstd * g0[k]; x[4 + k] *= rstd * g1[k]; }
    if (lat) {
        const int pos = (cc < 4) ? (t >> 6) : (t & 63); const int f0 = (cc & 1) * 8;
        const f32x4 c0 = *(LAS const f32x4*)(RP + pos * 16 + f0), c1 = *(LAS const f32x4*)(RP + pos * 16 + f0 + 4), s0 = *(LAS const f32x4*)(RP + 2048 + pos * 16 + f0), s1 = *(LAS const f32x4*)(RP + 2048 + pos * 16 + f0 + 4);
        const bool firsthalf = ((cc >> 1) & 1) == 0;
#pragma unroll
        for (int k = 0; k < 8; ++k) { const float other = dpp_f<0x4E>(x[k]); const float cs = k < 4 ? c0[k] : c1[k - 4], sn = k < 4 ? s0[k] : s1[k - 4];
            x[k] = firsthalf ? x[k] * cs - other * sn : x[k] * cs + other * sn; }
    }
#pragma unroll
    for (int k = 0; k < 8; ++k) x[k] *= outscale;
}
__device__ __forceinline__ void p_qkrope(const Frame& F) {
    const bf16_t* QKV = SCR(bf16_t, S_QKV); bf16_t* KB_ = SCR(bf16_t, S_KB); bf16_t* VB_ = SCR(bf16_t, S_VB);
    LAS float* RPl = (LAS float*)F.lds;
    for (int i = F.tid; i < 4096; i += NWAVES * 64) RPl[i] = WSP(float, WS_ROPE)[i];
    const int gw = F.vcu * NWAVES + F.wave, NGW = F.G * NWAVES, lane = F.lane, cc = lane & 7;
    const f32x4 g0 = *(const f32x4*)(F.in[I_ATKG] + 8 * cc), g1 = *(const f32x4*)(F.in[I_ATKG] + 8 * cc + 4);
    __syncthreads();
    auto ldrow = [&](int row) { return __builtin_nontemporal_load((const u32x4*)(QKV + (size_t)row * 1536) + 128 + lane); };
    auto process = [&](const u32x4 raw, int row) {
        const bool lat = row >= RC; const int b = lat ? (row - RC) >> 13 : row >> 8, t = lat ? (row - RC) & (TL - 1) : row & (TC - 1);
        const size_t kvrow = (size_t)b * KVL + (lat ? TC + t : t);
        float x[8]; unpack8(raw, x);
        qk_head8(x, g0, g1, RPl, cc, lat, t, 1.0f);
        if (lane < 32) *(u32x4*)(KB_ + kvrow * 256 + lane * 8) = pack8(x);
        else *(u32x4*)(VB_ + kvrow * 256 + (lane - 32) * 8) = raw;
    };
    u32x4 b0 = (u32x4){0u, 0u, 0u, 0u}, b1 = b0, b2 = b0, b3 = b0;
    int row = gw;
    if (row < RT) b0 = ldrow(row);
    if (row + NGW < RT) b1 = ldrow(row + NGW);
    if (row + 2 * NGW < RT) b2 = ldrow(row + 2 * NGW);
    for (; row < RT; row += 4 * NGW) {
        if (row + 3 * NGW < RT) b3 = ldrow(row + 3 * NGW);
        process(b0, row);
        if (row + NGW >= RT) break;
        if (row + 4 * NGW < RT) b0 = ldrow(row + 4 * NGW);
        process(b1, row + NGW);
        if (row + 2 * NGW >= RT) break;
        if (row + 5 * NGW < RT) b1 = ldrow(row + 5 * NGW);
        process(b2, row + 2 * NGW);
        if (row + 3 * NGW >= RT) break;
        if (row + 6 * NGW < RT) b2 = ldrow(row + 6 * NGW);
        process(b3, row + 3 * NGW);
    }
}

__device__ __forceinline__ void p_ctx_fix(const Frame& F, const float* gate, const float* ssq, int xin_inputs, int S) {
    const float* PART = SCR(float, S_PARTC); bf16_t* XW = WSP(bf16_t, WS_XW);
    const int gw = F.vcu * NWAVES + F.wave, NGW = F.G * NWAVES, lane = F.lane;
    for (int row = gw; row < RC; row += NGW) {
        float rs = 1.f;
        if (ssq) { const f32x4 q = *(const f32x4*)(ssq + (size_t)row * 4); rs = __builtin_amdgcn_rsqf(((q[0] + q[1]) + (q[2] + q[3])) * (1.f / 2048.f) + NORM_EPS); }
#pragma unroll
        for (int j = 0; j < 4; ++j) { const int c = 4 * lane + 256 * j; f32x4 a = (f32x4){0.f, 0.f, 0.f, 0.f};
            for (int ks = 0; ks < S; ++ks) a += *(const f32x4*)(PART + ((size_t)ks * RC + row) * DM + c);
            const f32x4 xi = xin_inputs ? *(const f32x4*)(F.in[I_CTX] + (size_t)row * DM + c) : ld_x4(XW + (size_t)row * DM + c);
            st_x4(XW + (size_t)row * DM + c, xi + *(const f32x4*)(gate + c) * a * rs); }
    }
}
__device__ __forceinline__ void moe_starts(const Frame& F, int (&ts)[NEXP]) {
    const int* CNT = WSP(int, WS_CNT); int acc = 0;
#pragma unroll
    for (int e = 0; e < NEXP; ++e) { acc += (CNT[e] + 255) >> 8; ts[e] = acc; }
}
__device__ __forceinline__ int seg_start(const int (&ts)[NEXP], int e) { int r = 0;
#pragma unroll
    for (int j = 0; j < NEXP - 1; ++j) r = (e == j + 1) ? ts[j] : r;
    return r; }
__device__ __forceinline__ void p_moe_gather(const Frame& F, int row_lo) {
    const int* SEL = WSP(int, WS_SEL); int* POS = WSP(int, WS_POS); int* CNT = WSP(int, WS_CNT); const bf16_t* H = WSP(bf16_t, WS_H); bf16_t* AG = SCR(bf16_t, S_AG);
    LAS int* red = (LAS int*)F.lds;
    const int nrows = RT - row_lo, per = (nrows + F.G - 1) / F.G, r_lo = row_lo + (int)blockIdx.x * per, r_hi = (r_lo + per < RT) ? r_lo + per : RT;
    int ct[8], cb_[8];
#pragma unroll
    for (int e = 0; e < 8; ++e) { ct[e] = 0; cb_[e] = 0; }
    for (int r = row_lo + F.tid; r < RT; r += NWAVES * 64) { const int s_ = SEL[r]; const int e0 = s_ & 255, e1 = s_ >> 8; const int before = r < r_lo ? 1 : 0;
#pragma unroll
        for (int e = 0; e < 8; ++e) { const int hit = (e0 == e) + (e1 == e); ct[e] += hit; cb_[e] += before * hit; } }
    __syncthreads();
#pragma unroll
    for (int e = 0; e < 8; ++e) { const float a = wave_sum((float)ct[e]), b = wave_sum((float)cb_[e]);
        if (F.lane == 0) { red[F.wave * 16 + e] = (int)a; red[F.wave * 16 + 8 + e] = (int)b; } }
    __syncthreads();
    if (F.tid < 16) { int a = 0;
#pragma unroll
        for (int w = 0; w < NWAVES; ++w) a += red[w * 16 + F.tid];
        red[8192 + F.tid] = a; }
    __syncthreads();
    int ts[NEXP]; { int acc = 0;
#pragma unroll
        for (int e = 0; e < NEXP; ++e) { acc += (red[8192 + e] + 255) >> 8; ts[e] = acc; } }
    if (blockIdx.x == 0 && F.tid < 8) CNT[F.tid] = red[8192 + F.tid];
    LAS int* slots = red + 8192 + 64;
    if (F.wave == 0) {
        int base[8];
#pragma unroll
        for (int e = 0; e < 8; ++e) base[e] = red[8192 + 8 + e];
        for (int ch = 0; r_lo + ch < r_hi; ch += 64) {
            const int r = r_lo + ch + F.lane; const bool valid = r < r_hi; const int s_ = valid ? SEL[r] : 0xffff; const int e0 = s_ & 255, e1 = (s_ >> 8) & 255;
            int p0 = 0, p1 = 0, g0 = 0, g1 = 0;
#pragma unroll
            for (int e = 0; e < 8; ++e) { const unsigned long long m = __ballot((e0 == e) || (e1 == e)); const int pre = base[e] + __popcll(m & ((1ull << F.lane) - 1ull));
                if (e0 == e) { p0 = pre; g0 = seg_start(ts, e); } if (e1 == e) { p1 = pre; g1 = seg_start(ts, e); } base[e] += __popcll(m); }
            if (valid) { POS[2 * r] = p0; POS[2 * r + 1] = p1; slots[2 * (ch + F.lane)] = g0 * 256 + p0; slots[2 * (ch + F.lane) + 1] = g1 * 256 + p1; }
        }
    }
    __syncthreads();
    const int nb = r_hi - r_lo;
    for (int i0 = F.wave * 4; i0 < nb; i0 += NWAVES * 4) {
        u32x4 a[4][2];
#pragma unroll
        for (int u = 0; u < 4; ++u) if (i0 + u < nb) { const u32x4* src = (const u32x4*)(H + (size_t)(r_lo + i0 + u) * DM); a[u][0] = src[F.lane]; a[u][1] = src[64 + F.lane]; }
#pragma unroll
        for (int u = 0; u < 4; ++u) if (i0 + u < nb) {
#pragma unroll
            for (int j = 0; j < 2; ++j) { u32x4* dst = (u32x4*)(AG + (size_t)slots[2 * (i0 + u) + j] * DM); dst[F.lane] = a[u][0]; dst[64 + F.lane] = a[u][1]; } }
    }
}
__device__ __forceinline__ f32x4 moe_y(const bf16_t* YS, const float* PARTM, size_t so, int nsl, int c) {
    if (so < (size_t)128 * 256 * DM) { const u32x2 y = *(const u32x2*)(YS + so + c); return (f32x4){bflo(y.x), bfhi(y.x), bflo(y.y), bfhi(y.y)}; }
    f32x4 a = (f32x4){0.f, 0.f, 0.f, 0.f}; const float* p = PARTM + (so - (size_t)128 * 256 * DM) + c;
    for (int ks = 0; ks < nsl; ++ks) a += *(const f32x4*)(p + (size_t)ks * PARTM_ROWS * 1024);
    return a;
}
template <int MODE>
__device__ __forceinline__ void p_moe_combine(const Frame& F, int layer, int row_lo) {
    const int* SEL = WSP(int, WS_SEL); const int* POS = WSP(int, WS_POS); const float* WTS = WSP(float, WS_WTS); const bf16_t* YS = SCR(bf16_t, S_YS);
    bf16_t* XW = WSP(bf16_t, WS_XW); bf16_t* H = WSP(bf16_t, WS_H);
    const float* MOD = WSP(float, WS_MOD) + (size_t)layer * 3 * 6144; const float* MODN = MOD + 3 * 6144;
    LAS float* GSw = (LAS float*)(F.lds + NL_GS); LAS float* GT = (LAS float*)(F.lds + NL_X);
    if (MODE == 0) stage_norm_params(F, F.in[I_N1G] + (layer + 1) * DM, MODN, 0);
    else { for (int i = F.tid; i < DM; i += NWAVES * 64) GSw[i] = F.in[I_FG][i]; }
    for (int i = F.tid; i < 3 * DM; i += NWAVES * 64) GT[i] = MOD[(size_t)(i >> 10) * 6144 + 5 * DM + (i & 1023)];
    __syncthreads();
    LAS const float* GS = GSw; LAS const float* SH = (LAS const float*)(F.lds + NL_SH);
    int ts[NEXP]; moe_starts(F, ts);
    const float* PARTM = SCR(float, S_PARTM);
    int nsl = 0; { const int nM = ts[NEXP - 1], tailU = (nM - 128) * 4; if (tailU > 0) { nsl = 256 / tailU; nsl = nsl > 7 ? 7 : (nsl < 1 ? 1 : nsl); } }
    const int gw = F.vcu * NWAVES + F.wave, NGW = F.G * NWAVES, lane = F.lane;
    struct CIdx { int s, p0, p1; float w0, w1; };
    struct CDat { u32x2 y0[4], y1[4], xr[4]; f32x4 fs[4]; int fast0, fast1; float w0, w1; };
    const size_t TAIL0 = (size_t)128 * 256 * DM;
    auto iload = [&](CIdx& x, int r) { x.s = SEL[r]; x.p0 = POS[2 * r]; x.p1 = POS[2 * r + 1]; x.w0 = WTS[2 * r]; x.w1 = WTS[2 * r + 1]; };
    auto dload = [&](CDat& d, const CIdx& x, int r) {
        const int e0 = x.s & 255, e1 = x.s >> 8;
        const size_t s0 = (size_t)(seg_start(ts, e0) * 256 + x.p0) * DM, s1 = (size_t)(seg_start(ts, e1) * 256 + x.p1) * DM;
        d.fast0 = s0 < TAIL0; d.fast1 = s1 < TAIL0; d.w0 = x.w0; d.w1 = x.w1;
#pragma unroll
        for (int j = 0; j < 4; ++j) { const int c = 4 * lane + 256 * j;
            d.xr[j] = *(const u32x2*)(XW + (size_t)r * DM + c);
            if (d.fast0) d.y0[j] = *(const u32x2*)(YS + s0 + c);
            if (d.fast1) d.y1[j] = *(const u32x2*)(YS + s1 + c);
            d.fs[j] = (f32x4){0.f, 0.f, 0.f, 0.f};
            if (!d.fast0) d.fs[j] += moe_y(YS, PARTM, s0, nsl, c) * x.w0;
            if (!d.fast1) d.fs[j] += moe_y(YS, PARTM, s1, nsl, c) * x.w1; }
    };
    auto process = [&](const CDat& d, int r) {
        const int sm = row_sample(r);
        f32x4 v[4]; float ss = 0.f;
#pragma unroll
        for (int j = 0; j < 4; ++j) { const int c = 4 * lane + 256 * j;
            f32x4 f = d.fs[j];
            if (d.fast0) f += (f32x4){bflo(d.y0[j].x), bfhi(d.y0[j].x), bflo(d.y0[j].y), bfhi(d.y0[j].y)} * d.w0;
            if (d.fast1) f += (f32x4){bflo(d.y1[j].x), bfhi(d.y1[j].x), bflo(d.y1[j].y), bfhi(d.y1[j].y)} * d.w1;
            v[j] = (f32x4){bflo(d.xr[j].x), bfhi(d.xr[j].x), bflo(d.xr[j].y), bfhi(d.xr[j].y)} + *(LAS const f32x4*)(GT + sm * DM + c) * f;
            if (MODE == 0) st_x4(XW + (size_t)r * DM + c, v[j]);
            ss += (v[j][0] * v[j][0] + v[j][1] * v[j][1]) + (v[j][2] * v[j][2] + v[j][3] * v[j][3]); }
        const float rstd = __builtin_amdgcn_rsqf(wave_sum(ss) * (1.f / DM) + NORM_EPS);
        if (MODE == 0) {
#pragma unroll
            for (int j = 0; j < 4; ++j) { const int c = 4 * lane + 256 * j; v[j] = v[j] * rstd * *(LAS const f32x4*)(GS + sm * DM + c) + *(LAS const f32x4*)(SH + sm * DM + c); }
            store_row_bf16(H + (size_t)r * DM, lane, v);
        } else {
#pragma unroll
            for (int j = 0; j < 4; ++j) { const int c = 4 * lane + 256 * j; *(f32x4*)(F.out + (size_t)(r - RC) * DM + c) = v[j] * rstd * *(LAS const f32x4*)(GS + c); }
        }
    };
    CIdx ia, ib; CDat da, db;
    int row = row_lo + gw;
    if (row < RT) iload(ia, row);
    if (row + NGW < RT) iload(ib, row + NGW);
    if (row < RT) dload(da, ia, row);
    for (; row < RT; row += 2 * NGW) {
        if (row + 2 * NGW < RT) iload(ia, row + 2 * NGW);
        if (row + NGW < RT) dload(db, ib, row + NGW);
        process(da, row);
        if (row + NGW >= RT) break;
        if (row + 3 * NGW < RT) iload(ib, row + 3 * NGW);
        if (row + 2 * NGW < RT) dload(da, ia, row + 2 * NGW);
        process(db, row + NGW);
    }
}

constexpr int N_PHASES = 39;
__global__ void __launch_bounds__(NWAVES * 64, 2) fwd_kernel(Args args) {
    extern __shared__ __attribute__((aligned(16))) unsigned char lds_raw[];
    Frame F;
    F.lds = (LAS unsigned char*)lds_raw; F.ws = args.ws; F.in = args.in; F.out = args.out;
    F.tid = threadIdx.x; F.lane = F.tid & 63; F.wave = __builtin_amdgcn_readfirstlane(F.tid >> 6);
    F.G = gridDim.x; { const int bx = blockIdx.x; F.vcu = (F.G % 8 == 0) ? (bx % 8) * (F.G / 8) + bx / 8 : bx; }
    volatile LAS unsigned* MISC = (volatile LAS unsigned*)(F.lds + MISC_OFF);
    for (int u = F.tid; u < (LDS_BYTES - LDSCTL_OFF) / 4; u += NWAVES * 64) ((LAS unsigned*)(F.lds + LDSCTL_OFF))[u] = 0u;
    __syncthreads();
    const int lo = args.ph_lo, hi = args.ph_hi;
    XcdBarrier bar; bar.bar = (unsigned*)(F.ws + WS_CTL) + CW_BAR + args.li * XCD_BAR_WORDS; bar.x = 0; bar.st = nullptr;
    if (hi - lo > 1) bar = xcd_barrier_post(bar.bar, MISC + 8);
#define IN(k) (lo <= (k) && (k) < hi)
#define SEAM(k) do { if (IN(k) && IN((k) + 1)) xcd_barrier(bar); } while (0)
#ifndef PROBE_MASK
#define PROBE_MASK 0ull
#endif
#define REPS(k) for (int rep_ = 0; rep_ < 1 + (int)((PROBE_MASK >> (k)) & 1ull); ++rep_)
#define REPBAR(k) if (rep_ + 1 < 1 + (int)((PROBE_MASK >> (k)) & 1ull)) xcd_barrier(bar);
    const int c_ = (int)blockIdx.x;
    LAS unsigned char* L = F.lds;
    float* MOD = WSP(float, WS_MOD);
    using namespace pg8;

    enum { P_PRO = 0, P_L0N1, P_MBIN, P_MBCONV, P_MBST, P_MBCARRY, P_MBOUT, P_MBOG, P_L0N2, P_FF0IN, P_FF0OUT, P_FIX1,
           P_L1N1, P_RWBIG, P_RWL2, P_WYPREP, P_RWSCAN, P_RWCOMB, P_RWOG, P_L1N2, P_M1GATH, P_M1IN, P_M1OUT, P_M1COMB,
           P_POOL, P_POOLG, P_L2N2, P_FF2IN, P_FF2OUT, P_L3N1, P_QKV, P_QKROPE, P_ATTN, P_ATOG, P_L3N2, P_M3GATH, P_M3IN, P_M3OUT, P_M3COMB };
    float* PARTC = SCR(float, S_PARTC); float* PARTM = SCR(float, S_PARTM);
    bf16_t* XWp = WSP(bf16_t, WS_XW);
#define PH(k, ...) if (IN(k)) REPS(k) { __VA_ARGS__ REPBAR(k) } SEAM(k);
    PH(P_PRO, p_prologue<0>(F);)
    PH(P_L0N1, p_norm<0>(F, 0, 0, 1, 0); __syncthreads(); p_prologue<1>(F);)
    PH(P_MBIN, SchedStd S{RT / 256, MB_NPAD / 256, F.G, c_, (size_t)256 * DM * 2, (size_t)256 * DM * 2, 0, 1, DM / 64};
        EpiMbIn E{SCR(bf16_t, S_Z), SCR(bf16_t, S_XBCP), SCR(float, S_DT), F.in[I_MBDTB]};
        gemm_phase<EpiMbIn, SchedStd, true>(L, WSP(bf16_t, WS_H), WSP(bf16_t, W_MBIN), DM, DM, S, E);)
    PH(P_MBCONV, p_mb_conv(F);)
    PH(P_MBST, p_mb_states(F);)
    PH(P_MBCARRY, p_mb_carry(F);)
    PH(P_MBOUT, p_mb_out(F);)
    PH(P_MBOG, SchedCtx S{F.G, c_, (size_t)256 * MB_DI * 2, (size_t)256 * MB_DI * 2, MB_DI / 64, (size_t)512};
        EpiRes E{XWp, F.in[I_X], F.in[I_CTX], MOD + 0 * 3 * 6144 + 2 * DM, SCR(float, S_SSQ), nullptr, 0, 1, PARTC};
        gemm_phase<EpiRes, SchedCtx, true>(L, SCR(bf16_t, S_YG), WSP(bf16_t, W_MBOUT), MB_DI, MB_DI, S, E);)
    PH(P_L0N2, p_norm<0>(F, 0, 1, 0, 0, CtxFix{MOD + 0 * 3 * 6144 + 2 * DM, SCR(float, S_SSQC), 1, MB_DI / 256});)
    PH(P_FF0IN, SchedStd S{RT / 256, 2 * FFD / 256, F.G, c_, (size_t)256 * DM * 2, (size_t)256 * DM * 2, 0, 1, DM / 64};
        EpiSwiglu E{SCR(bf16_t, S_HID), FFD, FFD / 64};
        gemm_phase<EpiSwiglu, SchedStd, true>(L, WSP(bf16_t, WS_H), WSP(bf16_t, W_FFIN), DM, DM, S, E);)
    PH(P_FF0OUT, SchedCtx S{F.G, c_, (size_t)256 * FFD * 2, (size_t)256 * FFD * 2, FFD / 64, (size_t)131072};
        EpiRes E{XWp, nullptr, nullptr, MOD + 0 * 3 * 6144 + 5 * DM, nullptr, nullptr, 0, 0, PARTC};
        gemm_phase<EpiRes, SchedCtx, true>(L, SCR(bf16_t, S_HID), WSP(bf16_t, W_FFOUT), 0, FFD, S, E);)
    PH(P_FIX1, p_ctx_fix(F, MOD + 0 * 3 * 6144 + 5 * DM, nullptr, 0, FFD / 256);)
    PH(P_L1N1, p_norm_rw(F, 1);)
    PH(P_RWBIG, SchedRw S{F.G, c_};
        EpiRwBig E{SCR(bf16_t, S_RKV), SCR(bf16_t, S_L1)};
        gemm_phase<EpiRwBig, SchedRw, true>(L, SCR(bf16_t, S_X6), WSP(bf16_t, W_RWBIG), DM, DM, S, E);)
    PH(P_WYPREP, p_rw_l2(F); p_wy_prep(F);)
    PH(P_RWSCAN, p_wy_seq(F);)
    PH(P_RWCOMB, p_rw_combine(F);)
    PH(P_RWOG, SchedCtx S{F.G, c_, (size_t)256 * DM * 2, (size_t)256 * DM * 2, DM / 64, (size_t)512};
        EpiRes E{XWp, nullptr, nullptr, MOD + 1 * 3 * 6144 + 2 * DM, nullptr, nullptr, 0, 0, PARTC};
        gemm_phase<EpiRes, SchedCtx, true>(L, SCR(bf16_t, S_OO), WSP(bf16_t, W_RWOUT), DM, DM, S, E);)
    PH(P_L1N2, p_norm<2>(F, 1, 1, 0, 0, CtxFix{MOD + 1 * 3 * 6144 + 2 * DM, nullptr, 0, DM / 256});)
    PH(P_M1GATH, p_moe_gather(F, 0);)
    PH(P_M1IN, SchedMoe S; moe_starts(F, S.ts); S.nM = S.ts[NEXP - 1]; S.nN = 2 * FFE / 256; S.G = F.G; S.c = c_; S.a_tile = (size_t)256 * DM * 2; S.b_tile = (size_t)256 * DM * 2; S.b_exp = (size_t)2 * FFE * DM * 2; S.nt = DM / 64; S.tail = 0; S.a_kpair = 256;
        EpiSwiglu E{SCR(bf16_t, S_HM), FFE, FFE / 64};
        gemm_phase<EpiSwiglu, SchedMoe, true>(L, SCR(bf16_t, S_AG), WSP(bf16_t, W_MOEIN), DM, DM, S, E);)
    PH(P_M1OUT, SchedMoe S; moe_starts(F, S.ts); S.nM = S.ts[NEXP - 1]; S.nN = DM / 256; S.G = F.G; S.c = c_; S.a_tile = (size_t)256 * FFE * 2; S.b_tile = (size_t)256 * FFE * 2; S.b_exp = (size_t)DM * FFE * 2; S.nt = FFE / 64; S.tail = 1; S.a_kpair = 65536;
        EpiBf16 E{SCR(bf16_t, S_YS), DM, PARTM, 128 * 256, (size_t)PARTM_ROWS * 1024};
        gemm_phase<EpiBf16, SchedMoe, true>(L, SCR(bf16_t, S_HM), WSP(bf16_t, W_MOEOUT), 0, FFE, S, E);)
    PH(P_M1COMB, p_moe_combine<0>(F, 1, 0);)
    PH(P_POOL, p_pool(F, SCR(bf16_t, S_YG));)
    PH(P_POOLG, SchedStd S{RT / 256, DM / 256, F.G, c_, (size_t)256 * DM * 2, (size_t)256 * 256 * 2, 512, 1, 256 / 64};
        EpiRes E{XWp, nullptr, nullptr, MOD + 2 * 3 * 6144 + 2 * DM, nullptr, F.in[I_PLS], 0, 0, nullptr};
        gemm_phase<EpiRes, SchedStd, true>(L, SCR(bf16_t, S_YG), WSP(bf16_t, W_POOL), DM, 256, S, E);)
    PH(P_L2N2, p_norm<0>(F, 2, 1, 0, 0);)
    PH(P_FF2IN, SchedStd S{RT / 256, 2 * FFD / 256, F.G, c_, (size_t)256 * DM * 2, (size_t)256 * DM * 2, 0, 1, DM / 64};
        EpiSwiglu E{SCR(bf16_t, S_HID), FFD, FFD / 64};
        gemm_phase<EpiSwiglu, SchedStd, true>(L, WSP(bf16_t, WS_H), WSP(bf16_t, W_FFIN) + (size_t)2 * FFD * DM, DM, DM, S, E);)
    PH(P_FF2OUT, SchedCtx S{F.G, c_, (size_t)256 * FFD * 2, (size_t)256 * FFD * 2, FFD / 64, (size_t)131072};
        EpiRes E{XWp, nullptr, nullptr, MOD + 2 * 3 * 6144 + 5 * DM, nullptr, nullptr, 0, 0, PARTC};
        gemm_phase<EpiRes, SchedCtx, true>(L, SCR(bf16_t, S_HID), WSP(bf16_t, W_FFOUT) + (size_t)DM * FFD, 0, FFD, S, E);)
    PH(P_L3N1, p_norm<0>(F, 3, 0, 0, 0, CtxFix{MOD + 2 * 3 * 6144 + 5 * DM, nullptr, 0, FFD / 256});)
    PH(P_QKV, SchedStd S{RT / 256, 1536 / 256, F.G, c_, (size_t)256 * DM * 2, (size_t)256 * DM * 2, 0, 1, DM / 64};
        EpiBf16 E{SCR(bf16_t, S_QKV), 1536, nullptr, 0, 0};
        gemm_phase<EpiBf16, SchedStd, true>(L, WSP(bf16_t, WS_H), WSP(bf16_t, W_QKV), DM, DM, S, E);)
    PH(P_QKROPE, p_qkrope(F);)
    PH(P_ATTN,
        const attn_body::bf16* Q = (const attn_body::bf16*)SCR(bf16_t, S_QKV); const attn_body::bf16* K = (const attn_body::bf16*)SCR(bf16_t, S_KB); const attn_body::bf16* V = (const attn_body::bf16*)SCR(bf16_t, S_VB);
        attn_body::bf16* O = (attn_body::bf16*)SCR(bf16_t, S_AO);
        for (int ui = F.vcu; ui < 1024; ui += F.G) { const int bh = ui >> 5, qb = ui & 31; attn_body::attn_unit<8>(bh >> 4, bh & 15, qb, Q, F.in[I_ATQG], WSP(float, WS_ROPE), K, V, O, (char*)lds_raw); })
    PH(P_ATOG, SchedStd S{RL / 256, DM / 256, F.G, c_, (size_t)256 * DM * 2, (size_t)256 * DM * 2, 0, 1, DM / 64};
        EpiRes E{XWp, nullptr, nullptr, MOD + 3 * 3 * 6144 + 2 * DM, nullptr, nullptr, RC, 0, nullptr};
        gemm_phase<EpiRes, SchedStd, true>(L, SCR(bf16_t, S_AO), WSP(bf16_t, W_ATOUT), DM, DM, S, E);)
    PH(P_L3N2, p_norm<2>(F, 3, 1, 0, RC);)
    PH(P_M3GATH, p_moe_gather(F, RC);)
    PH(P_M3IN, SchedMoe S; moe_starts(F, S.ts); S.nM = S.ts[NEXP - 1]; S.nN = 2 * FFE / 256; S.G = F.G; S.c = c_; S.a_tile = (size_t)256 * DM * 2; S.b_tile = (size_t)256 * DM * 2; S.b_exp = (size_t)2 * FFE * DM * 2; S.nt = DM / 64; S.tail = 0; S.a_kpair = 256;
        EpiSwiglu E{SCR(bf16_t, S_HM), FFE, FFE / 64};
        gemm_phase<EpiSwiglu, SchedMoe, true>(L, SCR(bf16_t, S_AG), WSP(bf16_t, W_MOEIN) + (size_t)8 * 2 * FFE * DM, DM, DM, S, E);)
    PH(P_M3OUT, SchedMoe S; moe_starts(F, S.ts); S.nM = S.ts[NEXP - 1]; S.nN = DM / 256; S.G = F.G; S.c = c_; S.a_tile = (size_t)256 * FFE * 2; S.b_tile = (size_t)256 * FFE * 2; S.b_exp = (size_t)DM * FFE * 2; S.nt = FFE / 64; S.tail = 1; S.a_kpair = 65536;
        EpiBf16 E{SCR(bf16_t, S_YS), DM, PARTM, 128 * 256, (size_t)PARTM_ROWS * 1024};
        gemm_phase<EpiBf16, SchedMoe, true>(L, SCR(bf16_t, S_HM), WSP(bf16_t, W_MOEOUT) + (size_t)8 * DM * FFE, 0, FFE, S, E);)
    if (IN(P_M3COMB)) { p_moe_combine<1>(F, 3, RC); }
#undef PH
#undef IN
#undef SEAM
}

#ifndef MK_CUTS
#define MK_CUTS 0
#endif
extern "C" void kernel_launch(void* const* d_in, const int* in_sizes, int n_in, void* d_out, int out_size, void* d_ws, size_t ws_size, hipStream_t stream) {
    static int grid = 0;
    if (grid == 0) {
        if (n_in != 44 || out_size != RL * DM || ws_size < WS_END) { fprintf(stderr, "kernel_launch: unexpected sizes (n_in %d out %d ws %zu)\n", n_in, out_size, ws_size); grid = -1; return; }
        int dev = 0, cus = 0, per_cu = 0;
        if (hipGetDevice(&dev) != hipSuccess || hipDeviceGetAttribute(&cus, hipDeviceAttributeMultiprocessorCount, dev) != hipSuccess) { grid = -1; return; }
        if (hipFuncSetAttribute((const void*)fwd_kernel, hipFuncAttributeMaxDynamicSharedMemorySize, LDS_BYTES) != hipSuccess) { fprintf(stderr, "kernel_launch: hipFuncSetAttribute failed\n"); grid = -1; return; }
        if (hipOccupancyMaxActiveBlocksPerMultiprocessor(&per_cu, (const void*)fwd_kernel, NWAVES * 64, LDS_BYTES) != hipSuccess || per_cu < 1)
            fprintf(stderr, "kernel_launch: occupancy query reports %d\n", per_cu);
        (void)hipGetLastError();
        grid = cus;
    }
    if (grid < 0) return;
    (void)hipMemsetAsync((char*)d_ws + WS_CTL + (size_t)CW_BAR * 4, 0, (size_t)XCD_BAR_WORDS * 4, stream);
    Args a{};
    for (int i = 0; i < 44; ++i) a.in[i] = (const float*)d_in[i];
    a.out = (float*)d_out; a.ws = (unsigned char*)d_ws; a.pad = 0;
#if MK_CUTS == 0
    a.ph_lo = 0; a.ph_hi = N_PHASES; a.li = 0;
    hipLaunchKernelGGL(fwd_kernel, dim3(grid), dim3(NWAVES * 64), LDS_BYTES, stream, a);
#else
    for (int p = 0; p < N_PHASES; ++p) { a.ph_lo = p; a.ph_hi = p + 1; a.li = 0; hipLaunchKernelGGL(fwd_kernel, dim3(grid), dim3(NWAVES * 64), LDS_BYTES, stream, a); }
#endif
}
```

```cpp
#include <hip/hip_runtime.h>
#include <hip/hip_bf16.h>
#include <cstdio>
#include <cstdint>
#include <cmath>

#define LAS __attribute__((address_space(3)))
#define GAS __attribute__((address_space(1)))
typedef unsigned short bf16_t;
typedef short bf16x8 __attribute__((ext_vector_type(8)));
typedef short s16x4 __attribute__((ext_vector_type(4)));
typedef float f32x4 __attribute__((ext_vector_type(4)));
typedef float f32x2 __attribute__((ext_vector_type(2)));
typedef unsigned u32x4 __attribute__((ext_vector_type(4)));
typedef unsigned u32x2 __attribute__((ext_vector_type(2)));

constexpr int DM = 1024, NB = 2, TL = 8192, TC = 256;
constexpr int RC = NB * TC, RL = NB * TL, RT = RC + RL;
constexpr float NORM_EPS = 1e-6f;
constexpr int MB_DI = 2048, MB_XBC = 3072, MB_NIN = 5184, MB_NPAD = 5376, MB_CH = 128, MB_NSC = RT / MB_CH;
constexpr int FFD = 2816, FFE = 3584, NEXP = 8;
constexpr int MOE_MAXT = 140;
constexpr int KVL = TC + TL;

constexpr size_t MiB = (size_t)1 << 20;
constexpr size_t WS_CTL = 0, CTL_ZERO_BYTES = 1 * MiB;
constexpr size_t WS_MOD = 4 * MiB;
constexpr size_t WS_ROPE = 4 * MiB + 512 * 1024;
constexpr size_t WS_SEL = 5 * MiB;
constexpr size_t WS_WTS = WS_SEL + 128 * 1024;
constexpr size_t WS_POS = WS_WTS + 256 * 1024;
constexpr size_t WS_CNT = WS_POS + 256 * 1024;
constexpr size_t W_MBIN = 8 * MiB, W_MBOUT = 19 * MiB, W_RWBIG = 23 * MiB  , W_RWL2 = 37 * MiB  , W_RWOUT = 40 * MiB, W_POOL = 42 * MiB, W_QKV = 43 * MiB, W_ATOUT = 46 * MiB;
constexpr size_t W_FFIN = 48 * MiB, W_FFOUT = 70 * MiB, W_MOEIN = 82 * MiB, W_MOEOUT = 306 * MiB;
constexpr size_t WS_XW = 420 * MiB, WS_H = 486 * MiB, WS_SCR = 552 * MiB, WS_END = 1640 * MiB;
constexpr size_t S_Z = 0, S_XBCP = 66 * MiB, S_XBC = 165 * MiB, S_DT = 264 * MiB, S_ST = 270 * MiB, S_DTOT = 402 * MiB, S_YG = 403 * MiB, S_SSQ = 469 * MiB, S_SSQC = 470 * MiB;
constexpr size_t S_HID = 0;
constexpr size_t S_RKV = 0, S_X6 = 100 * MiB, S_L1 = 300 * MiB, S_WD = 320 * MiB, S_AD = 452 * MiB  , S_BON2 = 456 * MiB, S_GG = 520 * MiB, S_YY = 555 * MiB, S_OO = 100 * MiB;
constexpr size_t S_AG = 0, S_HM = 70 * MiB, S_YS = 315 * MiB, S_PARTM = 385 * MiB;
constexpr int PARTM_ROWS = (MOE_MAXT - 128) * 256;
constexpr size_t S_WY = 704 * MiB;
constexpr size_t S_PARTC = 1036 * MiB;
constexpr size_t S_QKV = 0, S_QB = 50 * MiB, S_KB = 82 * MiB, S_VB = 91 * MiB, S_AO = 100 * MiB;
constexpr int CW_BAR = 4096;

constexpr int RING_BYTES = 143360;
constexpr int LDSCTL_OFF = RING_BYTES, MISC_OFF = LDSCTL_OFF + 320;
constexpr int LDS_BYTES = 147456;
constexpr int NWAVES = 8;

#define RLX_AGENT __ATOMIC_RELAXED, __HIP_MEMORY_SCOPE_AGENT
#define LDS_WAIT() asm volatile("s_waitcnt lgkmcnt(0)" ::: "memory")
typedef __bf16 bf16x2_hw __attribute__((ext_vector_type(2)));
__device__ __forceinline__ unsigned pk2(float lo, float hi) { const f32x2 v = {lo, hi}; const bf16x2_hw b = __builtin_convertvector(v, bf16x2_hw); return __builtin_bit_cast(unsigned, b); }
__device__ __forceinline__ unsigned f2bf(float f) { return pk2(f, f) & 0xffffu; }
__device__ __forceinline__ float bf2f(unsigned short b) { return __builtin_bit_cast(float, (unsigned)b << 16); }
__device__ __forceinline__ float bflo(unsigned w) { return __builtin_bit_cast(float, w << 16); }
__device__ __forceinline__ float bfhi(unsigned w) { return __builtin_bit_cast(float, w & 0xffff0000u); }
__device__ __forceinline__ float wave_sum(float v) {
#define WS_DPP(x, ctrl) __builtin_bit_cast(float, __builtin_amdgcn_update_dpp(0, __builtin_bit_cast(int, x), ctrl, 0xf, 0xf, false))
    v += WS_DPP(v, 0xB1); v += WS_DPP(v, 0x4E); v += WS_DPP(v, 0x141); v += WS_DPP(v, 0x140);
#undef WS_DPP
    const float a = __builtin_bit_cast(float, __builtin_amdgcn_readlane(__builtin_bit_cast(int, v), 0)), b = __builtin_bit_cast(float, __builtin_amdgcn_readlane(__builtin_bit_cast(int, v), 16)),
                c = __builtin_bit_cast(float, __builtin_amdgcn_readlane(__builtin_bit_cast(int, v), 32)), d = __builtin_bit_cast(float, __builtin_amdgcn_readlane(__builtin_bit_cast(int, v), 48));
    return (a + b) + (c + d);
}
__device__ __forceinline__ float sigmoidf_(float x) { return __builtin_amdgcn_rcpf(1.f + __expf(-x)); }
__device__ __forceinline__ float siluf_(float x) { return x * __builtin_amdgcn_rcpf(1.f + __expf(-x)); }
__device__ __forceinline__ void unpack8(const u32x4 w, float* v) {
    v[0] = bflo(w.x); v[1] = bfhi(w.x); v[2] = bflo(w.y); v[3] = bfhi(w.y); v[4] = bflo(w.z); v[5] = bfhi(w.z); v[6] = bflo(w.w); v[7] = bfhi(w.w);
}
__device__ __forceinline__ u32x4 pack8(const float* v) { u32x4 w; w.x = pk2(v[0], v[1]); w.y = pk2(v[2], v[3]); w.z = pk2(v[4], v[5]); w.w = pk2(v[6], v[7]); return w; }
__device__ __forceinline__ f32x4 ld_x4(const bf16_t* p) { const u32x2 w = *(const u32x2*)p; return (f32x4){bflo(w.x), bfhi(w.x), bflo(w.y), bfhi(w.y)}; }
__device__ __forceinline__ void st_x4(bf16_t* p, const f32x4 v) { u32x2 w; w.x = pk2(v[0], v[1]); w.y = pk2(v[2], v[3]); *(u32x2*)p = w; }
__device__ __forceinline__ int row_sample(int row) { return row < RC ? 0 : 1 + ((row - RC) >> 13); }

#define XB_TMO      128
#define XB_XCNT(j)  (256  + 64 * (j))
#define XB_XSUB(j)  (1280 + 64 * (j))
#define XB_XGEN(j)  (2304 + 64 * (j))
#define XB_TOP      3328
#define XB_TOPGEN   3392
#define XCD_BAR_WORDS 3456
#define XB_SPIN_CAP (1u << 22)
__device__ __forceinline__ unsigned xb_ld(unsigned* p)              { return __hip_atomic_load(p, __ATOMIC_RELAXED, __HIP_MEMORY_SCOPE_AGENT); }
__device__ __forceinline__ unsigned xb_add(unsigned* p, unsigned v) { return __hip_atomic_fetch_add(p, v, __ATOMIC_RELAXED, __HIP_MEMORY_SCOPE_AGENT); }
__device__ __forceinline__ unsigned xb_xcc_id() { return (unsigned)__builtin_amdgcn_s_getreg((3 << 11) | 20) & 0xFu; }
#define XB_SPIN(cond, bar) do { unsigned _sp = 0; while (cond) { __builtin_amdgcn_s_sleep(1); \
    if ((++_sp & 255u) == 0u) { if (xb_ld(&(bar)[XB_TMO])) break; if (_sp > XB_SPIN_CAP) { atomicAdd(&(bar)[XB_TMO], 1u); break; } } } } while (0)
struct XcdBarrier { unsigned* bar; unsigned x; volatile LAS unsigned* st; };
__device__ __forceinline__ XcdBarrier xcd_barrier_post(unsigned* bar, volatile LAS unsigned* st) {
    XcdBarrier b; b.bar = bar; b.x = xb_xcc_id(); b.st = st;
    if (threadIdx.x == 0) (void)xb_add(&bar[XB_XCNT(b.x)], 1u);
    return b;
}
__device__ __forceinline__ void xcd_barrier_complete(unsigned* bar, unsigned x, unsigned& nloc, unsigned& nx) {
    const unsigned G = gridDim.x * gridDim.y * gridDim.z;
    unsigned sum, cnt, mine, sp = 0u;
    for (;;) {
        sum = 0u; cnt = 0u; mine = 0u;
#pragma unroll
        for (unsigned j = 0; j < 16; ++j) { const unsigned c = xb_ld(&bar[XB_XCNT(j)]); sum += c; cnt += (c > 0u) ? 1u : 0u; mine = (j == x) ? c : mine; }
        if (sum == G) break;
        __builtin_amdgcn_s_sleep(1);
        if ((++sp & 255u) == 0u) { if (xb_ld(&bar[XB_TMO])) break; if (sp > XB_SPIN_CAP) { atomicAdd(&bar[XB_TMO], 1u); break; } }
    }
    nloc = mine > 0u ? mine : 1u; nx = cnt > 0u ? cnt : 1u;
}
__device__ __forceinline__ void xcd_barrier(const XcdBarrier& b) {
    asm volatile("s_waitcnt vmcnt(0)" ::: "memory");
    __syncthreads();
    if (threadIdx.x == 0) {
        unsigned* bar = b.bar;
        __builtin_amdgcn_s_waitcnt(0);
        unsigned nloc = b.st[0], nx = b.st[1];
        if (nloc == 0u) { xcd_barrier_complete(bar, b.x, nloc, nx); b.st[0] = nloc; b.st[1] = nx; }
        const unsigned old = xb_add(&bar[XB_XSUB(b.x)], 1u);
        const unsigned gen = old / nloc;
        if (old + 1u == (gen + 1u) * nloc) {
            __builtin_amdgcn_fence(__ATOMIC_RELEASE, "agent");
            asm volatile("s_waitcnt vmcnt(0)" ::: "memory");
            const unsigned og = xb_add(&bar[XB_TOP], 1u);
            const unsigned tg = og / nx;
            if (og + 1u == (tg + 1u) * nx) xb_add(&bar[XB_TOPGEN], 1u);
            else XB_SPIN(xb_ld(&bar[XB_TOPGEN]) == tg, bar);
            __builtin_amdgcn_fence(__ATOMIC_ACQUIRE, "agent");
            xb_add(&bar[XB_XGEN(b.x)], 1u);
            asm volatile("s_waitcnt vmcnt(0)" ::: "memory");
        } else {
            XB_SPIN(xb_ld(&bar[XB_XGEN(b.x)]) == gen, bar);
            __builtin_amdgcn_fence(__ATOMIC_ACQUIRE, "agent");
            asm volatile("s_waitcnt vmcnt(0)" ::: "memory");
        }
    }
    __syncthreads();
}

namespace pg8 {
constexpr int BM = 256, BK = 64, HALF = 128, HTB = HALF * BK * 2, STAGE_BYTES = 8 * HTB, NXCD = 8, WGM = 8;
__host__ __device__ __forceinline__ int lds_byte(int r, int c) { const int st = (r >> 4) * 2 + (c >> 5), rr = r & 15, cc = c & 31, ob = rr * 64 + cc * 2; return st * 1024 + (ob ^ (((ob >> 9) & 1) << 5)); }
__host__ __device__ __forceinline__ void stage_rc(int b, int& R, int& C) { const int st = b / 1024, sb = b % 1024, swz = sb ^ (((sb >> 9) & 1) << 5); R = (st >> 1) * 16 + swz / 64; C = (st & 1) * 32 + (swz % 64) / 2; }
__host__ __device__ __forceinline__ int perm32(int rho) { const int n = rho >> 4, i = rho & 15; return 8 * (i >> 2) + 4 * n + (i & 3); }

struct Unit { int pm, pn; size_t aoff, boff; int nt, ks; };
__device__ __forceinline__ void tile_of(int wgid, int nM, int nN, int& pm, int& pn) {
    const int nwg = nM * nN;
    { const int q = nwg / NXCD, r = nwg % NXCD, xcd = wgid % NXCD, off = wgid / NXCD; wgid = (xcd < r ? xcd * (q + 1) : r * (q + 1) + (xcd - r) * q) + off; }
    const int nig = WGM * nN, gid = wgid / nig, fm = gid * WGM, gsz = (nM - fm) < WGM ? (nM - fm) : WGM;
    pm = fm + ((wgid % nig) % gsz); pn = (wgid % nig) / gsz;
}
struct SchedStd {
    int nM, nN, G, c; size_t a_tile, b_tile, a_add; int a_div; int nt;
    __device__ __forceinline__ bool next(int i, Unit& u) const {
        const long L = (long)i * G + c; if (L >= (long)nM * nN) return false;
        tile_of((int)L, nM, nN, u.pm, u.pn); u.nt = nt; u.ks = -1;
        u.aoff = (size_t)u.pm * a_tile + (size_t)(u.pn / a_div) * a_add; u.boff = (size_t)u.pn * b_tile; return true;
    }
};
struct SchedMoe {
    int nM, nN, G, c; size_t a_tile, b_tile, b_exp; int ts[NEXP]; int nt; int tail; size_t a_kpair;
    __device__ __forceinline__ bool next(int i, Unit& u) const {
        const int L = i * G + c; size_t koff = 0, koffA = 0; u.nt = nt; u.ks = -1;
        if (!tail) { if (L >= nM * nN) return false; tile_of(L, nM, nN, u.pm, u.pn); }
        else {
            const int nFull = nM < 128 ? nM : 128, fullU = nFull * nN;
            if (L < fullU) tile_of(L, nFull, nN, u.pm, u.pn);
            else { const int tailU = (nM - nFull) * nN; if (tailU <= 0) return false; int S = 256 / tailU; S = S > 7 ? 7 : (S < 1 ? 1 : S);
                const int q = L - fullU; if (q >= tailU * S) return false;
                const int ks = q / tailU, tu = q % tailU, np = nt / 2, p0 = ks * np / S, p1 = (ks + 1) * np / S;
                u.pm = nFull + tu / nN; u.pn = tu % nN; u.ks = ks; u.nt = 2 * (p1 - p0); koff = (size_t)p0 * 256; koffA = (size_t)p0 * a_kpair; }
        }
        int e = 0;
#pragma unroll
        for (int j = 0; j < NEXP - 1; ++j) e += (u.pm >= ts[j]) ? 1 : 0;
        u.aoff = (size_t)u.pm * a_tile + koffA; u.boff = (size_t)e * b_exp + (size_t)u.pn * b_tile + koff; return true;
    }
};
struct SchedRw {
    int G, c;
    __device__ __forceinline__ bool next(int i, Unit& u) const {
        const int L = i * G + c; if (L >= (RT / 256) * 15) return false;
        tile_of(L, RT / 256, 15, u.pm, u.pn); u.nt = DM / 64; u.ks = -1;
        const int g4 = u.pn >> 2, ai = u.pn < 12 ? (g4 == 0 ? 0 : g4 + 1) : (u.pn == 12 ? 1 : u.pn - 9);
        u.aoff = (size_t)ai * RT * DM * 2 + (size_t)u.pm * 256 * DM * 2; u.boff = (size_t)u.pn * 256 * DM * 2; return true;
    }
};
struct SchedCtx {
    int G, c; size_t a_tile, b_tile; int nt; size_t a_ks;
    __device__ __forceinline__ bool next(int i, Unit& u) const {
        const int L = i * G + c;
        if (L < 256) { tile_of(L, 64, 4, u.pm, u.pn); u.pm += 2; u.nt = nt; u.ks = -1; u.aoff = (size_t)u.pm * a_tile; u.boff = (size_t)u.pn * b_tile; return true; }
        const int q = L - 256, S = nt / 4; if (q >= 8 * S) return false;
        const int ks = q >> 3, r = q & 7; u.pm = r >> 2; u.pn = r & 3; u.nt = 4; u.ks = ks;
        u.aoff = (size_t)u.pm * a_tile + (size_t)ks * a_ks; u.boff = (size_t)u.pn * b_tile + (size_t)ks * 512; return true;
    }
};

__device__ __forceinline__ unsigned cvt_pk_bf16(float lo, float hi) { unsigned r; asm volatile("v_cvt_pk_bf16_f32 %0, %1, %2" : "=v"(r) : "v"(lo), "v"(hi)); return r; }

template <class Epi, class Sched, bool ALIGN_EPI>
__device__ __forceinline__ void gemm_phase(LAS unsigned char* lds, const bf16_t* Abase, const bf16_t* Bbase, int lda  , int ldb, const Sched& S, const Epi& E) {
    const int tid = threadIdx.x, wid = __builtin_amdgcn_readfirstlane(tid >> 6), lane = tid & 63, wr = wid >> 2, wc = wid & 3, fr = lane & 15, fq = lane >> 4;
    unsigned voffA[2], voffB[2];
    const int lda_e = lda <= 0 ? BK : lda;
#pragma unroll
    for (int i = 0; i < 2; ++i) { int R, C; stage_rc(tid * 16 + i * 8192, R, C); const int Rb = (R & ~31) + perm32(R & 31);
        voffA[i] = (unsigned)(R * lda_e + C) * 2u; voffB[i] = (unsigned)(Rb * ldb + C) * 2u; }
    const bool a_blk = lda <= 0; if (a_blk) lda = BK;
    const size_t kstepA = a_blk ? (size_t)BM * BK * 2 : (size_t)(BK * 2), kstep = (size_t)(BK * 2);
    const size_t hstepA = (size_t)HALF * lda * 2, hstepB = (size_t)HALF * ldb * 2;
    const unsigned ldsw = (unsigned)wid * 1024u;
    const int aoff = lds_byte(wr * 64 + fr, fq * 8), boff = lds_byte(wc * 32 + fr, fq * 8);
#define PG8_SA(b, h) (((b) * 2 + (h)) * HTB)
#define PG8_SB(b, h) ((4 + (b) * 2 + (h)) * HTB)
#define PG8_STAGE(bufoff, gbase, voff) do { _Pragma("unroll") for (int _i = 0; _i < 2; ++_i) \
        __builtin_amdgcn_global_load_lds((const unsigned*)((const char*)(gbase) + (voff)[_i]), (LAS unsigned*)(lds + (bufoff) + ldsw + _i * 8192), 16, 0, 0); } while (0)
#define PG8_LDA(dst, b, h) do { _Pragma("unroll") for (int m = 0; m < 4; ++m) _Pragma("unroll") for (int k = 0; k < 2; ++k) dst[m][k] = *(const LAS bf16x8*)(lds + PG8_SA(b, h) + aoff + m * 2048 + k * 1024); } while (0)
#define PG8_LDB(dst, b, h) do { _Pragma("unroll") for (int n = 0; n < 2; ++n) _Pragma("unroll") for (int k = 0; k < 2; ++k) dst[n][k] = *(const LAS bf16x8*)(lds + PG8_SB(b, h) + boff + n * 2048 + k * 1024); } while (0)
#define PG8_MMA(ai, bj, At, Bt) do { __builtin_amdgcn_s_setprio(1); _Pragma("unroll") for (int m = 0; m < 4; ++m) _Pragma("unroll") for (int n = 0; n < 2; ++n) _Pragma("unroll") for (int k = 0; k < 2; ++k) \
        acc[ai][bj][m][n] = __builtin_amdgcn_mfma_f32_16x16x32_bf16(Bt[n][k], At[m][k], acc[ai][bj][m][n], 0, 0, 0); __builtin_amdgcn_s_setprio(0); } while (0)
#define PG8_WAIT_V(n) asm volatile("s_waitcnt vmcnt(" #n ")" ::: "memory")
#define PG8_WAIT_L(n) asm volatile("s_waitcnt lgkmcnt(" #n ")" ::: "memory")
#define PG8_BAR __builtin_amdgcn_s_barrier()
#define PG8_SCHED __builtin_amdgcn_sched_barrier(0)
    Unit cur, nxt; int ui = 0;
    if (!S.next(0, cur)) return;
    f32x4 acc[2][2][4][2];
#pragma unroll
    for (int a = 0; a < 2; ++a)
#pragma unroll
        for (int b = 0; b < 2; ++b)
#pragma unroll
            for (int m = 0; m < 4; ++m)
#pragma unroll
                for (int n = 0; n < 2; ++n) acc[a][b][m][n] = (f32x4){0.f, 0.f, 0.f, 0.f};
    bf16x8 At[4][2], B0[2][2], B1[2][2];
    const char* cA = (const char*)Abase + cur.aoff; const char* cB = (const char*)Bbase + cur.boff;
    PG8_STAGE(PG8_SB(0, 0), cB, voffB); PG8_STAGE(PG8_SB(0, 1), cB + hstepB, voffB); PG8_STAGE(PG8_SA(0, 0), cA, voffA); PG8_STAGE(PG8_SA(0, 1), cA + hstepA, voffA);
    if (wr == 1) PG8_BAR;
    PG8_WAIT_V(2); PG8_BAR;
    PG8_STAGE(PG8_SB(1, 0), cB + kstep, voffB); PG8_STAGE(PG8_SA(1, 0), cA + kstepA, voffA); PG8_STAGE(PG8_SB(1, 1), cB + hstepB + kstep, voffB);
    PG8_WAIT_V(6); PG8_BAR;
    for (;;) {
        const bool has_next = S.next(ui + 1, nxt);
        const char* nA = has_next ? (const char*)Abase + nxt.aoff : cA; const char* nB = has_next ? (const char*)Bbase + nxt.boff : cB;
        const int nt = cur.nt;
#pragma unroll 1
        for (int t = 0; t < nt; t += 2) {
            const bool last = (t == nt - 2);
            const char* a1 = cA + (size_t)(t + 1) * kstepA;
            const char* a2 = last ? nA : cA + (size_t)(t + 2) * kstepA; const char* b2 = last ? nB : cB + (size_t)(t + 2) * kstep;
            const char* a3 = a2 + kstepA; const char* b3 = b2 + kstep;
            PG8_LDB(B0, 0, 0); PG8_LDB(B1, 0, 1); PG8_SCHED; PG8_LDA(At, 0, 0); PG8_STAGE(PG8_SA(1, 1), a1 + hstepA, voffA);
            PG8_WAIT_V(8); PG8_WAIT_L(0); PG8_BAR; PG8_MMA(0, 0, At, B0); PG8_MMA(0, 1, At, B1); PG8_BAR; PG8_SCHED;
            PG8_LDA(At, 0, 1); PG8_STAGE(PG8_SB(0, 0), b2, voffB); PG8_STAGE(PG8_SB(0, 1), b2 + hstepB, voffB); PG8_STAGE(PG8_SA(0, 0), a2, voffA);
            PG8_WAIT_V(8); PG8_WAIT_L(0); PG8_BAR; PG8_MMA(1, 0, At, B0); PG8_MMA(1, 1, At, B1); PG8_BAR; PG8_SCHED;
            PG8_LDB(B0, 1, 0); PG8_LDB(B1, 1, 1); PG8_SCHED; PG8_LDA(At, 1, 0); PG8_STAGE(PG8_SA(0, 1), a2 + hstepA, voffA);
            PG8_WAIT_V(8); PG8_WAIT_L(0); PG8_BAR; PG8_MMA(0, 0, At, B0); PG8_MMA(0, 1, At, B1); PG8_BAR; PG8_SCHED;
            PG8_LDA(At, 1, 1); PG8_STAGE(PG8_SB(1, 0), b3, voffB); PG8_STAGE(PG8_SB(1, 1), b3 + hstepB, voffB); PG8_STAGE(PG8_SA(1, 0), a3, voffA);
            PG8_WAIT_V(8); PG8_WAIT_L(0); PG8_BAR; PG8_MMA(1, 0, At, B0); PG8_MMA(1, 1, At, B1); PG8_BAR; PG8_SCHED;
        }
        if constexpr (ALIGN_EPI) { if (wr == 0) PG8_BAR; }
        E(acc, cur, wr, wc, fr, fq);
        if (!has_next) break;
#pragma unroll
        for (int a = 0; a < 2; ++a)
#pragma unroll
            for (int b = 0; b < 2; ++b)
#pragma unroll
                for (int m = 0; m < 4; ++m)
#pragma unroll
                    for (int n = 0; n < 2; ++n) acc[a][b][m][n] = (f32x4){0.f, 0.f, 0.f, 0.f};
        cur = nxt; cA = nA; cB = nB; ++ui;
        if constexpr (ALIGN_EPI) { if (wr == 1) PG8_BAR; }
    }
    PG8_WAIT_V(0);
    if constexpr (!ALIGN_EPI) { if (wr == 0) PG8_BAR; }
    PG8_BAR;
#undef PG8_SA
#undef PG8_SB
#undef PG8_STAGE
#undef PG8_LDA
#undef PG8_LDB
#undef PG8_MMA
#undef PG8_WAIT_V
#undef PG8_WAIT_L
#undef PG8_BAR
#undef PG8_SCHED
}

#define EPI_BEGIN _Pragma("unroll") for (int ai = 0; ai < 2; ++ai) _Pragma("unroll") for (int m = 0; m < 4; ++m) { const int rl = ai * 128 + wr * 64 + m * 16 + fr; \
    _Pragma("unroll") for (int bj = 0; bj < 2; ++bj) { const int cl = bj * 128 + wc * 32 + 8 * fq; const f32x4 v0 = acc[ai][bj][m][0], v1 = acc[ai][bj][m][1];
#define EPI_END } asm volatile("" ::: "memory"); }

struct EpiBf16 {
    bf16_t* O; int ldc; float* PART; int part_row0; size_t part_stride;
    __device__ __forceinline__ void operator()(const f32x4 (&acc)[2][2][4][2], const Unit& u, int wr, int wc, int fr, int fq) const {
        if (u.ks < 0) {
        EPI_BEGIN
            u32x4 w; w.x = cvt_pk_bf16(v0[0], v0[1]); w.y = cvt_pk_bf16(v0[2], v0[3]); w.z = cvt_pk_bf16(v1[0], v1[1]); w.w = cvt_pk_bf16(v1[2], v1[3]);
            *(u32x4*)(O + (size_t)(u.pm * BM + rl) * ldc + u.pn * BM + cl) = w;
        EPI_END
        } else {
        EPI_BEGIN
            float* o = PART + (size_t)u.ks * part_stride + (size_t)(u.pm * BM + rl - part_row0) * 1024 + u.pn * BM + cl;
            *(f32x4*)o = v0; *(f32x4*)(o + 4) = v1;
        EPI_END
        }
    }
};
struct EpiSwiglu {
    bf16_t* O; int ldc; int nkb;
    __device__ __forceinline__ void operator()(const f32x4 (&acc)[2][2][4][2], const Unit& u, int wr, int wc, int fr, int fq) const {
        EPI_BEGIN
            u32x2 w; w.x = cvt_pk_bf16(siluf_(v0[0]) * v0[1], siluf_(v0[2]) * v0[3]); w.y = cvt_pk_bf16(siluf_(v1[0]) * v1[1], siluf_(v1[2]) * v1[3]);
            const int hc = (u.pn * BM + cl) >> 1;
            bf16_t* o = nkb ? O + ((((size_t)u.pm * nkb + (hc >> 6)) * BM + rl) << 6) + (hc & 63) : O + (size_t)(u.pm * BM + rl) * ldc + hc;
            *(u32x2*)o = w;
        EPI_END
    }
};
struct EpiRes {
    bf16_t* XW; const float* xin_x; const float* xin_c; const float* gate;
    const float* ssq; const float* colscale; int row_base; int xin_mode; float* PART;
    __device__ __forceinline__ void operator()(const f32x4 (&acc)[2][2][4][2], const Unit& u, int wr, int wc, int fr, int fq) const {
        if (u.ks >= 0) {
        EPI_BEGIN
            float* o = PART + ((size_t)u.ks * RC + (u.pm * BM + rl)) * DM + u.pn * BM + cl;
            *(f32x4*)o = v0; *(f32x4*)(o + 4) = v1;
        EPI_END
            return;
        }
        const float* gp = gate + (size_t)row_sample(row_base + u.pm * BM) * 6144 + u.pn * BM + wc * 32 + 8 * fq;
        f32x4 gq[2][2], cq[2][2];
#pragma unroll
        for (int bj = 0; bj < 2; ++bj) { gq[bj][0] = *(const f32x4*)(gp + bj * 128); gq[bj][1] = *(const f32x4*)(gp + bj * 128 + 4);
            if (colscale) { const float* cp = colscale + u.pn * BM + wc * 32 + 8 * fq + bj * 128; cq[bj][0] = *(const f32x4*)cp; cq[bj][1] = *(const f32x4*)(cp + 4); }
            else { cq[bj][0] = (f32x4){1.f, 1.f, 1.f, 1.f}; cq[bj][1] = cq[bj][0]; } }
        if (xin_mode == 0 && !ssq) {
#pragma unroll
            for (int ai = 0; ai < 2; ++ai) {
                u32x4 xr[4][2];
#pragma unroll
                for (int m = 0; m < 4; ++m)
#pragma unroll
                    for (int bj = 0; bj < 2; ++bj) xr[m][bj] = *(const u32x4*)(XW + (size_t)(row_base + u.pm * BM + ai * 128 + wr * 64 + m * 16 + fr) * DM + u.pn * BM + bj * 128 + wc * 32 + 8 * fq);
#pragma unroll
                for (int m = 0; m < 4; ++m)
#pragma unroll
                    for (int bj = 0; bj < 2; ++bj) {
                        bf16_t* xo = XW + (size_t)(row_base + u.pm * BM + ai * 128 + wr * 64 + m * 16 + fr) * DM + u.pn * BM + bj * 128 + wc * 32 + 8 * fq;
                        float t8[8]; unpack8(xr[m][bj], t8);
                        const f32x4 x0 = (f32x4){t8[0], t8[1], t8[2], t8[3]} + gq[bj][0] * (acc[ai][bj][m][0] * cq[bj][0]), x1 = (f32x4){t8[4], t8[5], t8[6], t8[7]} + gq[bj][1] * (acc[ai][bj][m][1] * cq[bj][1]);
                        u32x4 w_; w_.x = cvt_pk_bf16(x0[0], x0[1]); w_.y = cvt_pk_bf16(x0[2], x0[3]); w_.z = cvt_pk_bf16(x1[0], x1[1]); w_.w = cvt_pk_bf16(x1[2], x1[3]);
                        *(u32x4*)xo = w_;
                    }
                asm volatile("" ::: "memory");
            }
            return;
        }
#pragma unroll
        for (int ai = 0; ai < 2; ++ai)
#pragma unroll
            for (int m = 0; m < 4; ++m) {
                const int rl = ai * 128 + wr * 64 + m * 16 + fr, row = row_base + u.pm * BM + rl;
                float rs = 1.f;
                if (ssq) { const f32x4 q = *(const f32x4*)(ssq + (size_t)row * 4); rs = __builtin_amdgcn_rsqf(((q[0] + q[1]) + (q[2] + q[3])) * (1.f / 2048.f) + NORM_EPS); }
#pragma unroll
                for (int bj = 0; bj < 2; ++bj) {
                    const int col = u.pn * BM + bj * 128 + wc * 32 + 8 * fq;
                    const f32x4 a0 = acc[ai][bj][m][0] * rs * cq[bj][0], a1 = acc[ai][bj][m][1] * rs * cq[bj][1];
                    bf16_t* xo = XW + (size_t)row * DM + col;
                    f32x4 x0, x1;
                    if (xin_mode == 0) { float t8[8]; unpack8(*(const u32x4*)xo, t8); x0 = (f32x4){t8[0], t8[1], t8[2], t8[3]}; x1 = (f32x4){t8[4], t8[5], t8[6], t8[7]}; }
                    else { const float* xi = row < RC ? xin_c + (size_t)row * DM + col : xin_x + (size_t)(row - RC) * DM + col; x0 = *(const f32x4*)xi; x1 = *(const f32x4*)(xi + 4); }
                    x0 = x0 + gq[bj][0] * a0; x1 = x1 + gq[bj][1] * a1;
                    u32x4 w_; w_.x = cvt_pk_bf16(x0[0], x0[1]); w_.y = cvt_pk_bf16(x0[2], x0[3]); w_.z = cvt_pk_bf16(x1[0], x1[1]); w_.w = cvt_pk_bf16(x1[2], x1[3]);
                    *(u32x4*)xo = w_;
                }
                if (m & 1) asm volatile("" ::: "memory");
            }
    }
};
__device__ __forceinline__ float softplusf_(float x) { return x > 20.f ? x : log1pf(__expf(x)); }
struct EpiMbIn {
    bf16_t* Z; bf16_t* XBCP; float* DT; const float* dt_bias;
    __device__ __forceinline__ void operator()(const f32x4 (&acc)[2][2][4][2], const Unit& u, int wr, int wc, int fr, int fq) const {
        EPI_BEGIN
            const int row = u.pm * BM + rl, col = u.pn * BM + cl;
            if (col < MB_DI + MB_XBC) {
                u32x4 w; w.x = cvt_pk_bf16(v0[0], v0[1]); w.y = cvt_pk_bf16(v0[2], v0[3]); w.z = cvt_pk_bf16(v1[0], v1[1]); w.w = cvt_pk_bf16(v1[2], v1[3]);
                bf16_t* o = (col < MB_DI) ? Z + (size_t)row * MB_DI + col : XBCP + (size_t)row * MB_XBC + (col - MB_DI);
                *(u32x4*)o = w;
            } else if (col < MB_NIN) {
                const int c = col - (MB_DI + MB_XBC);
                const f32x4 b0 = *(const f32x4*)(dt_bias + c), b1 = *(const f32x4*)(dt_bias + c + 4);
                f32x4 o0, o1;
#pragma unroll
                for (int j = 0; j < 4; ++j) { o0[j] = softplusf_(v0[j] + b0[j]); o1[j] = softplusf_(v1[j] + b1[j]); }
                *(f32x4*)(DT + (size_t)row * 64 + c) = o0; *(f32x4*)(DT + (size_t)row * 64 + c + 4) = o1;
            }
        EPI_END
    }
};
struct EpiRwBig {
    bf16_t* RKV; bf16_t* L1;
    __device__ __forceinline__ void operator()(const f32x4 (&acc)[2][2][4][2], const Unit& u, int wr, int wc, int fr, int fq) const {
        EPI_BEGIN
            const int row = u.pm * BM + rl, col = u.pn * BM + cl;
            if (col < 3072) {
                bf16_t* o = RKV + (size_t)(col >> 10) * RT * DM + (size_t)row * DM + (col & 1023);
                u32x4 w; w.x = cvt_pk_bf16(v0[0], v0[1]); w.y = cvt_pk_bf16(v0[2], v0[3]); w.z = cvt_pk_bf16(v1[0], v1[1]); w.w = cvt_pk_bf16(v1[2], v1[3]);
                *(u32x4*)o = w;
            } else {
                const int c = col - 3072, tile = c >> 8, cc = c & 255;
                if (cc < 128) {
                    float t[8];
#pragma unroll
                    for (int j = 0; j < 4; ++j) { t[j] = v0[j]; t[4 + j] = v1[j]; }
                    if (tile == 0) {
#pragma unroll
                        for (int j = 0; j < 8; ++j) t[j] = tanhf(t[j]);
                    } else if (tile == 2) {
#pragma unroll
                        for (int j = 0; j < 8; ++j) t[j] = sigmoidf_(t[j]);
                    }
                    u32x4 w; w.x = cvt_pk_bf16(t[0], t[1]); w.y = cvt_pk_bf16(t[2], t[3]); w.z = cvt_pk_bf16(t[4], t[5]); w.w = cvt_pk_bf16(t[6], t[7]);
                    *(u32x4*)(L1 + (size_t)row * 384 + tile * 128 + cc) = w;
                }
            }
        EPI_END
    }
};
struct EpiRwL2 {
    float* WD; bf16_t* AD; bf16_t* GG; const float* w0; const float* a0;
    __device__ __forceinline__ void operator()(const f32x4 (&acc)[2][2][4][2], const Unit& u, int wr, int wc, int fr, int fq) const {
        EPI_BEGIN
            const int row = u.pm * BM + rl, col = u.pn * BM + cl, seg = col >> 10, c = col & 1023;
            if (seg < 4) {
                const float* bp = (seg < 2 ? w0 : a0) + (seg & 1) * DM + c;
                const f32x4 b0 = *(const f32x4*)bp, b1 = *(const f32x4*)(bp + 4); f32x4 o0, o1;
#pragma unroll
                for (int j = 0; j < 4; ++j) { const float s0 = sigmoidf_(v0[j] + b0[j]), s1 = sigmoidf_(v1[j] + b1[j]);
                    o0[j] = seg < 2 ? -0.606531f * s0 : s0; o1[j] = seg < 2 ? -0.606531f * s1 : s1; }
                if (seg < 2) { float* o = WD + (size_t)(seg & 1) * RT * DM + (size_t)row * DM + c; *(f32x4*)o = o0; *(f32x4*)(o + 4) = o1; }
                else { u32x4 w; w.x = cvt_pk_bf16(o0[0], o0[1]); w.y = cvt_pk_bf16(o0[2], o0[3]); w.z = cvt_pk_bf16(o1[0], o1[1]); w.w = cvt_pk_bf16(o1[2], o1[3]);
                    *(u32x4*)(AD + (size_t)(seg & 1) * RT * DM + (size_t)row * DM + c) = w; }
            } else {
                u32x4 w; w.x = cvt_pk_bf16(v0[0], v0[1]); w.y = cvt_pk_bf16(v0[2], v0[3]); w.z = cvt_pk_bf16(v1[0], v1[1]); w.w = cvt_pk_bf16(v1[2], v1[3]);
                *(u32x4*)(GG + (size_t)row * DM + c) = w;
            }
        EPI_END
    }
};
}

namespace attn_body {
using bf16 = __hip_bfloat16;
using f32x16 = __attribute__((ext_vector_type(16))) float;
constexpr int D = 64, DMQ = 1024, DKV = 256;
constexpr int NW = 8, QBLK = 32, QB = QBLK * NW, KVBLK = 64;
__device__ __forceinline__ int crow(int r, int hi) { return (r & 3) + 8 * (r >> 2) + 4 * hi; }
#define SBAR() __builtin_amdgcn_sched_barrier(0)
constexpr int NSLOT = 3, SLOTB = 8192;
constexpr int LDS_K = 0, LDS_V = NSLOT * SLOTB, LDS_WS = 2 * NSLOT * SLOTB, LDS_OST = LDS_WS + NW * 64 * 4, ATTN_LDS_BYTES = LDS_OST + NW * 4096;
constexpr float C2 = 0.125f * 1.4426950408889634f;
__device__ __forceinline__ void glds16(const void* gsrc, unsigned lds_dst) { unsigned keep;
    asm volatile("s_mov_b32 %0, m0\n\ts_mov_b32 m0, %2\n\ts_nop 0\n\tglobal_load_lds_dwordx4 %1, off\n\ts_mov_b32 m0, %0" : "=&s"(keep) : "v"(gsrc), "s"(lds_dst) : "memory"); }
__device__ __forceinline__ float max3f(float a, float b, float c) { float r; asm("v_max3_f32 %0, %1, %2, %3" : "=v"(r) : "v"(a), "v"(b), "v"(c)); return r; }
__device__ __forceinline__ float max2f(float a, float b) { float r; asm("v_max_f32_e32 %0, %1, %2" : "=v"(r) : "v"(a), "v"(b)); return r; }
__device__ __forceinline__ float fadd_s(float a, float b) { float r; asm("v_add_f32_e32 %0, %1, %2" : "=v"(r) : "v"(a), "v"(b)); return r; }
__device__ __forceinline__ float fsub_s(float a, float b) { float r; asm("v_sub_f32_e32 %0, %1, %2" : "=v"(r) : "v"(a), "v"(b)); return r; }
typedef float f32x2_t __attribute__((ext_vector_type(2))); typedef __bf16 bf16x2_t __attribute__((ext_vector_type(2)));
__device__ __forceinline__ unsigned cvtpk_s(float lo, float hi) { f32x2_t v = {lo, hi}; bf16x2_t b = __builtin_convertvector(v, bf16x2_t); return __builtin_bit_cast(unsigned, b); }
#define WAIT_BAR(N) asm volatile("s_waitcnt vmcnt(" #N ") lgkmcnt(0)\n\ts_barrier" ::: "memory")
__device__ __forceinline__ void qkt(f32x16& p0, f32x16& p1, const char* Kslot, const bf16x8* qr, const f32x16& negm, int r32, int hi) {
    const char* kb = Kslot + hi * 1024 + r32 * 16;
#pragma unroll
    for (int d0 = 0; d0 < 4; ++d0) {
        const bf16x8 b0 = *reinterpret_cast<const bf16x8*>(kb + d0 * 2048);
        const bf16x8 b1 = *reinterpret_cast<const bf16x8*>(kb + d0 * 2048 + 512);
        if (d0 == 0) { p0 = __builtin_amdgcn_mfma_f32_32x32x16_bf16(b0, qr[0], negm, 0, 0, 0); p1 = __builtin_amdgcn_mfma_f32_32x32x16_bf16(b1, qr[0], negm, 0, 0, 0); }
        else { p0 = __builtin_amdgcn_mfma_f32_32x32x16_bf16(b0, qr[d0], p0, 0, 0, 0); p1 = __builtin_amdgcn_mfma_f32_32x32x16_bf16(b1, qr[d0], p1, 0, 0, 0); } }
}
typedef __attribute__((address_space(3))) const char* lds_cptr;
typedef short v4i16_t __attribute__((ext_vector_type(4)));
__device__ __forceinline__ void kload8(bf16x8* kf, lds_cptr kp) {
    kf[0] = *(const LAS bf16x8*)(kp);        kf[1] = *(const LAS bf16x8*)(kp + 512);
    kf[2] = *(const LAS bf16x8*)(kp + 2048); kf[3] = *(const LAS bf16x8*)(kp + 2560);
    kf[4] = *(const LAS bf16x8*)(kp + 4096); kf[5] = *(const LAS bf16x8*)(kp + 4608);
    kf[6] = *(const LAS bf16x8*)(kp + 6144); kf[7] = *(const LAS bf16x8*)(kp + 6656);
}
__device__ __forceinline__ void kload2(bf16x8* kf, lds_cptr kp, int j) { kf[2 * j] = *(const LAS bf16x8*)(kp + j * 2048); kf[2 * j + 1] = *(const LAS bf16x8*)(kp + j * 2048 + 512); }
__device__ __forceinline__ s16x4 vtr(lds_cptr p) { return __builtin_bit_cast(s16x4, __builtin_amdgcn_ds_read_tr16_b64_v4i16((LAS v4i16_t*)p)); }
__device__ __forceinline__ float rowmax(const f32x16& p0, const f32x16& p1) {
    float a = max3f(p0[0], p0[1], p1[0]), b = max3f(p0[2], p0[3], p1[1]); a = max3f(a, p1[2], p1[3]);
#pragma unroll
    for (int r = 4; r < 16; r += 4) { a = max3f(a, p0[r], p0[r + 1]); b = max3f(b, p0[r + 2], p0[r + 3]); a = max3f(a, p1[r], p1[r + 1]); b = max3f(b, p1[r + 2], p1[r + 3]); }
    const float m = max2f(a, b);
    auto rr = __builtin_amdgcn_permlane32_swap(__float_as_uint(m), __float_as_uint(m), false, false);
    return max2f(__uint_as_float(rr[0]), __uint_as_float(rr[1]));
}
__device__ __forceinline__ void pv(f32x16* o, int vb, bf16x8 pa0, bf16x8 pa1, bf16x8 pa2, bf16x8 pa3) {
#pragma unroll
    for (int d0 = 0; d0 < 2; ++d0) { s16x4 lo[4], hi[4];
#pragma unroll
        for (int ks = 0; ks < 4; ++ks) {
            asm volatile("ds_read_b64_tr_b16 %0,%1 offset:%c2" : "=&v"(lo[ks]) : "v"(vb), "i"(d0 * 4096 + ks * 1024) : "memory");
            asm volatile("ds_read_b64_tr_b16 %0,%1 offset:%c2" : "=&v"(hi[ks]) : "v"(vb), "i"(d0 * 4096 + ks * 1024 + 512) : "memory"); }
        asm volatile("s_waitcnt lgkmcnt(0)" ::: "memory"); SBAR();
#define PK(k) (bf16x8){lo[k][0], lo[k][1], lo[k][2], lo[k][3], hi[k][0], hi[k][1], hi[k][2], hi[k][3]}
        o[d0] = __builtin_amdgcn_mfma_f32_32x32x16_bf16(pa0, PK(0), o[d0], 0, 0, 0);
        o[d0] = __builtin_amdgcn_mfma_f32_32x32x16_bf16(pa1, PK(1), o[d0], 0, 0, 0);
        o[d0] = __builtin_amdgcn_mfma_f32_32x32x16_bf16(pa2, PK(2), o[d0], 0, 0, 0);
        o[d0] = __builtin_amdgcn_mfma_f32_32x32x16_bf16(pa3, PK(3), o[d0], 0, 0, 0);
#undef PK
    }
}
template <int THRL> __device__ __forceinline__ void attn_unit(int b, int h, int qb, const bf16* Q  , const float* qgain, const float* rope, const bf16* __restrict__ K, const bf16* __restrict__ V, bf16* O, char* shm) {
    const int tid = threadIdx.x, lane = tid & 63, r32 = lane & 31, hi = lane >> 5; const int wid = __builtin_amdgcn_readfirstlane(tid >> 6);
    const long rowbase = (long)b * TL; const int q0 = qb * QB;
    const bf16* Qw = Q + ((long)RC + rowbase + q0 + wid * QBLK) * 1536 + h * D;
    const bf16* Kh = K + (long)b * KVL * DKV + (h >> 2) * D, *Vh = V + (long)b * KVL * DKV + (h >> 2) * D;
    const unsigned lds0 = (unsigned)(uintptr_t)shm;
    float* wsf = (float*)(shm + LDS_WS) + wid * 64;
    const bf16* ksrc = Kh + (long)lane * DKV + wid * 8;
    const bf16* vsrc = Vh + (long)(16 * (wid & 3) + (lane >> 2)) * DKV + (wid >> 2) * 32 + (lane & 3) * 8;
    const unsigned kdst = lds0 + LDS_K + wid * 1024, vdst = lds0 + LDS_V + wid * 1024;
#define DMA_K(t, slot) glds16(ksrc + (long)(t) * KVBLK * DKV, (unsigned)__builtin_amdgcn_readfirstlane(kdst + (slot)))
#define DMA_V(t, slot) glds16(vsrc + (long)(t) * KVBLK * DKV, (unsigned)__builtin_amdgcn_readfirstlane(vdst + (slot)))
    const int vb0 = (int)(lds0 + LDS_V) + ((lane >> 4) & 1) * 32 + (lane & 3) * 8 + (4 * hi + ((lane & 15) >> 2)) * 64;
    const char* Kbase = shm + LDS_K; bf16x8 kf[8];
    const lds_cptr shm3 = (lds_cptr)shm; const lds_cptr kp0 = shm3 + LDS_K + hi * 1024 + r32 * 16; const lds_cptr vp0 = shm3 + LDS_V + ((lane >> 4) & 1) * 32 + (lane & 3) * 8 + (4 * hi + ((lane & 15) >> 2)) * 64;
    constexpr int NT = KVL / KVBLK;
    DMA_K(0, 0); DMA_V(0, 0); DMA_K(1, SLOTB);
    bf16x8 qr[4];
#pragma unroll
    for (int d0 = 0; d0 < 4; ++d0) qr[d0] = *reinterpret_cast<const bf16x8*>(&Qw[(long)r32 * 1536 + d0 * 16 + hi * 8]);
    {
        float qf[4][8]; float ss = 0.f;
#pragma unroll
        for (int d0 = 0; d0 < 4; ++d0)
#pragma unroll
            for (int k = 0; k < 8; ++k) { qf[d0][k] = __uint_as_float(((unsigned)(unsigned short)qr[d0][k]) << 16); ss += qf[d0][k] * qf[d0][k]; }
        { auto rr = __builtin_amdgcn_permlane32_swap(__float_as_uint(ss), __float_as_uint(ss), false, false); ss = __uint_as_float(rr[0]) + __uint_as_float(rr[1]); }
        const float rstd = __builtin_amdgcn_rsqf(ss * (1.f / 64.f) + 1e-6f);
        const int tq = q0 + wid * QBLK + r32, prow = tq >> 6, pcol = tq & 63;
#pragma unroll
        for (int d0 = 0; d0 < 4; ++d0)
#pragma unroll
            for (int k = 0; k < 8; ++k) qf[d0][k] *= rstd * qgain[16 * d0 + 8 * hi + k];
#pragma unroll
        for (int hf = 0; hf < 2; ++hf) { const float* cs = rope + (hf ? pcol : prow) * 16 + 8 * hi; const float* sn = cs + 2048;
#pragma unroll
            for (int k = 0; k < 8; ++k) { const float c_ = cs[k], s_ = sn[k], x1 = qf[2 * hf][k], x2 = qf[2 * hf + 1][k];
                qf[2 * hf][k] = x1 * c_ - x2 * s_; qf[2 * hf + 1][k] = x2 * c_ + x1 * s_; } }
#pragma unroll
        for (int d0 = 0; d0 < 4; ++d0) { u32x4 pw;
            pw.x = cvtpk_s(qf[d0][0] * C2, qf[d0][1] * C2); pw.y = cvtpk_s(qf[d0][2] * C2, qf[d0][3] * C2); pw.z = cvtpk_s(qf[d0][4] * C2, qf[d0][5] * C2); pw.w = cvtpk_s(qf[d0][6] * C2, qf[d0][7] * C2);
            qr[d0] = __builtin_bit_cast(bf16x8, pw); }
    }
    constexpr float M0 = 12.f;
    float l_reg = 0.f; f32x16 o[2]; o[0] = f32x16{}; o[1] = f32x16{}; f32x16 negm;
    _Pragma("unroll") for (int r = 0; r < 16; ++r) negm[r] = -M0;
    asm volatile("" : "+v"(negm));
#define START(P0, P1) do { _Pragma("unroll") for (int r = 0; r < 16; ++r) P0[r] = __builtin_amdgcn_exp2f(P0[r]); } while (0)
#define RESC() do { } while (0)
    f32x16 pA0, pA1, pB0, pB1;
    int sl_prev = 0, sl_cur = 0, sl_next = SLOTB;
#define ROT() do { sl_prev = sl_cur; sl_cur = sl_next; sl_next = (sl_next == (NSLOT - 1) * SLOTB) ? 0 : sl_next + SLOTB; } while (0)
    DMA_K(2, 2 * SLOTB);
    WAIT_BAR(3);
    qkt(pA0, pA1, Kbase, qr, negm, r32, hi); asm volatile("s_nop 15\n\ts_nop 7" : "+v"(pA0), "+v"(pA1));
    START(pA0, pA1);
    _Pragma("unroll") for (int r = 0; r < 16; ++r) pA1[r] = __builtin_amdgcn_exp2f(pA1[r]);
    WAIT_BAR(0);
    DMA_K(3, 0); DMA_V(1, SLOTB);
    ROT();
    kload8(kf, kp0 + sl_cur);
    WAIT_BAR(2);
    s16x4 vlo[8], vhi[8]; u32x4 pw0, pw1, pw2, pw3;
#define PKW(P, B) cvtpk_s(P[B], P[B + 1])
#define PAF(k) __builtin_bit_cast(bf16x8, pw##k)
#define VFR(i) (bf16x8){vlo[i][0], vlo[i][1], vlo[i][2], vlo[i][3], vhi[i][0], vhi[i][1], vhi[i][2], vhi[i][3]}
#define PIN(x) asm volatile("" : "+v"(x))
#define MX3(a, b, c) __builtin_fmaxf(__builtin_fmaxf((a), (b)), (c))
#define GAPA(MF, A0, A1, A2, A3, W0, W1, PW) do { MF; sacc += A0; sacc += A1; sacc += A2; sacc += A3; PIN(sacc); W0; W1; PIN(PW); SBAR(); } while (0)
#define EX(v) __builtin_amdgcn_exp2f(v)
#define GAPB(MF, X, B) do { MF; X[B] = EX(X[B]); X[B + 1] = EX(X[B + 1]); X[B + 2] = EX(X[B + 2]); X[B + 3] = EX(X[B + 3]); PIN(X); SBAR(); } while (0)
#define VRD(i) do { vlo[i] = vtr(vp_ + (((i) >> 2) * 4096 + ((i) & 3) * 1024)); vhi[i] = vtr(vp_ + (((i) >> 2) * 4096 + ((i) & 3) * 1024 + 512)); } while (0)
#define KRD(G, j) do { if (G) { kload2(kf, kp0 + sl_next, j); SBAR(); } } while (0)
#define STEP(C0, C1, P0, P1, t, GK, GV, GL) do { SBAR(); \
    const lds_cptr vp_ = vp0 + sl_prev; \
    VRD(0); SBAR(); float sacc = (P0[0] + P0[1]); \
    GAPA(C0 = __builtin_amdgcn_mfma_f32_32x32x16_bf16(kf[0], qr[0], negm, 0, 0, 0), P0[2], P0[3], P0[4], P0[5],     pw0[0] = PKW(P0, 0), pw0[1] = PKW(P0, 2), pw0); \
    VRD(4); SBAR(); GAPA(C1 = __builtin_amdgcn_mfma_f32_32x32x16_bf16(kf[1], qr[0], negm, 0, 0, 0), P0[6], P0[7], P0[8], P0[9],     pw0[2] = PKW(P0, 4), pw0[3] = PKW(P0, 6), pw0); \
    VRD(1); SBAR(); GAPA(C0 = __builtin_amdgcn_mfma_f32_32x32x16_bf16(kf[2], qr[1], C0, 0, 0, 0),   P0[10], P0[11], P0[12], P0[13], pw1[0] = PKW(P0, 8), pw1[1] = PKW(P0, 10), pw1); \
    VRD(5); SBAR(); GAPA(C1 = __builtin_amdgcn_mfma_f32_32x32x16_bf16(kf[3], qr[1], C1, 0, 0, 0),   P0[14], P0[15], P1[0], P1[1],   pw1[2] = PKW(P0, 12), pw1[3] = PKW(P0, 14), pw1); \
    VRD(2); SBAR(); GAPA(C0 = __builtin_amdgcn_mfma_f32_32x32x16_bf16(kf[4], qr[2], C0, 0, 0, 0),   P1[2], P1[3], P1[4], P1[5],     pw2[0] = PKW(P1, 0), pw2[1] = PKW(P1, 2), pw2); \
    VRD(6); SBAR(); GAPA(C1 = __builtin_amdgcn_mfma_f32_32x32x16_bf16(kf[5], qr[2], C1, 0, 0, 0),   P1[6], P1[7], P1[8], P1[9],     pw2[2] = PKW(P1, 4), pw2[3] = PKW(P1, 6), pw2); \
    VRD(3); SBAR(); GAPA(C0 = __builtin_amdgcn_mfma_f32_32x32x16_bf16(kf[6], qr[3], C0, 0, 0, 0),   P1[10], P1[11], P1[12], P1[13], pw3[0] = PKW(P1, 8), pw3[1] = PKW(P1, 10), pw3); \
    VRD(7); SBAR(); GAPA(C1 = __builtin_amdgcn_mfma_f32_32x32x16_bf16(kf[7], qr[3], C1, 0, 0, 0),   P1[14], P1[15], 0.f, 0.f,       pw3[2] = PKW(P1, 12), pw3[3] = PKW(P1, 14), pw3); \
    l_reg += sacc; \
    if (GK) { DMA_K((t) + 3, sl_cur); } if (GV) { DMA_V((t) + 1, sl_next); } \
    SBAR(); \
    GAPB(o[0] = __builtin_amdgcn_mfma_f32_32x32x16_bf16(PAF(0), VFR(0), o[0], 0, 0, 0), C0, 0); \
    GAPB(o[1] = __builtin_amdgcn_mfma_f32_32x32x16_bf16(PAF(0), VFR(4), o[1], 0, 0, 0), C0, 4); \
    KRD(GL, 0); GAPB(o[0] = __builtin_amdgcn_mfma_f32_32x32x16_bf16(PAF(1), VFR(1), o[0], 0, 0, 0), C0, 8); \
    KRD(GL, 1); GAPB(o[1] = __builtin_amdgcn_mfma_f32_32x32x16_bf16(PAF(1), VFR(5), o[1], 0, 0, 0), C0, 12); \
    KRD(GL, 2); GAPB(o[0] = __builtin_amdgcn_mfma_f32_32x32x16_bf16(PAF(2), VFR(2), o[0], 0, 0, 0), C1, 0); \
    KRD(GL, 3); GAPB(o[1] = __builtin_amdgcn_mfma_f32_32x32x16_bf16(PAF(2), VFR(6), o[1], 0, 0, 0), C1, 4); \
    GAPB(o[0] = __builtin_amdgcn_mfma_f32_32x32x16_bf16(PAF(3), VFR(3), o[0], 0, 0, 0), C1, 8); \
    GAPB(o[1] = __builtin_amdgcn_mfma_f32_32x32x16_bf16(PAF(3), VFR(7), o[1], 0, 0, 0), C1, 12); \
    } while (0)
    int t = 1;
    for (; t + 5 < NT; t += 2) {
        STEP(pB0, pB1, pA0, pA1, t, true, true, true);     WAIT_BAR(2); RESC(); ROT();
        STEP(pA0, pA1, pB0, pB1, t + 1, true, true, true); WAIT_BAR(2); RESC(); ROT();
    }
#define ENDW(tt) do { if ((tt) + 3 < NT) { WAIT_BAR(2); } else if ((tt) + 2 < NT) { WAIT_BAR(1); } else { WAIT_BAR(0); } } while (0)
    for (; t + 1 < NT; t += 2) {
        STEP(pB0, pB1, pA0, pA1, t, (t + 3 < NT), (t + 1 < NT), (t + 1 < NT));         ENDW(t);     RESC(); ROT();
        STEP(pA0, pA1, pB0, pB1, t + 1, (t + 4 < NT), (t + 2 < NT), (t + 2 < NT));     ENDW(t + 1); RESC(); ROT();
    }
    STEP(pB0, pB1, pA0, pA1, NT - 1, false, false, false); RESC();
    { float sacc = pB0[0] + pB0[1]; _Pragma("unroll") for (int r = 2; r < 16; ++r) sacc += pB0[r]; _Pragma("unroll") for (int r = 0; r < 16; ++r) sacc += pB1[r]; l_reg += sacc;
      pw0 = (u32x4){PKW(pB0, 0), PKW(pB0, 2), PKW(pB0, 4), PKW(pB0, 6)}; pw1 = (u32x4){PKW(pB0, 8), PKW(pB0, 10), PKW(pB0, 12), PKW(pB0, 14)}; pw2 = (u32x4){PKW(pB1, 0), PKW(pB1, 2), PKW(pB1, 4), PKW(pB1, 6)}; pw3 = (u32x4){PKW(pB1, 8), PKW(pB1, 10), PKW(pB1, 12), PKW(pB1, 14)};
      SBAR(); pv(o, vb0 + sl_cur, PAF(0), PAF(1), PAF(2), PAF(3)); }
#undef PKW
#undef PAF
#undef VFR
#undef PIN
#undef MX3
#undef GAPA
#undef GAPB
#undef EX
#undef VRD
#undef KRD
#undef STEP
#undef ENDW
    { auto rr = __builtin_amdgcn_permlane32_swap(__float_as_uint(l_reg), __float_as_uint(l_reg), false, false); l_reg = __uint_as_float(rr[0]) + __uint_as_float(rr[1]); }
    if (hi == 0) wsf[32 + r32] = l_reg; asm volatile("s_waitcnt lgkmcnt(0)" ::: "memory");
    float rli[16];
#pragma unroll
    for (int r = 0; r < 16; ++r) rli[r] = __builtin_amdgcn_rcpf(wsf[32 + crow(r, hi)]);
    bf16* Ow = O + (rowbase + q0 + wid * QBLK) * DMQ + h * D;
    { bf16* stg = (bf16*)(shm + LDS_OST) + wid * 2048;
#pragma unroll
      for (int r = 0; r < 16; ++r) { const int orow = crow(r, hi);
#pragma unroll
          for (int d0 = 0; d0 < 2; ++d0) stg[orow * 64 + d0 * 32 + r32] = __float2bfloat16(o[d0][r] * rli[r]); }
      asm volatile("s_waitcnt lgkmcnt(0)" ::: "memory");
#pragma unroll
      for (int i = 0; i < 4; ++i) { const int row = i * 8 + (lane >> 3), ch = lane & 7; const u32x4 v = *(const u32x4*)(stg + row * 64 + ch * 8); *(u32x4*)(Ow + (long)row * DMQ + ch * 8) = v; } }
    asm volatile("s_waitcnt lgkmcnt(0)\n\ts_barrier" ::: "memory");
#undef DMA_K
#undef DMA_V
#undef START
#undef RESC
#undef ROT
}
#undef SBAR
#undef WAIT_BAR
}

struct Args { const float* in[44]; float* out; unsigned char* ws; int ph_lo, ph_hi, li, pad; };
enum { I_X = 0, I_C, I_CTX, I_CCTX, I_MODW, I_MODB, I_N1G, I_N2G, I_FG, I_MBIN, I_MBCW, I_MBCB, I_MBDTB, I_MBALOG, I_MBD, I_MBNG, I_MBOUT,
       I_RWMIX, I_RWRKV, I_RWW0, I_RWW1, I_RWW2, I_RWA0, I_RWA1, I_RWA2, I_RWG1, I_RWG2, I_RWKK, I_RWKA, I_RWRK, I_RWLNG, I_RWLNB, I_RWOUT,
       I_PLW, I_PLS, I_ATQKV, I_ATQG, I_ATKG, I_ATOUT, I_FFIN, I_FFOUT, I_MOER, I_MOEIN, I_MOEOUT };

struct Frame {
    LAS unsigned char* lds; unsigned char* ws; const float* const* in; float* out;
    int tid, lane, wave, G, vcu;
};
#define WSP(T, off) ((T*)(F.ws + (off)))
#define SCR(T, off) ((T*)(F.ws + WS_SCR + (off)))

constexpr int NL_GS = 0, NL_SH = 3 * DM * 4, NL_X = 6 * DM * 4;
__device__ __forceinline__ void stage_norm_params(const Frame& F, const float* g, const float* MOD, int which) {
    LAS float* GS = (LAS float*)(F.lds + NL_GS); LAS float* SH = (LAS float*)(F.lds + NL_SH);
    for (int i = F.tid; i < 3 * DM; i += NWAVES * 64) { const int s = i >> 10, c = i & 1023; const float* shift = MOD + (size_t)s * 6144 + (which ? 3 : 0) * DM;
        GS[i] = g[c] * (shift[DM + c] + 1.0f); SH[i] = shift[c]; }
}
struct XRow { f32x4 f[4]; u32x2 r[4]; };
__device__ __forceinline__ void xrow_load(const Frame& F, int src_inputs, int row, int lane, XRow& x) {
    if (src_inputs) { const float* xr = row < RC ? F.in[I_CTX] + (size_t)row * DM : F.in[I_X] + (size_t)(row - RC) * DM;
#pragma unroll
        for (int j = 0; j < 4; ++j) x.f[j] = *(const f32x4*)(xr + 4 * lane + 256 * j);
    } else { const bf16_t* xr = WSP(bf16_t, WS_XW) + (size_t)row * DM;
#pragma unroll
        for (int j = 0; j < 4; ++j) x.r[j] = *(const u32x2*)(xr + 4 * lane + 256 * j); }
}
__device__ __forceinline__ void xrow_get(int src_inputs, const XRow& x, f32x4 (&v)[4]) {
#pragma unroll
    for (int j = 0; j < 4; ++j) v[j] = src_inputs ? x.f[j] : (f32x4){bflo(x.r[j].x), bfhi(x.r[j].x), bflo(x.r[j].y), bfhi(x.r[j].y)};
}
__device__ __forceinline__ void norm_regs(f32x4 (&v)[4], LAS const float* GSs, LAS const float* SHs, int lane) {
    float s = 0.f;
#pragma unroll
    for (int j = 0; j < 4; ++j) s += (v[j][0] * v[j][0] + v[j][1] * v[j][1]) + (v[j][2] * v[j][2] + v[j][3] * v[j][3]);
    const float rstd = __builtin_amdgcn_rsqf(wave_sum(s) * (1.f / DM) + NORM_EPS);
#pragma unroll
    for (int j = 0; j < 4; ++j) { const int c = 4 * lane + 256 * j; v[j] = v[j] * rstd * *(LAS const f32x4*)(GSs + c) + *(LAS const f32x4*)(SHs + c); }
}
__device__ __forceinline__ void store_row_bf16(bf16_t* o, int lane, const f32x4 (&v)[4]) {
#pragma unroll
    for (int j = 0; j < 4; ++j) { u32x2 w; w.x = pk2(v[j][0], v[j][1]); w.y = pk2(v[j][2], v[j][3]); *(u32x2*)(o + 4 * lane + 256 * j) = w; }
}
__device__ __forceinline__ void route_row(const Frame& F, LAS const float* rw, int row, const f32x4 (&v)[4]) {
    float lg[8];
#pragma unroll
    for (int e = 0; e < 8; ++e) lg[e] = 0.f;
#pragma unroll
    for (int j = 0; j < 4; ++j)
#pragma unroll
        for (int i = 0; i < 4; ++i) { const f32x4 w0 = *(LAS const f32x4*)(rw + (((4 * j + i) * 2 + 0) * 64 + F.lane) * 4), w1 = *(LAS const f32x4*)(rw + (((4 * j + i) * 2 + 1) * 64 + F.lane) * 4);
#pragma unroll
            for (int e = 0; e < 4; ++e) { lg[e] += v[j][i] * w0[e]; lg[4 + e] += v[j][i] * w1[e]; } }
#pragma unroll
    for (int e = 0; e < 8; ++e) lg[e] = wave_sum(lg[e]);
    if (F.lane == 0) {
        int e0 = 0; float m0 = lg[0];
#pragma unroll
        for (int e = 1; e < 8; ++e) if (lg[e] > m0) { m0 = lg[e]; e0 = e; }
        int e1 = -1; float m1 = -INFINITY;
#pragma unroll
        for (int e = 0; e < 8; ++e) if (e != e0 && lg[e] > m1) { m1 = lg[e]; e1 = e; }
        if (e1 < 0) { e1 = (e0 == 0) ? 1 : 0; m1 = m0; }
        const float p1 = __expf(m1 - m0), inv = 1.f / (1.f + p1);
        WSP(int, WS_SEL)[row] = e0 | (e1 << 8);
        WSP(float, WS_WTS)[2 * row] = inv; WSP(float, WS_WTS)[2 * row + 1] = p1 * inv;
    }
}
struct CtxFix { const float* gate; const float* ssq; int xin_inputs; int S; };
template <int MODE>
__device__ __forceinline__ void p_norm(const Frame& F, int layer, int which, int src_inputs, int row_lo, const CtxFix fx = CtxFix{nullptr, nullptr, 0, 0}) {
    const float* g = F.in[which ? I_N2G : I_N1G] + layer * DM;
    const float* MOD = WSP(float, WS_MOD) + (size_t)layer * 3 * 6144;
    bf16_t* H = WSP(bf16_t, WS_H);
    LAS const float* GS = (LAS const float*)(F.lds + NL_GS); LAS const float* SH = (LAS const float*)(F.lds + NL_SH); LAS float* RW8 = (LAS float*)(F.lds + NL_X);
    stage_norm_params(F, g, MOD, which);
    if (MODE == 2) { const float* rw = F.in[I_MOER] + (size_t)(layer >> 1) * DM * 8;
        for (int i = F.tid; i < DM * 8; i += NWAVES * 64) { const int c = i >> 3, e8 = i & 7, j = c >> 8, l = (c & 255) >> 2, q = c & 3; RW8[(((4 * j + q) * 2 + (e8 >> 2)) * 64 + l) * 4 + (e8 & 3)] = rw[i]; } }
    __syncthreads();
    const int gw = F.vcu * NWAVES + F.wave, NGW = F.G * NWAVES;
    auto process = [&](const XRow& xr, int row) {
        const int s = row_sample(row);
        f32x4 v[4]; xrow_get(src_inputs, xr, v);
        if (fx.S > 0 && row < RC) {
            const float* PART = SCR(float, S_PARTC); bf16_t* XW = WSP(bf16_t, WS_XW);
            float rs = 1.f;
            if (fx.ssq) { f32x4 q = (f32x4){0.f, 0.f, 0.f, 0.f};
#pragma unroll
                for (int k = 0; k < 8; ++k) q += *(const f32x4*)(fx.ssq + (size_t)row * 32 + 4 * k);
                rs = __builtin_amdgcn_rsqf(((q[0] + q[1]) + (q[2] + q[3])) * (1.f / 2048.f) + NORM_EPS); }
#pragma unroll
            for (int j = 0; j < 4; ++j) { const int c = 4 * F.lane + 256 * j; f32x4 a = (f32x4){0.f, 0.f, 0.f, 0.f};
                for (int ks = 0; ks < fx.S; ++ks) a += *(const f32x4*)(PART + ((size_t)ks * RC + row) * DM + c);
                const f32x4 xi = fx.xin_inputs ? *(const f32x4*)(F.in[I_CTX] + (size_t)row * DM + c) : v[j];
                v[j] = xi + *(const f32x4*)(fx.gate + c) * a * rs; st_x4(XW + (size_t)row * DM + c, v[j]); }
        }
        norm_regs(v, GS + s * DM, SH + s * DM, F.lane);
        store_row_bf16(H + (size_t)row * DM, F.lane, v);
        if (MODE == 2) route_row(F, RW8, row, v);
    };
    XRow b0, b1, b2, b3;
    int row = row_lo + gw;
    if (row < RT) xrow_load(F, src_inputs, row, F.lane, b0);
    if (row + NGW < RT) xrow_load(F, src_inputs, row + NGW, F.lane, b1);
    if (row + 2 * NGW < RT) xrow_load(F, src_inputs, row + 2 * NGW, F.lane, b2);
    for (; row < RT; row += 4 * NGW) {
        if (row + 3 * NGW < RT) xrow_load(F, src_inputs, row + 3 * NGW, F.lane, b3);
        process(b0, row);
        if (row + NGW >= RT) break;
        if (row + 4 * NGW < RT) xrow_load(F, src_inputs, row + 4 * NGW, F.lane, b0);
        process(b1, row + NGW);
        if (row + 2 * NGW >= RT) break;
        if (row + 5 * NGW < RT) xrow_load(F, src_inputs, row + 5 * NGW, F.lane, b1);
        process(b2, row + 2 * NGW);
        if (row + 3 * NGW >= RT) break;
        if (row + 6 * NGW < RT) xrow_load(F, src_inputs, row + 6 * NGW, F.lane, b2);
        process(b3, row + 3 * NGW);
    }
}
__device__ __forceinline__ void p_norm_rw(const Frame& F, int layer) {
    const float* g = F.in[I_N1G] + layer * DM;
    const float* MOD = WSP(float, WS_MOD) + (size_t)layer * 3 * 6144;
    bf16_t* X6 = SCR(bf16_t, S_X6);
    LAS const float* GS = (LAS const float*)(F.lds + NL_GS); LAS const float* SH = (LAS const float*)(F.lds + NL_SH); LAS float* MIX = (LAS float*)(F.lds + NL_X);
    stage_norm_params(F, g, MOD, 0);
    for (int i = F.tid; i < 6 * DM; i += NWAVES * 64) MIX[i] = F.in[I_RWMIX][i];
    __syncthreads();
    const int gw = F.vcu * NWAVES + F.wave, NGW = F.G * NWAVES;
    const int n4 = ((RT / 4) / NGW) * NGW, nitems = n4 + (RT - 4 * n4);
    for (int idx = gw; idx < nitems; idx += NGW) {
        const int r0 = idx < n4 ? 4 * idx : 4 * n4 + (idx - n4), nr = idx < n4 ? 4 : 1;
        const int s_ = row_sample(r0);
        const int start = r0 < RC ? (r0 & ~(TC - 1)) : RC + ((r0 - RC) & ~(TL - 1)), len = r0 < RC ? TC : TL, t0 = r0 - start;
        XRow xr[6]; unsigned okm = 0u;
#pragma unroll
        for (int q = 0; q < 6; ++q) { const int t = t0 - 1 + q; const bool ok = (q <= nr + 1) && t >= 0 && t < len; if (ok) { okm |= 1u << q; xrow_load(F, 0, r0 - 1 + q, F.lane, xr[q]); } }
        f32x4 hp[4], hc[4], hn[4];
#define NRW_ROW(dst, q) do { if ((okm >> (q)) & 1u) { xrow_get(0, xr[q], dst); norm_regs(dst, GS + s_ * DM, SH + s_ * DM, F.lane); } \
            else { _Pragma("unroll") for (int j = 0; j < 4; ++j) dst[j] = (f32x4){0.f, 0.f, 0.f, 0.f}; } } while (0)
        NRW_ROW(hp, 0); NRW_ROW(hc, 1);
#pragma unroll
        for (int i = 0; i < 4; ++i) {
            if (i < nr) {
                NRW_ROW(hn, i + 2);
                f32x4 xx[4];
#pragma unroll
                for (int j = 0; j < 4; ++j) xx[j] = (hp[j] + hn[j]) * 0.5f - hc[j];
#pragma unroll
                for (int m = 0; m < 6; ++m) { f32x4 o[4];
#pragma unroll
                    for (int j = 0; j < 4; ++j) o[j] = hc[j] + xx[j] * *(LAS const f32x4*)(MIX + m * DM + 4 * F.lane + 256 * j);
                    store_row_bf16(X6 + (size_t)m * RT * DM + (size_t)(r0 + i) * DM, F.lane, o); }
#pragma unroll
                for (int j = 0; j < 4; ++j) { hp[j] = hc[j]; hc[j] = hn[j]; }
            }
        }
#undef NRW_ROW
    }
}

__device__ __forceinline__ void p_mb_conv(const Frame& F) {
    const bf16_t* P = SCR(bf16_t, S_XBCP); bf16_t* O = SCR(bf16_t, S_XBC);
    const float* cw = F.in[I_MBCW]; const float* cb = F.in[I_MBCB];
    constexpr int NCH = MB_XBC / 8, NSTRIP = RT / 16;
    for (int i = blockIdx.x * (NWAVES * 64) + F.tid; i < NSTRIP * NCH; i += F.G * NWAVES * 64) {
        const int strip = i / NCH, c = (i % NCH) * 8, row0 = strip * 16;
        const int start = row0 < RC ? (row0 & ~(TC - 1)) : RC + ((row0 - RC) & ~(TL - 1)), len = row0 < RC ? TC : TL, t0 = row0 - start;
        float w[5][8], bias[8];
#pragma unroll
        for (int j = 0; j < 5; ++j) { const f32x4 w0 = *(const f32x4*)(cw + j * MB_XBC + c), w1 = *(const f32x4*)(cw + j * MB_XBC + c + 4);
#pragma unroll
            for (int k = 0; k < 4; ++k) { w[j][k] = w0[k]; w[j][4 + k] = w1[k]; } }
        { const f32x4 b0 = *(const f32x4*)(cb + c), b1 = *(const f32x4*)(cb + c + 4);
#pragma unroll
          for (int k = 0; k < 4; ++k) { bias[k] = b0[k]; bias[4 + k] = b1[k]; } }
        u32x4 raw[20];
#pragma unroll
        for (int r = 0; r < 20; ++r) { const int tt = t0 + r - 2; raw[r] = (tt >= 0 && tt < len) ? *(const u32x4*)(P + (size_t)(start + tt) * MB_XBC + c) : (u32x4){0u, 0u, 0u, 0u}; }
#pragma unroll
        for (int r = 0; r < 16; ++r) {
            float acc[8];
#pragma unroll
            for (int k = 0; k < 8; ++k) acc[k] = bias[k];
#pragma unroll
            for (int j = 0; j < 5; ++j) { float x[8]; unpack8(raw[r + j], x);
#pragma unroll
                for (int k = 0; k < 8; ++k) acc[k] += w[j][k] * x[k]; }
#pragma unroll
            for (int k = 0; k < 8; ++k) acc[k] = siluf_(acc[k]);
            *(u32x4*)(O + (size_t)(row0 + r) * MB_XBC + c) = pack8(acc);
        }
    }
}
__device__ __forceinline__ int sc_row0(int sc) { return sc < 4 ? (sc >> 1) * TC + (sc & 1) * MB_CH : RC + ((sc - 4) >> 6) * TL + ((sc - 4) & 63) * MB_CH; }
__device__ __forceinline__ bf16x8 tr_frag(LAS const unsigned char* base, int ldb, int k0, int n0, int lane) {
    const int g = lane >> 4, q = (lane & 15) >> 2, p = lane & 3;
    LAS const unsigned char* a = base + (k0 + 8 * g + q) * ldb + (n0 + 4 * p) * 2;
    typedef short v4i16_t __attribute__((ext_vector_type(4)));
    const v4i16_t lo = __builtin_amdgcn_ds_read_tr16_b64_v4i16((LAS v4i16_t*)a);
    const v4i16_t hi = __builtin_amdgcn_ds_read_tr16_b64_v4i16((LAS v4i16_t*)(a + 4 * ldb));
    return (bf16x8){lo[0], lo[1], lo[2], lo[3], hi[0], hi[1], hi[2], hi[3]};
}
struct MbScanIn { float dv[4], al[2]; };
__device__ __forceinline__ void mb_scans_load(const Frame& F, int row0, int g, MbScanIn& m) {
    const float* DT = SCR(float, S_DT);
#pragma unroll
    for (int k = 0; k < 4; ++k) { const int i = F.tid + k * (NWAVES * 64), q = i >> 4, p = i & 15; m.dv[k] = DT[(size_t)(row0 + q) * 64 + (p >> 3) * 32 + g * 8 + (p & 7)]; }
#pragma unroll
    for (int pp = 0; pp < 2; ++pp) { const int p = F.wave * 2 + pp, d = p >> 3, hd = g * 8 + (p & 7); m.al[pp] = F.in[I_MBALOG][d * 32 + hd]; }
}
__device__ __forceinline__ void mb_scans(const Frame& F, const MbScanIn& m, LAS float* dts, LAS float* cum, LAS float* tot) {
#pragma unroll
    for (int k = 0; k < 4; ++k) { const int i = F.tid + k * (NWAVES * 64), q = i >> 4, p = i & 15; dts[p * 128 + q] = m.dv[k]; }
    __syncthreads();
#pragma unroll
    for (int pp = 0; pp < 2; ++pp) {
        const int p = F.wave * 2 + pp, d = p >> 3;
        const float a = -__expf(m.al[pp]);
        const float v0 = dts[p * 128 + 2 * F.lane] * a, v1 = dts[p * 128 + 2 * F.lane + 1] * a;
        float inc = v0 + v1;
#pragma unroll
        for (int o = 1; o < 64; o <<= 1) { const float t = __shfl_up(inc, o); if (F.lane >= o) inc += t; }
        const float total = __shfl(inc, 63), exc = inc - (v0 + v1);
        if (d == 0) { cum[p * 128 + 2 * F.lane] = exc + v0; cum[p * 128 + 2 * F.lane + 1] = inc; }
        else { cum[p * 128 + 2 * F.lane] = total - exc; cum[p * 128 + 2 * F.lane + 1] = total - exc - v0; }
        if (F.lane == 0) tot[p] = total;
    }
    __syncthreads();
}
__device__ __forceinline__ void p_mb_states(const Frame& F) {
    const bf16_t* XBC = SCR(bf16_t, S_XBC); bf16_t* ST = SCR(bf16_t, S_ST); float* DTOT = SCR(float, S_DTOT);
    LAS unsigned char* bmS = F.lds;
    LAS unsigned char* xwS = F.lds + 34816;
    LAS float* dts = (LAS float*)(F.lds + 34816 + 4 * 18432);
    LAS float* cum = dts + 2048; LAS float* tot = cum + 2048;
    const int lane = F.lane, fr = lane & 15, fq = lane >> 4, tid = F.tid;
    for (int u = blockIdx.x; u < 512 + 128; u += F.G) {
        int sc, g, e_lo, e_hi;
        if (u < 512) { sc = 4 + (u >> 2); g = u & 3; e_lo = 0; e_hi = 8; }
        else { const int v = u - 512; sc = v >> 5; g = (v >> 3) & 3; e_lo = v & 7; e_hi = e_lo + 1; }
        const int row0 = sc_row0(sc);
        u32x4 pX[2];
#define MBS_PREFETCH(e_) do { _Pragma("unroll") for (int i = 0; i < 2; ++i) { const int idx = tid + i * 512; pX[i] = *(const u32x4*)(XBC + (size_t)(row0 + (idx >> 3)) * MB_XBC + (g * 8 + (e_)) * 64 + (idx & 7) * 8); } } while (0)
        MbScanIn msi; mb_scans_load(F, row0, g, msi);
        u32x4 bmr[4];
#pragma unroll
        for (int k = 0; k < 4; ++k) { const int i = tid + k * (NWAVES * 64), q = i >> 4, ch = i & 15; bmr[k] = *(const u32x4*)(XBC + (size_t)(row0 + q) * MB_XBC + MB_DI + g * 128 + ch * 8); }
        MBS_PREFETCH(e_lo);
#pragma unroll
        for (int k = 0; k < 4; ++k) { const int i = tid + k * (NWAVES * 64), q = i >> 4, ch = i & 15; *(LAS u32x4*)(bmS + q * 272 + ch * 16) = bmr[k]; }
        mb_scans(F, msi, dts, cum, tot);
        if (tid < 16 && (tid & 7) >= e_lo && (tid & 7) < e_hi) DTOT[(size_t)sc * 64 + (tid >> 3) * 32 + g * 8 + (tid & 7)] = tot[tid];
        for (int i = tid; i < 2048; i += NWAVES * 64) { const int p = i >> 7; dts[i] = __expf(tot[p] - cum[i]) * dts[i]; }
        __syncthreads();
        bf16x8 af[4];
#pragma unroll
        for (int kk = 0; kk < 4; ++kk) af[kk] = tr_frag(bmS, 272, 32 * kk, 16 * F.wave, lane);
        for (int e = e_lo; e < e_hi; ++e) {
            const int hd = g * 8 + e;
            LAS unsigned char* xw = xwS + (e & 1) * 2 * 18432;
#pragma unroll
            for (int i = 0; i < 2; ++i) { const int idx = tid + i * 512, q = idx >> 3, ch = idx & 7; float x[8], y[8];
                unpack8(pX[i], x); const float wf_ = dts[e * 128 + q], wb_ = dts[(8 + e) * 128 + q];
#pragma unroll
                for (int k = 0; k < 8; ++k) { y[k] = x[k] * wb_; x[k] *= wf_; }
                *(LAS u32x4*)(xw + q * 144 + ch * 16) = pack8(x); *(LAS u32x4*)(xw + 18432 + q * 144 + ch * 16) = pack8(y); }
            __syncthreads();
            if (e + 1 < e_hi) MBS_PREFETCH(e + 1);
#pragma unroll
            for (int d = 0; d < 2; ++d) {
                bf16_t* so = ST + (((size_t)sc * 2 + d) * 32 + hd) * 8192;
#pragma unroll
                for (int pt = 0; pt < 4; ++pt) {
                    f32x4 acc = (f32x4){0.f, 0.f, 0.f, 0.f};
#pragma unroll
                    for (int kk = 0; kk < 4; ++kk) acc = __builtin_amdgcn_mfma_f32_16x16x32_bf16(af[kk], tr_frag(xw + d * 18432, 144, 32 * kk, 16 * pt, lane), acc, 0, 0, 0);
                    u32x2 w_; w_.x = pk2(acc[0], acc[1]); w_.y = pk2(acc[2], acc[3]);
                    *(u32x2*)(so + (size_t)(16 * pt + fr) * 128 + 16 * F.wave + 4 * fq) = w_;
                }
            }
        }
#undef MBS_PREFETCH
        __syncthreads();
    }
}
__device__ __forceinline__ void p_mb_carry(const Frame& F) {
    bf16_t* ST = SCR(bf16_t, S_ST); const float* DTOT = SCR(float, S_DTOT);
    for (int i = blockIdx.x * (NWAVES * 64) + F.tid; i < 2 * 2 * 32 * 1024; i += F.G * NWAVES * 64) {
        const int e8 = i & 1023, hd = (i >> 10) & 31, d = (i >> 15) & 1, b = i >> 16;
        float S[8];
#pragma unroll
        for (int k = 0; k < 8; ++k) S[k] = 0.f;
        for (int s0 = 0; s0 < 66; s0 += 6) {
            bf16_t* p[6]; u32x4 raw[6]; float dec[6];
#pragma unroll
            for (int k = 0; k < 6; ++k) { const int step = s0 + k; int sc;
                if (d == 0) sc = step < 2 ? 2 * b + step : 4 + b * 64 + (step - 2);
                else sc = step < 2 ? 2 * b + 1 - step : 4 + b * 64 + 63 - (step - 2);
                p[k] = ST + (((size_t)sc * 2 + d) * 32 + hd) * 8192 + e8 * 8; raw[k] = *(const u32x4*)p[k]; dec[k] = DTOT[(size_t)sc * 64 + d * 32 + hd]; }
#pragma unroll
            for (int k = 0; k < 6; ++k) { float st[8]; unpack8(raw[k], st); const float dd = __expf(dec[k]);
                *(u32x4*)p[k] = pack8(S);
#pragma unroll
                for (int q = 0; q < 8; ++q) S[q] = S[q] * dd + st[q]; }
        }
    }
}
__device__ __forceinline__ void p_mb_out(const Frame& F) {
    const bf16_t* XBC = SCR(bf16_t, S_XBC); const bf16_t* ST = SCR(bf16_t, S_ST); const bf16_t* Z = SCR(bf16_t, S_Z);
    bf16_t* YG = SCR(bf16_t, S_YG); float* SSQ = SCR(float, S_SSQ); float* SSQC = SCR(float, S_SSQC);
    LAS unsigned char* cmS = F.lds;
    LAS unsigned char* zS = F.lds; LAS unsigned char* ygS = F.lds + 17408;
    LAS unsigned char* bmS = F.lds + 34816;
    LAS unsigned char* sFS = bmS; LAS unsigned char* sBS = bmS + 17408;
    LAS unsigned char* WS_ = F.lds + 2 * 34816 + F.wave * 4352;
    LAS unsigned char* xS = F.lds + 3 * 34816;
    LAS float* dts = (LAS float*)(F.lds + 3 * 34816 + 18432);
    LAS float* cum = dts + 2048; LAS float* tot = cum + 2048;
    const int lane = F.lane, fr = lane & 15, fq = lane >> 4, w = F.wave, tid = F.tid;
    for (int u = blockIdx.x; u < 512 + 128; u += F.G) {
        int sc, g, e_lo, e_hi;
        if (u < 512) { sc = 4 + (u >> 2); g = u & 3; e_lo = 0; e_hi = 8; }
        else { const int v = u - 512; sc = v >> 5; g = (v >> 3) & 3; e_lo = v & 7; e_hi = e_lo + 1; }
        const int row0 = sc_row0(sc);
        __syncthreads();
        MbScanIn msi; mb_scans_load(F, row0, g, msi);
        const float Dall = F.in[I_MBD][g * 8 + (lane & 7)];
        u32x4 bmr[4], cmr[4];
#pragma unroll
        for (int k = 0; k < 4; ++k) { const int i = tid + k * (NWAVES * 64), q = i >> 4, ch = i & 15; const bf16_t* src = XBC + (size_t)(row0 + q) * MB_XBC + MB_DI + g * 128 + ch * 8;
            bmr[k] = *(const u32x4*)src; cmr[k] = *(const u32x4*)(src + 512); }
        u32x4 pS[4], pX[2], pZ[2];
#define MBO_PREFETCH(e_) do { const int hd_ = g * 8 + (e_); \
            _Pragma("unroll") for (int i = 0; i < 4; ++i) { const int idx = tid + (i & 1) * 512; pS[i] = *(const u32x4*)(ST + (((size_t)sc * 2 + (i >> 1)) * 32 + hd_) * 8192 + (size_t)idx * 8); } \
            _Pragma("unroll") for (int i = 0; i < 2; ++i) { const int idx = tid + i * 512, q = idx >> 3, ch = idx & 7; \
                pX[i] = *(const u32x4*)(XBC + (size_t)(row0 + q) * MB_XBC + hd_ * 64 + ch * 8); pZ[i] = *(const u32x4*)(Z + (size_t)(row0 + q) * MB_DI + hd_ * 64 + ch * 8); } } while (0)
        MBO_PREFETCH(e_lo);
#pragma unroll
        for (int k = 0; k < 4; ++k) { const int i = tid + k * (NWAVES * 64), q = i >> 4, ch = i & 15; *(LAS u32x4*)(bmS + q * 272 + ch * 16) = bmr[k]; *(LAS u32x4*)(cmS + q * 272 + ch * 16) = cmr[k]; }
        mb_scans(F, msi, dts, cum, tot);
        bf16x8 cf[4];
#pragma unroll
        for (int kk = 0; kk < 4; ++kk) cf[kk] = *(LAS const bf16x8*)(cmS + (16 * w + fr) * 272 + (32 * kk + 8 * fq) * 2);
        f32x4 cb[8];
#pragma unroll
        for (int jt = 0; jt < 8; ++jt) { cb[jt] = (f32x4){0.f, 0.f, 0.f, 0.f};
#pragma unroll
            for (int kk = 0; kk < 4; ++kk) cb[jt] = __builtin_amdgcn_mfma_f32_16x16x32_bf16(*(LAS const bf16x8*)(bmS + (16 * jt + fr) * 272 + (32 * kk + 8 * fq) * 2), cf[kk], cb[jt], 0, 0, 0); }
        float ssq = 0.f;
        const int irow = 16 * w + fr;
        __syncthreads();
        for (int e = e_lo; e < e_hi; ++e) {
            const int hd = g * 8 + e;
#pragma unroll
            for (int i = 0; i < 4; ++i) { const int idx = tid + (i & 1) * 512; *(LAS u32x4*)((i >> 1 ? sBS : sFS) + (idx >> 4) * 272 + (idx & 15) * 16) = pS[i]; }
#pragma unroll
            for (int i = 0; i < 2; ++i) { const int idx = tid + i * 512, q = idx >> 3, ch = idx & 7; *(LAS u32x4*)(xS + q * 144 + ch * 16) = pX[i]; *(LAS u32x4*)(zS + q * 136 + ch * 16) = pZ[i]; }
            __syncthreads();
            if (e + 1 < e_hi) MBO_PREFETCH(e + 1);
            const float Dsk = __int_as_float(__builtin_amdgcn_readlane(__float_as_int(Dall), e));
            const LAS float* cf_ = cum + e * 128; const LAS float* cr_ = cum + (8 + e) * 128; const LAS float* df_ = dts + e * 128; const LAS float* db_ = dts + (8 + e) * 128;
            const float ci_f = cf_[irow], ci_r = cr_[irow];
#pragma unroll
            for (int jt = 0; jt < 8; ++jt) { const int j4 = 16 * jt + 4 * fq;
                f32x4 val;
                if (jt != w) { const bool fwd = jt < w;
                    const f32x4 cj = *(const LAS f32x4*)((fwd ? cf_ : cr_) + j4), dj = *(const LAS f32x4*)((fwd ? df_ : db_) + j4); const float ci = fwd ? ci_f : ci_r;
#pragma unroll
                    for (int r = 0; r < 4; ++r) val[r] = cb[jt][r] * __expf(ci - cj[r]) * dj[r];
                } else { const f32x4 cjf = *(const LAS f32x4*)(cf_ + j4), cjr = *(const LAS f32x4*)(cr_ + j4), djf = *(const LAS f32x4*)(df_ + j4), djb = *(const LAS f32x4*)(db_ + j4);
#pragma unroll
                    for (int r = 0; r < 4; ++r) { const int j = j4 + r; const bool lo = j < irow;
                        val[r] = cb[jt][r] * __expf(lo ? ci_f - cjf[r] : ci_r - cjr[r]) * (lo ? djf[r] : djb[r]);
                        if (j == irow) val[r] = cb[jt][r] * (djf[r] + djb[r]) + Dsk; } }
                u32x2 w_; w_.x = pk2(val[0], val[1]); w_.y = pk2(val[2], val[3]);
                *(LAS u32x2*)(WS_ + fr * 272 + j4 * 2) = w_; }
            bf16x8 wf[4];
#pragma unroll
            for (int kk = 0; kk < 4; ++kk) wf[kk] = *(LAS const bf16x8*)(WS_ + fr * 272 + (32 * kk + 8 * fq) * 2);
            const float ef = __expf(ci_f), er = __expf(ci_r);
#pragma unroll
            for (int pt = 0; pt < 4; ++pt) {
                f32x4 y = (f32x4){0.f, 0.f, 0.f, 0.f}, t1 = y, t2 = y;
#pragma unroll
                for (int kk = 0; kk < 4; ++kk) {
                    y = __builtin_amdgcn_mfma_f32_16x16x32_bf16(tr_frag(xS, 144, 32 * kk, 16 * pt, lane), wf[kk], y, 0, 0, 0);
                    t1 = __builtin_amdgcn_mfma_f32_16x16x32_bf16(*(LAS const bf16x8*)(sFS + (16 * pt + fr) * 272 + (32 * kk + 8 * fq) * 2), cf[kk], t1, 0, 0, 0);
                    t2 = __builtin_amdgcn_mfma_f32_16x16x32_bf16(*(LAS const bf16x8*)(sBS + (16 * pt + fr) * 272 + (32 * kk + 8 * fq) * 2), cf[kk], t2, 0, 0, 0); }
                const u32x2 zz = *(LAS const u32x2*)(zS + irow * 136 + (16 * pt + 4 * fq) * 2);
                const f32x4 zf = (f32x4){bflo(zz.x), bfhi(zz.x), bflo(zz.y), bfhi(zz.y)};
                f32x4 o;
#pragma unroll
                for (int r = 0; r < 4; ++r) { o[r] = (y[r] + ef * t1[r] + er * t2[r]) * siluf_(zf[r]); ssq += o[r] * o[r]; }
                u32x2 w_; w_.x = pk2(o[0], o[1]); w_.y = pk2(o[2], o[3]);
                *(LAS u32x2*)(ygS + irow * 136 + (16 * pt + 4 * fq) * 2) = w_;
            }
            __syncthreads();
#pragma unroll
            for (int i = 0; i < 2; ++i) { const int idx = tid + i * 512, q = idx >> 3, ch = idx & 7;
                *(u32x4*)(YG + (size_t)(row0 + q) * MB_DI + hd * 64 + ch * 8) = *(LAS const u32x4*)(ygS + q * 136 + ch * 16); }
        }
#undef MBO_PREFETCH
        { float s_ = ssq; s_ += __shfl_xor(s_, 16); s_ += __shfl_xor(s_, 32);
          if (fq == 0) { if (u < 512) SSQ[(size_t)(row0 + irow) * 4 + g] = s_; else SSQC[(size_t)(row0 + irow) * 32 + g * 8 + e_lo] = s_; } }
    }
}


template <int CTRL> __device__ __forceinline__ float dpp_f(float v) { return __builtin_bit_cast(float, __builtin_amdgcn_update_dpp(0, __builtin_bit_cast(int, v), CTRL, 0xf, 0xf, false)); }
__device__ __forceinline__ float red8(float v) { v += dpp_f<0xB1>(v); v += dpp_f<0x4E>(v); v += dpp_f<0x141>(v); return v; }
__device__ __forceinline__ float red16(float v);
__device__ __forceinline__ float wave_sum_fast(float v) {
    v = red16(v);
    const float a = __builtin_bit_cast(float, __builtin_amdgcn_readlane(__builtin_bit_cast(int, v), 0)), b = __builtin_bit_cast(float, __builtin_amdgcn_readlane(__builtin_bit_cast(int, v), 16)),
                c = __builtin_bit_cast(float, __builtin_amdgcn_readlane(__builtin_bit_cast(int, v), 32)), d = __builtin_bit_cast(float, __builtin_amdgcn_readlane(__builtin_bit_cast(int, v), 48));
    return (a + b) + (c + d);
}
__device__ __forceinline__ float red16(float v) { v += dpp_f<0xB1>(v); v += dpp_f<0x4E>(v); v += dpp_f<0x141>(v); v += dpp_f<0x140>(v); return v; }
#ifndef CVT_REP
#define CVT_REP 1
#endif
constexpr int RW_TS = 32;
constexpr int N_MOEIN_IT = 16 * 224, N_MOEOUT_IT = 56 * 32;
__device__ __forceinline__ void p_rw_l2(const Frame& F) {
    const bf16_t* L1 = SCR(bf16_t, S_L1); const bf16_t* W2 = WSP(bf16_t, W_RWL2);
    float* WD = SCR(float, S_WD); bf16_t* AD = SCR(bf16_t, S_AD); bf16_t* GG = SCR(bf16_t, S_GG);
    const int gw = F.vcu * NWAVES + F.wave, NGW = F.G * NWAVES, lane = F.lane, fr = lane & 15, fq = lane >> 4;
    for (int it = gw; it < 2 * (RT / 16); it += NGW) {
        const int rt = it >> 1, nb0 = (it & 1) * 32, seg = 4, row = rt * 16 + fr;
        const int K = seg < 4 ? 64 : 128, koff = seg < 4 ? seg * 64 : 256;
        const bf16_t* Wseg = W2 + (seg < 4 ? (size_t)seg * 1024 * 64 : (size_t)4 * 1024 * 64);
        bf16x8 af[4];
#pragma unroll
        for (int kk = 0; kk < 4; ++kk) af[kk] = (kk * 32 < K) ? *(const bf16x8*)(L1 + (size_t)row * 384 + koff + 32 * kk + 8 * fq) : (bf16x8){0, 0, 0, 0, 0, 0, 0, 0};
        const float* bias = seg < 2 ? F.in[I_RWW0] + seg * DM : (seg < 4 ? F.in[I_RWA0] + (seg - 2) * DM : nullptr);
#pragma unroll 1
        for (int nb = nb0; nb < nb0 + 32; nb += 8) {
            bf16x8 wf[8][4];
#pragma unroll
            for (int u = 0; u < 8; ++u) { const bf16_t* wr = Wseg + (size_t)(16 * (nb + u) + fr) * K + 8 * fq;
                wf[u][0] = *(const bf16x8*)(wr); wf[u][1] = *(const bf16x8*)(wr + 32);
                if (seg == 4) { wf[u][2] = *(const bf16x8*)(wr + 64); wf[u][3] = *(const bf16x8*)(wr + 96); } }
#pragma unroll
            for (int u = 0; u < 8; ++u) {
                const int nt = nb + u;
                f32x4 acc = (f32x4){0.f, 0.f, 0.f, 0.f};
                acc = __builtin_amdgcn_mfma_f32_16x16x32_bf16(wf[u][0], af[0], acc, 0, 0, 0);
                acc = __builtin_amdgcn_mfma_f32_16x16x32_bf16(wf[u][1], af[1], acc, 0, 0, 0);
                if (seg == 4) { acc = __builtin_amdgcn_mfma_f32_16x16x32_bf16(wf[u][2], af[2], acc, 0, 0, 0); acc = __builtin_amdgcn_mfma_f32_16x16x32_bf16(wf[u][3], af[3], acc, 0, 0, 0); }
                const int c = 16 * nt + 4 * fq;
                if (seg < 4) { const f32x4 bb = *(const f32x4*)(bias + c); f32x4 o;
#pragma unroll
                    for (int i = 0; i < 4; ++i) { const float sg = sigmoidf_(acc[i] + bb[i]); o[i] = seg < 2 ? -0.606531f * sg : sg; }
                    if (seg < 2) *(f32x4*)(WD + (size_t)seg * RT * DM + (size_t)row * DM + c) = o;
                    else { u32x2 w_; w_.x = pk2(o[0], o[1]); w_.y = pk2(o[2], o[3]); *(u32x2*)(AD + (size_t)(seg - 2) * RT * DM + (size_t)row * DM + c) = w_; }
                } else { u32x2 w_; w_.x = pk2(acc[0], acc[1]); w_.y = pk2(acc[2], acc[3]); *(u32x2*)(GG + (size_t)row * DM + c) = w_; }
            }
        }
    }
}

constexpr int WY_C = 64, WY_NCH = (TC + TL) / WY_C, WY_LD = 144, WY_IMG = 64 * WY_LD, WY_FRAGS = 40, WY_ITEM = WY_FRAGS * 1024;
__device__ __forceinline__ int wy_row0(int b, int d, int c) {
    return c < TC / WY_C ? b * TC + (d ? TC - 1 - c * WY_C : c * WY_C) : RC + b * TL + (d ? TL - 1 - (c - TC / WY_C) * WY_C : (c - TC / WY_C) * WY_C);
}
template <int CTRL> __device__ __forceinline__ float dpp0_f(float v) { return __builtin_bit_cast(float, __builtin_amdgcn_update_dpp(0, __builtin_bit_cast(int, v), CTRL, 0xf, 0xf, true)); }
template <bool ATR, bool BTR>
__device__ __forceinline__ void wy_mm2(f32x4 (&acc)[2], LAS const unsigned char* X, LAS const unsigned char* Y, int mt, int nt0, int lane) {
    const int fr = lane & 15, fq = lane >> 4;
#pragma unroll
    for (int kk = 0; kk < 2; ++kk) {
        const bf16x8 a = ATR ? tr_frag(X, WY_LD, 32 * kk, 16 * mt, lane) : *(LAS const bf16x8*)(X + (16 * mt + fr) * WY_LD + (32 * kk + 8 * fq) * 2);
#pragma unroll
        for (int q = 0; q < 2; ++q) {
            const bf16x8 bb = BTR ? tr_frag(Y, WY_LD, 32 * kk, 16 * (nt0 + q), lane) : *(LAS const bf16x8*)(Y + (16 * (nt0 + q) + fr) * WY_LD + (32 * kk + 8 * fq) * 2);
            acc[q] = __builtin_amdgcn_mfma_f32_16x16x32_bf16(a, bb, acc[q], 0, 0, 0);
        }
    }
}
__device__ __forceinline__ void wy_put2(LAS unsigned char* img, const f32x4 (&acc)[2], int mt, int nt0, int lane) {
    const int fr = lane & 15, fq = lane >> 4;
#pragma unroll
    for (int q = 0; q < 2; ++q) { u32x2 w_; w_.x = pk2(acc[q][0], acc[q][1]); w_.y = pk2(acc[q][2], acc[q][3]);
        *(LAS u32x2*)(img + (16 * (nt0 + q) + fr) * WY_LD + (16 * mt + 4 * fq) * 2) = w_; }
}
struct CvtJob { const float* W; bf16_t* WT; int ldw, ldt, k0, n0, inter_half, drow0; const float* ksc; };
__device__ __forceinline__ CvtJob moe_cvt_job(const Frame& F, int it) {
    const int per = N_MOEIN_IT + N_MOEOUT_IT, le = it / per, r = it % per; CvtJob j; j.drow0 = 0; j.ksc = nullptr;
    if (r < N_MOEIN_IT) { j.W = F.in[I_MOEIN] + (size_t)le * DM * 2 * FFE; j.ldw = 2 * FFE; j.k0 = 64 * (r / 224); j.n0 = 32 * (r % 224); j.WT = WSP(bf16_t, W_MOEIN) + (size_t)le * 2 * FFE * DM; j.ldt = DM; j.inter_half = FFE; }
    else { const int rr = r - N_MOEIN_IT; j.W = F.in[I_MOEOUT] + (size_t)le * FFE * DM; j.ldw = DM; j.k0 = 64 * (rr / 32); j.n0 = 32 * (rr % 32); j.WT = WSP(bf16_t, W_MOEOUT) + (size_t)le * DM * FFE; j.ldt = FFE; j.inter_half = 0; }
    return j;
}
__device__ __forceinline__ void cvt_load(const CvtJob& j, float (&tv)[32], int lane) {
#pragma unroll
    for (int i = 0; i < 32; ++i) { const int kk = 2 * i + (lane >> 5); tv[i] = __builtin_nontemporal_load(j.W + (size_t)(j.k0 + kk) * j.ldw + j.n0 + (lane & 31)); }
}
__device__ __forceinline__ void cvt_finish(const CvtJob& j, const float (&tv)[32], LAS unsigned char* img, int lane) {
#pragma unroll
    for (int i = 0; i < 32; ++i) { const int kk = 2 * i + (lane >> 5); float v = tv[i]; if (j.ksc) v *= j.ksc[j.k0 + kk]; *(LAS bf16_t*)(img + kk * 72 + (lane & 31) * 2) = (bf16_t)f2bf(v); }
    LDS_WAIT(); asm volatile("" ::: "memory");
    const int fr = lane & 15, fq = lane >> 4;
#pragma unroll
    for (int c = 0; c < 2; ++c) { const int gn = j.n0 + 16 * c + fr; const int drow = j.drow0 + (j.inter_half ? (gn < j.inter_half ? 2 * gn : 2 * (gn - j.inter_half) + 1) : gn);
#pragma unroll
        for (int kk = 0; kk < 2; ++kk) { const bf16x8 v = tr_frag(img, 72, 32 * kk, 16 * c, lane);
            *(bf16x8*)(j.WT + (size_t)drow * j.ldt + j.k0 + 32 * kk + 8 * fq) = v; } }
    LDS_WAIT(); asm volatile("" ::: "memory");
}
namespace pro {
constexpr int N_MBIN = 16 * 162, N_MBOUT = 32 * 32, N_RKV = 16 * 32, N_W1 = 16 * 2, N_G1 = 16 * 4, N_SQ = 16 * 32, N_PL = 4 * 8, N_QKV = 16 * 48, N_FFIN = 16 * 176, N_FFOUT = 44 * 32;
constexpr int NITEMS = N_MBIN + N_MBOUT + 3 * N_RKV + 4 * N_W1 + N_G1 + 4 * 32 + 2 * 32 + N_SQ + 4 * N_PL + N_QKV + N_SQ + 2 * N_FFIN + 2 * N_FFOUT;
}
__device__ __forceinline__ CvtJob pro_cvt_job(const Frame& F, int r) {
    using namespace pro;
    const float* const* in = F.in; CvtJob j; j.inter_half = 0; j.drow0 = 0; j.ksc = nullptr;
#define PSET(Wp, LDW, K0, N0, WTp, LDT) do { j.W = (Wp); j.ldw = (LDW); j.k0 = (K0); j.n0 = (N0); j.WT = (WTp); j.ldt = (LDT); } while (0)
#define PJ(cnt, ...) if (r < (cnt)) { __VA_ARGS__; return j; } r -= (cnt);
    PJ(N_MBIN, PSET(in[I_MBIN], MB_NIN, 64 * (r / 162), 32 * (r % 162), WSP(bf16_t, W_MBIN), DM))
    PJ(N_MBOUT, PSET(in[I_MBOUT], DM, 64 * (r / 32), 32 * (r % 32), WSP(bf16_t, W_MBOUT), MB_DI); j.ksc = in[I_MBNG])
    PJ(3 * N_RKV, { const int q = r / N_RKV, rr = r % N_RKV; PSET(in[I_RWRKV] + (size_t)q * DM * DM, DM, 64 * (rr / 32), 32 * (rr % 32), WSP(bf16_t, W_RWBIG), DM); j.drow0 = q * 1024; })
    PJ(4 * N_W1, { const int q = r / N_W1, rr = r % N_W1; const int isa = q >> 1, d = q & 1;
        PSET(in[isa ? I_RWA1 : I_RWW1] + (size_t)d * DM * 64, 64, 64 * (rr / 2), 32 * (rr % 2), WSP(bf16_t, W_RWBIG), DM); j.drow0 = 3072 + isa * 256 + d * 64; })
    PJ(N_G1, PSET(in[I_RWG1], 128, 64 * (r / 4), 32 * (r % 4), WSP(bf16_t, W_RWBIG), DM); j.drow0 = 3584)
    PJ(4 * 32, { const int seg = r / 32, nb = r % 32; PSET(in[seg < 2 ? I_RWW2 : I_RWA2] + (size_t)(seg & 1) * 64 * DM, DM, 0, 32 * nb, WSP(bf16_t, W_RWL2) + (size_t)seg * 1024 * 64, 64); })
    PJ(2 * 32, PSET(in[I_RWG2], DM, 64 * (r / 32), 32 * (r % 32), WSP(bf16_t, W_RWL2) + (size_t)4 * 1024 * 64, 128))
    PJ(N_SQ, PSET(in[I_RWOUT], DM, 64 * (r / 32), 32 * (r % 32), WSP(bf16_t, W_RWOUT), DM))
    PJ(4 * N_PL, { const int gi = r / N_PL, rr = r % N_PL; PSET(in[I_PLW] + (size_t)gi * 65536, 256, 64 * (rr / 8), 32 * (rr % 8), WSP(bf16_t, W_POOL), 256); j.drow0 = gi * 256; })
    PJ(N_QKV, PSET(in[I_ATQKV], 1536, 64 * (r / 48), 32 * (r % 48), WSP(bf16_t, W_QKV), DM))
    PJ(N_SQ, PSET(in[I_ATOUT], DM, 64 * (r / 32), 32 * (r % 32), WSP(bf16_t, W_ATOUT), DM))
    PJ(2 * N_FFIN, { const int l = r / N_FFIN, rr = r % N_FFIN; PSET(in[I_FFIN] + (size_t)l * DM * 2 * FFD, 2 * FFD, 64 * (rr / 176), 32 * (rr % 176), WSP(bf16_t, W_FFIN) + (size_t)l * 2 * FFD * DM, DM); j.inter_half = FFD; })
    { const int l = r / N_FFOUT, rr = r % N_FFOUT; PSET(in[I_FFOUT] + (size_t)l * FFD * DM, DM, 64 * (rr / 32), 32 * (rr % 32), WSP(bf16_t, W_FFOUT) + (size_t)l * DM * FFD, FFD); }
    return j;
#undef PJ
#undef PSET
}
template <int PART>
__device__ __forceinline__ void p_prologue(const Frame& F) {
    const float* const* in = F.in;
    if (PART == 0) {
    {
        LAS float* sv = (LAS float*)F.lds;
        LAS float* part = (LAS float*)(F.lds + 16384);
        for (int i = F.tid; i < 3 * DM; i += NWAVES * 64) { const int s = i >> 10, k = i & 1023; const float cv = (s == 0) ? in[I_CCTX][k] : in[I_C][(s - 1) * DM + k]; sv[i] = siluf_(cv); }
        __syncthreads();
        float* MOD = WSP(float, WS_MOD);
        const int c4 = F.lane & 7, kb = F.wave * 128 + (F.lane >> 3);
        f32x4 w[16], wn[16];
        int it = blockIdx.x;
#define MOD_LOAD(dst, item) do { const float* W_ = in[I_MODW] + (size_t)((item) / 192) * DM * 6144 + ((item) % 192) * 32 + 4 * c4; \
        _Pragma("unroll") for (int i = 0; i < 16; ++i) dst[i] = __builtin_nontemporal_load((const f32x4*)(W_ + (size_t)(kb + 8 * i) * 6144)); } while (0)
        if (it < 4 * 192) MOD_LOAD(w, it);
        for (; it < 4 * 192; it += F.G) {
            const int layer = it / 192, cg = it % 192; const bool hn = it + F.G < 4 * 192;
            if (hn) MOD_LOAD(wn, it + F.G);
            f32x4 a0 = (f32x4){0.f, 0.f, 0.f, 0.f}, a1 = a0, a2 = a0;
#pragma unroll
            for (int i = 0; i < 16; ++i) { const int k = kb + 8 * i; a0 += w[i] * sv[k]; a1 += w[i] * sv[DM + k]; a2 += w[i] * sv[2 * DM + k]; }
#pragma unroll
            for (int m = 8; m < 64; m <<= 1)
#pragma unroll
                for (int q = 0; q < 4; ++q) { a0[q] += __shfl_xor(a0[q], m); a1[q] += __shfl_xor(a1[q], m); a2[q] += __shfl_xor(a2[q], m); }
            if (F.lane < 8) { *(LAS f32x4*)(part + (F.wave * 3 + 0) * 32 + 4 * c4) = a0; *(LAS f32x4*)(part + (F.wave * 3 + 1) * 32 + 4 * c4) = a1; *(LAS f32x4*)(part + (F.wave * 3 + 2) * 32 + 4 * c4) = a2; }
            __syncthreads();
            if (F.tid < 96) { const int s = F.tid >> 5, col = F.tid & 31; float sum = in[I_MODB][layer * 6144 + cg * 32 + col];
#pragma unroll
                for (int wv = 0; wv < 8; ++wv) sum += part[(wv * 3 + s) * 32 + col];
                MOD[((size_t)layer * 3 + s) * 6144 + cg * 32 + col] = sum; }
            __syncthreads();
            if (hn) {
#pragma unroll
                for (int i = 0; i < 16; ++i) w[i] = wn[i]; }
        }
#undef MOD_LOAD
    }
    {
        float* RP = WSP(float, WS_ROPE);
        for (int i = blockIdx.x * (NWAVES * 64) + F.tid; i < 2048; i += F.G * NWAVES * 64) {
            const int pos = i >> 4, f = i & 15; const float inv = powf(10000.f, -(float)f / 16.f); const float ang = (float)pos * inv;
            RP[i] = (float)cos((double)ang); RP[2048 + i] = (float)sin((double)ang); }
    }
    }
    if (PART == 1)
    {
        LAS unsigned char* img = F.lds + F.wave * 16384;
        const int gw = F.vcu * NWAVES + F.wave, NGW = F.G * NWAVES, lane = F.lane;
        float ta[32], tb[32];
        int it = gw;
        if (it < pro::NITEMS) {
            CvtJob ja = pro_cvt_job(F, it), jb = ja; cvt_load(ja, ta, lane);
            for (;;) {
                const int i1 = it + NGW; const bool h1 = i1 < pro::NITEMS;
                if (h1) { jb = pro_cvt_job(F, i1); cvt_load(jb, tb, lane); }
                cvt_finish(ja, ta, img, lane);
                if (!h1) break;
                const int i2 = i1 + NGW; const bool h2 = i2 < pro::NITEMS;
                if (h2) { ja = pro_cvt_job(F, i2); cvt_load(ja, ta, lane); }
                cvt_finish(jb, tb, img, lane);
                if (!h2) break;
                it = i2;
            }
        }
    }
}

constexpr int WY_PREP_CVT = 64 * WY_NCH * 8;
#define WY_BAR() asm volatile("s_waitcnt lgkmcnt(0)\n\ts_barrier" ::: "memory")
__device__ __forceinline__ void p_wy_prep(const Frame& F) {
    const bf16_t* RKV = SCR(bf16_t, S_RKV);
    unsigned char* WYB = SCR(unsigned char, S_WY);
#define WIMG(i) (F.lds + (i) * WY_IMG)
    LAS float* lwS = (LAS float*)(F.lds + 11 * WY_IMG);
    LAS float* gCs = lwS + 64 * 65;
    const int tid = F.tid, lane = F.lane, w = F.wave, fr = lane & 15, fq = lane >> 4;
    const int t = tid >> 3, cc = tid & 7;
    const int mt = w >> 1, nt0 = 2 * (w & 1);
    const size_t PL = (size_t)RT * DM;
    const bf16_t* L1 = SCR(bf16_t, S_L1); const bf16_t* W2 = WSP(bf16_t, W_RWL2);
    LAS float* aS = gCs + 64;
    LAS float* hpS = aS + 64 * 65; LAS f32x4* hpS4 = (LAS f32x4*)hpS;
    u32x4 pfb[7];
#define WY_PREFETCH(item_) do { const int ch_ = (item_) / WY_NCH, c_ = (item_) % WY_NCH, b_ = ch_ >> 5, h_ = (ch_ >> 1) & 15, d_ = ch_ & 1; \
        const size_t row_ = (size_t)(wy_row0(b_, d_, c_) + (d_ ? -t : t)), o_ = row_ * DM + h_ * 64 + 8 * cc; \
        pfb[0] = *(const u32x4*)(RKV + o_); pfb[1] = *(const u32x4*)(RKV + PL + o_); pfb[2] = *(const u32x4*)(RKV + 2 * PL + o_); \
        pfb[3] = *(const u32x4*)(L1 + row_ * 384 + d_ * 64 + 8 * cc); pfb[4] = *(const u32x4*)(L1 + row_ * 384 + 128 + d_ * 64 + 8 * cc); \
        pfb[5] = *(const u32x4*)(W2 + ((size_t)d_ * 1024 + h_ * 64 + t) * 64 + 8 * cc); pfb[6] = *(const u32x4*)(W2 + ((size_t)(2 + d_) * 1024 + h_ * 64 + t) * 64 + 8 * cc); } while (0)
    if ((int)blockIdx.x < 64 * WY_NCH) WY_PREFETCH((int)blockIdx.x);
    for (int item = blockIdx.x; item < 64 * WY_NCH; item += F.G) {
        const int chain = item / WY_NCH, c = item % WY_NCH, b = chain >> 5, h = (chain >> 1) & 15, d = chain & 1;
        unsigned char* ob = WYB + (size_t)item * WY_ITEM;
        float wbv[2], abv[2];
#pragma unroll
        for (int q = 0; q < 2; ++q) { const int ch = 16 * (nt0 + q) + fr; wbv[q] = F.in[I_RWW0][d * DM + h * 64 + ch]; abv[q] = F.in[I_RWA0][d * DM + h * 64 + ch]; }
        if (tid < 48) { const int q_ = tid >> 4; hpS4[tid] = *(const f32x4*)(F.in[q_ == 0 ? I_RWKK : (q_ == 1 ? I_RWKA : I_RWRK)] + h * 64 + 4 * (tid & 15)); }
        const CvtJob cj = moe_cvt_job(F, item * 8 + w); float ctv[32];
        cvt_load(cj, ctv, lane);
        WY_BAR();
        float r8[8], k8[8], v8[8], lw8[8], a8[8];
        unpack8(pfb[0], r8); unpack8(pfb[1], k8); unpack8(pfb[2], v8);
        *(LAS u32x4*)(WIMG(6) + t * WY_LD + cc * 16) = pfb[3]; *(LAS u32x4*)(WIMG(7) + t * WY_LD + cc * 16) = pfb[4];
        *(LAS u32x4*)(WIMG(8) + t * WY_LD + cc * 16) = pfb[5]; *(LAS u32x4*)(WIMG(9) + t * WY_LD + cc * 16) = pfb[6];
        WY_BAR();
        { f32x4 la[2] = {(f32x4){0.f, 0.f, 0.f, 0.f}, (f32x4){0.f, 0.f, 0.f, 0.f}}, aa[2] = {(f32x4){0.f, 0.f, 0.f, 0.f}, (f32x4){0.f, 0.f, 0.f, 0.f}};
          wy_mm2<false, false>(la, WIMG(6), WIMG(8), mt, nt0, lane); wy_mm2<false, false>(aa, WIMG(7), WIMG(9), mt, nt0, lane);
#pragma unroll
          for (int q = 0; q < 2; ++q) { const int ch = 16 * (nt0 + q) + fr; const float wb = wbv[q], ab = abv[q];
#pragma unroll
              for (int i = 0; i < 4; ++i) { const int tt = 16 * mt + 4 * fq + i; lwS[tt * 65 + ch] = -0.606531f * sigmoidf_(la[q][i] + wb); aS[tt * 65 + ch] = sigmoidf_(aa[q][i] + ab); } } }
        WY_BAR();
#pragma unroll
        for (int q = 0; q < 8; ++q) { lw8[q] = lwS[t * 65 + 8 * cc + q]; a8[q] = aS[t * 65 + 8 * cc + q]; }
        { const int row = wy_row0(b, d, c) + (d ? -t : t);
          float p1 = 0.f, p2 = 0.f;
#pragma unroll
          for (int q = 0; q < 8; ++q) { const float rkk = r8[q] * hpS[128 + 8 * cc + q] * k8[q]; p1 += rkk; p2 += rkk * hpS[64 + 8 * cc + q] * (a8[q] - 1.f); }
          p1 = red8(p1); p2 = red8(p2);
          if (cc == 0) { SCR(float, S_BON2)[((size_t)d * RT + row) * 16 + h] = p2; if (d == 0) SCR(float, S_AD)[(size_t)row * 16 + h] = p1; } }
        WY_BAR();
#pragma unroll
        for (int q = 0; q < 8; ++q) { const int ch = 8 * w + q; float x = lwS[lane * 65 + ch];
            x += dpp0_f<0x111>(x); x += dpp0_f<0x112>(x); x += dpp0_f<0x114>(x); x += dpp0_f<0x118>(x);
            const float t0 = __builtin_bit_cast(float, __builtin_amdgcn_readlane(__builtin_bit_cast(int, x), 15)), t1 = __builtin_bit_cast(float, __builtin_amdgcn_readlane(__builtin_bit_cast(int, x), 31)),
                        t2 = __builtin_bit_cast(float, __builtin_amdgcn_readlane(__builtin_bit_cast(int, x), 47));
            x += (fq == 1) ? t0 : (fq == 2) ? (t0 + t1) : (fq == 3) ? ((t0 + t1) + t2) : 0.f;
            lwS[lane * 65 + ch] = x; }
        WY_BAR();
        {
            float kx[8], ss = 0.f;
#pragma unroll
            for (int q = 0; q < 8; ++q) { kx[q] = k8[q] * hpS[8 * cc + q]; ss += kx[q] * kx[q]; }
            const float inv = 1.0f / fmaxf(sqrtf(red8(ss)), 1e-12f);
            float oA[8], oBt[8], oKt[8], oRt[8], oBc[8], oKc[8];
#pragma unroll
            for (int q = 0; q < 8; ++q) { const float lg = lwS[t * 65 + 8 * cc + q], lgC = lwS[63 * 65 + 8 * cc + q];
                const float kkv = kx[q] * inv, bv = kkv * a8[q], kd = k8[q] * (1.f + (a8[q] - 1.f) * hpS[64 + 8 * cc + q]);
                const float ginv = __expf(-lg), gc = __expf(lgC - lg);
                oA[q] = __expf(lg - lw8[q]) * kkv; oBt[q] = bv * ginv; oKt[q] = kd * ginv; oRt[q] = __expf(lg) * r8[q]; oBc[q] = bv * gc; oKc[q] = kd * gc;
                if (t == 63) gCs[8 * cc + q] = __expf(lgC); }
            *(LAS u32x4*)(WIMG(0) + t * WY_LD + cc * 16) = pack8(oA);  *(LAS u32x4*)(WIMG(1) + t * WY_LD + cc * 16) = pack8(oBt);
            *(LAS u32x4*)(WIMG(2) + t * WY_LD + cc * 16) = pack8(oKt); *(LAS u32x4*)(WIMG(3) + t * WY_LD + cc * 16) = pack8(oRt);
            *(LAS u32x4*)(WIMG(4) + t * WY_LD + cc * 16) = pack8(oBc); *(LAS u32x4*)(WIMG(5) + t * WY_LD + cc * 16) = pack8(oKc);
#pragma unroll
            for (int q = 0; q < 8; ++q) { const int vv = 8 * cc + q;
                *(bf16_t*)(ob + (32 + 2 * (vv >> 4) + (t >> 5)) * 1024 + (((t >> 3) & 3) * 16 + (vv & 15)) * 16 + (t & 7) * 2) = (bf16_t)f2bf(v8[q]); }
        }
        WY_BAR();
        if (item + F.G < 64 * WY_NCH) WY_PREFETCH(item + F.G);
        f32x4 nb[2], nk[2], mbr[2], mkr[2], Treg[2];
#pragma unroll
        for (int q = 0; q < 2; ++q) { nb[q] = (f32x4){0.f, 0.f, 0.f, 0.f}; nk[q] = nb[q]; mbr[q] = nb[q]; mkr[q] = nb[q]; }
        wy_mm2<false, false>(nb, WIMG(1), WIMG(0), mt, nt0, lane); wy_mm2<false, false>(nk, WIMG(2), WIMG(0), mt, nt0, lane);
        wy_mm2<false, false>(mbr, WIMG(1), WIMG(3), mt, nt0, lane); wy_mm2<false, false>(mkr, WIMG(2), WIMG(3), mt, nt0, lane);
#pragma unroll
        for (int q = 0; q < 2; ++q)
#pragma unroll
            for (int i = 0; i < 4; ++i) { const int j = 16 * mt + 4 * fq + i, tt = 16 * (nt0 + q) + fr;
                nb[q][i] = (j < tt) ? -nb[q][i] : 0.f; nk[q][i] = (j < tt) ? nk[q][i] : 0.f; mbr[q][i] = (j <= tt) ? mbr[q][i] : 0.f; mkr[q][i] = (j <= tt) ? mkr[q][i] : 0.f;
                Treg[q][i] = nb[q][i] + ((j == tt) ? 1.f : 0.f); }
        WY_BAR();
        wy_put2(WIMG(8), nb, mt, nt0, lane); wy_put2(WIMG(6), nk, mt, nt0, lane); wy_put2(WIMG(7), mbr, mt, nt0, lane); wy_put2(WIMG(2), Treg, mt, nt0, lane);
        WY_BAR();
        { f32x4 p2[2] = {(f32x4){0.f, 0.f, 0.f, 0.f}, (f32x4){0.f, 0.f, 0.f, 0.f}};
          wy_mm2<true, false>(p2, WIMG(8), WIMG(8), mt, nt0, lane); wy_put2(WIMG(9), p2, mt, nt0, lane); }
        WY_BAR();
        int ts_ = 2, ps_ = 9, td_ = 1, pd_ = 8;
#pragma unroll 1
        for (int it = 1; it <= 5; ++it) {
            f32x4 tp[2] = {(f32x4){0.f, 0.f, 0.f, 0.f}, (f32x4){0.f, 0.f, 0.f, 0.f}}, pp[2] = {(f32x4){0.f, 0.f, 0.f, 0.f}, (f32x4){0.f, 0.f, 0.f, 0.f}};
            wy_mm2<true, false>(tp, WIMG(ts_), WIMG(ps_), mt, nt0, lane);
            if (it < 5) wy_mm2<true, false>(pp, WIMG(ps_), WIMG(ps_), mt, nt0, lane);
            Treg[0] += tp[0]; Treg[1] += tp[1];
            wy_put2(WIMG(td_), Treg, mt, nt0, lane);
            if (it < 5) wy_put2(WIMG(pd_), pp, mt, nt0, lane);
            WY_BAR();
            int tmp = ts_; ts_ = td_; td_ = tmp; tmp = ps_; ps_ = pd_; pd_ = tmp;
        }
        { f32x4 p1[2] = {(f32x4){0.f, 0.f, 0.f, 0.f}, (f32x4){0.f, 0.f, 0.f, 0.f}}, p2_[2] = {(f32x4){0.f, 0.f, 0.f, 0.f}, (f32x4){0.f, 0.f, 0.f, 0.f}};
          wy_mm2<true, false>(p1, WIMG(0), WIMG(1), mt, nt0, lane); wy_mm2<true, false>(p2_, WIMG(6), WIMG(1), mt, nt0, lane);
          wy_put2(WIMG(9), p1, mt, nt0, lane); wy_put2(WIMG(10), p2_, mt, nt0, lane); }
        WY_BAR();
        {
            f32x4 q1[2] = {(f32x4){0.f, 0.f, 0.f, 0.f}, (f32x4){0.f, 0.f, 0.f, 0.f}}, q2[2] = {q1[0], q1[0]}, e1[2] = {q1[0], q1[0]}, e2[2] = {q1[0], q1[0]};
            wy_mm2<true, false>(q1, WIMG(9), WIMG(7), mt, nt0, lane); wy_mm2<true, false>(q2, WIMG(10), WIMG(7), mt, nt0, lane);
            wy_mm2<true, true>(e1, WIMG(9), WIMG(4), mt, nt0, lane); wy_mm2<true, true>(e2, WIMG(10), WIMG(4), mt, nt0, lane);
#pragma unroll
            for (int q = 0; q < 2; ++q) {
                const int nt = nt0 + q, n = 16 * nt + fr;
                float o1[4], o2[4], o3[4], o4[4];
#pragma unroll
                for (int i = 0; i < 4; ++i) { const int m = 16 * mt + 4 * fq + i;
                    o1[i] = bf2f(*(LAS const bf16_t*)(WIMG(3) + n * WY_LD + m * 2)) - q1[q][i];
                    o2[i] = mkr[q][i] - q2[q][i];
                    o3[i] = ((m == n) ? gCs[m] : 0.f) - e1[q][i];
                    o4[i] = bf2f(*(LAS const bf16_t*)(WIMG(5) + m * WY_LD + n * 2)) - e2[q][i]; }
                const int offS = (2 * nt + (mt >> 1)) * 1024 + (fq * 16 + fr) * 16 + (mt & 1) * 8;
                const int offC = (2 * nt + (mt >> 1)) * 1024 + ((2 * (mt & 1) + (fq >> 1)) * 16 + fr) * 16 + (fq & 1) * 8;
                u32x2 w1, w2, w3, w4; w1.x = pk2(o1[0], o1[1]); w1.y = pk2(o1[2], o1[3]); w2.x = pk2(o2[0], o2[1]); w2.y = pk2(o2[2], o2[3]);
                w3.x = pk2(o3[0], o3[1]); w3.y = pk2(o3[2], o3[3]); w4.x = pk2(o4[0], o4[1]); w4.y = pk2(o4[2], o4[3]);
                *(u32x2*)(ob + offS) = w1; *(u32x2*)(ob + 8 * 1024 + offC) = w2; *(u32x2*)(ob + 16 * 1024 + offS) = w3; *(u32x2*)(ob + 24 * 1024 + offC) = w4;
            }
        }
        { LAS unsigned char* cimg = F.lds + (w < 6 ? w * 4608 : 6 * WY_IMG + (w - 6) * 4608);
          cvt_finish(cj, ctv, cimg, lane);
          const int extra = WY_PREP_CVT + item * 8 + w;
          if (extra < 16 * (N_MOEIN_IT + N_MOEOUT_IT)) { const CvtJob cj2 = moe_cvt_job(F, extra); cvt_load(cj2, ctv, lane); cvt_finish(cj2, ctv, cimg, lane); } }
    }
#undef WIMG
#undef WY_PREFETCH
}
__device__ __forceinline__ unsigned lds_ld_u32(unsigned addr) { unsigned v; asm volatile("ds_read_b32 %0, %1\n\ts_waitcnt lgkmcnt(0)" : "=v"(v) : "v"(addr) : "memory"); return v; }
__device__ __forceinline__ void lds_st_u32(unsigned addr, unsigned val) { asm volatile("ds_write_b32 %0, %1" :: "v"(addr), "v"(val) : "memory"); }
__device__ __forceinline__ void p_wy_seq(const Frame& F) {
    volatile LAS unsigned* flg = (volatile LAS unsigned*)(F.lds + LDSCTL_OFF + 128);
    if (F.tid < 8) flg[F.tid] = 0u;
    __syncthreads();
    const unsigned fa = (unsigned)(uintptr_t)(F.lds + LDSCTL_OFF + 128);
    const unsigned char* WYB = SCR(unsigned char, S_WY); float* YY = SCR(float, S_YY);
    const int lane = F.lane, fr = lane & 15, fq = lane >> 4;
    int gbase = 0;
    for (int unit = F.vcu; unit < 256; unit += F.G, gbase += WY_NCH) {
        const int chain = unit >> 2, vb = unit & 3, b = chain >> 5, h = (chain >> 1) & 15, d = chain & 1;
        const unsigned char* ib = WYB + (size_t)chain * WY_NCH * WY_ITEM + lane * 16;
        if (F.wave >= 1) {
            const int lw = F.wave - 1;
            for (int c = lw; c < WY_NCH; c += 7) {
                const int gc = gbase + c;
                const unsigned char* g_ = ib + (size_t)c * WY_ITEM; LAS unsigned char* l_ = F.lds + (gc & 3) * 34816 + lane * 16;
                u32x4 rg[34];
#pragma unroll
                for (int f = 0; f < 32; ++f) rg[f] = *(const u32x4*)(g_ + f * 1024);
#pragma unroll
                for (int f = 0; f < 2; ++f) rg[32 + f] = *(const u32x4*)(g_ + (32 + 2 * vb + f) * 1024);
                for (unsigned sp = 0; (int)lds_ld_u32(fa + 16) < gc - 3 && sp < (1u << 22); ++sp) __builtin_amdgcn_s_sleep(1);
#pragma unroll
                for (int f = 0; f < 34; ++f) *(LAS u32x4*)(l_ + f * 1024) = rg[f];
                asm volatile("s_waitcnt lgkmcnt(0)" ::: "memory");
                if (lane == 0) lds_st_u32(fa + 4 * (gc & 3), (unsigned)(gc + 1));
            }
            continue;
        }
        float* yP = YY + (size_t)d * RT * DM + h * 64 + vb * 16 + fr;
        f32x4 S[4];
#pragma unroll
        for (int k = 0; k < 4; ++k) S[k] = (f32x4){0.f, 0.f, 0.f, 0.f};
        for (int c = 0; c < WY_NCH; ++c) {
            const int gc = gbase + c;
            for (unsigned sp = 0; lds_ld_u32(fa + 4 * (gc & 3)) != (unsigned)(gc + 1) && sp < (1u << 24); ++sp) __builtin_amdgcn_s_sleep(0);
            asm volatile("" ::: "memory");
            LAS const unsigned char* lb = F.lds + (gc & 3) * 34816 + lane * 16;
            bf16x8 sf[2], vf[2];
#pragma unroll
            for (int kk = 0; kk < 2; ++kk) { u32x4 pw; pw.x = pk2(S[2 * kk][0], S[2 * kk][1]); pw.y = pk2(S[2 * kk][2], S[2 * kk][3]); pw.z = pk2(S[2 * kk + 1][0], S[2 * kk + 1][1]); pw.w = pk2(S[2 * kk + 1][2], S[2 * kk + 1][3]);
                sf[kk] = __builtin_bit_cast(bf16x8, pw); vf[kk] = *(LAS const bf16x8*)(lb + (32 + kk) * 1024); }
            const int row0 = wy_row0(b, d, c), dir = d ? -1 : 1;
            bf16x8 fg[32];
#pragma unroll
            for (int f = 0; f < 32; ++f) fg[f] = *(LAS const bf16x8*)(lb + f * 1024);
            asm volatile("s_waitcnt lgkmcnt(0)" ::: "memory");
            if (lane == 0) lds_st_u32(fa + 16, (unsigned)(gc + 1));
            __builtin_amdgcn_sched_barrier(0);
            f32x4 Sn[4], yv[4];
#pragma unroll
            for (int k = 0; k < 4; ++k) { Sn[k] = (f32x4){0.f, 0.f, 0.f, 0.f}; yv[k] = Sn[k]; }
#pragma unroll
            for (int st = 0; st < 4; ++st) {
                const bf16x8 op = (st & 1) ? vf[st >> 1] : sf[st >> 1];
#pragma unroll
                for (int kt = 0; kt < 4; ++kt) Sn[kt] = __builtin_amdgcn_mfma_f32_16x16x32_bf16(fg[((st & 1) ? 24 : 16) + 2 * kt + (st >> 1)], op, Sn[kt], 0, 0, 0);
#pragma unroll
                for (int mt = 0; mt < 4; ++mt) yv[mt] = __builtin_amdgcn_mfma_f32_16x16x32_bf16(fg[((st & 1) ? 8 : 0) + 2 * mt + (st >> 1)], op, yv[mt], 0, 0, 0);
            }
#pragma unroll
            for (int mt = 0; mt < 4; ++mt)
#pragma unroll
                for (int i = 0; i < 4; ++i) yP[(size_t)(row0 + dir * (16 * mt + 4 * fq + i)) * DM] = yv[mt][i];
#pragma unroll
            for (int kt = 0; kt < 4; ++kt) S[kt] = Sn[kt];
        }
    }
}

__device__ __forceinline__ float sum4(const f32x4 v) { return (v[0] + v[1]) + (v[2] + v[3]); }
__device__ __forceinline__ f32x4 ld_bf4(const bf16_t* p) { const u32x2 w = *(const u32x2*)p; return (f32x4){bflo(w.x), bfhi(w.x), bflo(w.y), bfhi(w.y)}; }
__device__ __forceinline__ void p_rw_combine(const Frame& F) {
    const bf16_t* RKV = SCR(bf16_t, S_RKV); const float* BON1 = SCR(float, S_AD); const float* BON2 = SCR(float, S_BON2); const float* YY = SCR(float, S_YY); const bf16_t* GG = SCR(bf16_t, S_GG); bf16_t* OO = SCR(bf16_t, S_OO);
    const int gw = F.vcu * NWAVES + F.wave, NGW = F.G * NWAVES, lane = F.lane;
    const size_t PL = (size_t)RT * DM;
    LAS float* PR = (LAS float*)F.lds;
    for (int i = F.tid; i < 4 * DM; i += NWAVES * 64) { const int q = i >> 10, c = i & 1023; PR[i] = F.in[q == 0 ? I_RWKA : (q == 1 ? I_RWRK : (q == 2 ? I_RWLNG : I_RWLNB))][c]; }
    __syncthreads();
    auto bf4 = [](const u32x2 w) { return (f32x4){bflo(w.x), bfhi(w.x), bflo(w.y), bfhi(w.y)}; };
    struct RowIn { f32x4 y0[4], y1[4]; u32x2 v_[4], gg[4]; float b1[4], b20[4], b21[4]; };
    auto rload = [&](RowIn& x, int row) {
#pragma unroll
        for (int j = 0; j < 4; ++j) {
            const size_t o = (size_t)row * DM + 256 * j + 4 * lane; const int hd = 4 * j + (lane >> 4);
            x.y0[j] = __builtin_nontemporal_load((const f32x4*)(YY + o)); x.y1[j] = __builtin_nontemporal_load((const f32x4*)(YY + PL + o));
            x.v_[j] = __builtin_nontemporal_load((const u32x2*)(RKV + 2 * PL + o));
            x.gg[j] = __builtin_nontemporal_load((const u32x2*)(GG + o));
            x.b1[j] = BON1[(size_t)row * 16 + hd]; x.b20[j] = BON2[(size_t)row * 16 + hd]; x.b21[j] = BON2[((size_t)RT + row) * 16 + hd]; }
    };
    auto process = [&](const RowIn& x, int row) {
#pragma unroll
        for (int j = 0; j < 4; ++j) {
            const int c = 256 * j + 4 * lane; const size_t o = (size_t)row * DM + c;
            const f32x4 y = x.y0[j] + x.y1[j];
            const f32x4 v = bf4(x.v_[j]);
            const f32x4 lg = *(LAS const f32x4*)(PR + 2 * DM + c), lb = *(LAS const f32x4*)(PR + 3 * DM + c);
            const float mu = red16(sum4(y)) * (1.f / 64.f); const f32x4 dy = y - mu;
            const float var = red16(sum4(dy * dy)) * (1.f / 64.f);
            const float bon = x.b1[j] + 0.5f * (x.b20[j] + x.b21[j]);
            const float rs = __builtin_amdgcn_rsqf(var + 64e-5f);
            const f32x4 res = dy * rs * lg + lb + v * bon;
            u32x2 w_; w_.x = pk2(res[0] * bflo(x.gg[j].x), res[1] * bfhi(x.gg[j].x)); w_.y = pk2(res[2] * bflo(x.gg[j].y), res[3] * bfhi(x.gg[j].y));
            *(u32x2*)(OO + o) = w_;
        }
    };
    RowIn ra, rb;
    int row = gw;
    if (row < RT) rload(ra, row);
    for (; row < RT; row += 2 * NGW) {
        if (row + NGW < RT) rload(rb, row + NGW);
        process(ra, row);
        if (row + NGW >= RT) break;
        if (row + 2 * NGW < RT) rload(ra, row + 2 * NGW);
        process(rb, row + NGW);
    }
}

__device__ __forceinline__ void p_pool(const Frame& F, bf16_t* Pout) {
    const bf16_t* H = WSP(bf16_t, WS_H);
    constexpr int SR = 22, HALO = 8, TR = SR + 2 * HALO, NSTRIP = RT / SR, NLD = (TR * 128 + NWAVES * 64 - 1) / (NWAVES * 64);
    static_assert(RT % SR == 0, "strip rows");
    LAS unsigned char* tile = F.lds;
    const int tid = F.tid, cg = tid & 127, rq = tid >> 7, c = cg * 8, hw = 1 << (cg >> 5);
    u32x4 pf[NLD];
#define POOL_LOAD(strip_) do { const int rb_ = (strip_) * SR - HALO; _Pragma("unroll") for (int k = 0; k < NLD; ++k) { const int idx = tid + k * (NWAVES * 64), j = idx >> 7, ab = rb_ + j; \
        pf[k] = (j < TR && ab >= 0 && ab < RT) ? *(const u32x4*)(H + (size_t)ab * DM + (idx & 127) * 8) : (u32x4){0u, 0u, 0u, 0u}; } } while (0)
    int strip = blockIdx.x;
    if (strip < NSTRIP) POOL_LOAD(strip);
    for (; strip < NSTRIP; strip += F.G) {
        __syncthreads();
#pragma unroll
        for (int k = 0; k < NLD; ++k) { const int idx = tid + k * (NWAVES * 64); if ((idx >> 7) < TR) *(LAS u32x4*)(tile + (size_t)idx * 16) = pf[k]; }
        __syncthreads();
        if (strip + F.G < NSTRIP) POOL_LOAD(strip + F.G);
        const int r0 = strip * SR, rb = r0 - HALO;
        for (int r = rq * 6; r < (rq * 6 + 6 < SR ? rq * 6 + 6 : SR); ++r) {
            const int row = r0 + r;
            const int start = row < RC ? (row & ~(TC - 1)) : RC + ((row - RC) & ~(TL - 1)), len = row < RC ? TC : TL, t = row - start;
            int lo = t - hw; lo = lo < 0 ? 0 : lo; int hi = t + hw; hi = hi > len ? len : hi;
            float acc[8], x[8];
#pragma unroll
            for (int k = 0; k < 8; ++k) acc[k] = 0.f;
            for (int tt = lo; tt < hi; ++tt) { unpack8(*(LAS const u32x4*)(tile + (size_t)(start + tt - rb) * 2048 + cg * 16), x);
#pragma unroll
                for (int k = 0; k < 8; ++k) acc[k] += x[k]; }
            const float inv = 1.f / (float)(hi - lo);
            unpack8(*(LAS const u32x4*)(tile + (size_t)(row - rb) * 2048 + cg * 16), x);
            float o[8];
#pragma unroll
            for (int k = 0; k < 8; ++k) o[k] = acc[k] * inv - x[k];
            *(u32x4*)(Pout + (size_t)row * DM + c) = pack8(o);
        }
    }
#undef POOL_LOAD
}

__device__ __forceinline__ void qk_head8(float (&x)[8], const f32x4 g0, const f32x4 g1, LAS const float* RP, int cc, bool lat, int t, float outscale) {
    float ss = 0.f;
#pragma unroll
    for (int k = 0; k < 8; ++k) ss += x[k] * x[k];
    const float rstd = __builtin_amdgcn_rsqf(red8(ss) * (1.f / 64.f) + NORM_EPS);
#pragma unroll
    for (int k = 0; k < 4; ++k) { x[k] *= rstd * g0[k]; x[4 + k] *= rstd * g1[k]; }
    if (lat) {
        const int pos = (cc < 4) ? (t >> 6) : (t & 63); const int f0 = (cc & 1) * 8;
        const f32x4 c0 = *(LAS const f32x4*)(RP + pos * 16 + f0), c1 = *(LAS const f32x4*)(RP + pos * 16 + f0 + 4), s0 = *(LAS const f32x4*)(RP + 2048 + pos * 16 + f0), s1 = *(LAS const f32x4*)(RP + 2048 + pos * 16 + f0 + 4);
        const bool firsthalf = ((cc >> 1) & 1) == 0;
#pragma unroll
        for (int k = 0; k < 8; ++k) { const float other = dpp_f<0x4E>(x[k]); const float cs = k < 4 ? c0[k] : c1[k - 4], sn = k < 4 ? s0[k] : s1[k - 4];
            x[k] = firsthalf ? x[k] * cs - other * sn : x[k] * cs + other * sn; }
    }
#pragma unroll
    for (int k = 0; k < 8; ++k) x[k] *= outscale;
}
__device__ __forceinline__ void p_qkrope(const Frame& F) {
    const bf16_t* QKV = SCR(bf16_t, S_QKV); bf16_t* KB_ = SCR(bf16_t, S_KB); bf16_t* VB_ = SCR(bf16_t, S_VB);
    LAS float* RPl = (LAS float*)F.lds;
    for (int i = F.tid; i < 4096; i += NWAVES * 64) RPl[i] = WSP(float, WS_ROPE)[i];
    const int gw = F.vcu * NWAVES + F.wave, NGW = F.G * NWAVES, lane = F.lane, cc = lane & 7;
    const f32x4 g0 = *(const f32x4*)(F.in[I_ATKG] + 8 * cc), g1 = *(const f32x4*)(F.in[I_ATKG] + 8 * cc + 4);
    __syncthreads();
    auto ldrow = [&](int row) { return __builtin_nontemporal_load((const u32x4*)(QKV + (size_t)row * 1536) + 128 + lane); };
    auto process = [&](const u32x4 raw, int row) {
        const bool lat = row >= RC; const int b = lat ? (row - RC) >> 13 : row >> 8, t = lat ? (row - RC) & (TL - 1) : row & (TC - 1);
        const size_t kvrow = (size_t)b * KVL + (lat ? TC + t : t);
        float x[8]; unpack8(raw, x);
        qk_head8(x, g0, g1, RPl, cc, lat, t, 1.0f);
        if (lane < 32) *(u32x4*)(KB_ + kvrow * 256 + lane * 8) = pack8(x);
        else *(u32x4*)(VB_ + kvrow * 256 + (lane - 32) * 8) = raw;
    };
    u32x4 b0 = (u32x4){0u, 0u, 0u, 0u}, b1 = b0, b2 = b0, b3 = b0;
    int row = gw;
    if (row < RT) b0 = ldrow(row);
    if (row + NGW < RT) b1 = ldrow(row + NGW);
    if (row + 2 * NGW < RT) b2 = ldrow(row + 2 * NGW);
    for (; row < RT; row += 4 * NGW) {
        if (row + 3 * NGW < RT) b3 = ldrow(row + 3 * NGW);
        process(b0, row);
        if (row + NGW >= RT) break;
        if (row + 4 * NGW < RT) b0 = ldrow(row + 4 * NGW);
        process(b1, row + NGW);
        if (row + 2 * NGW >= RT) break;
        if (row + 5 * NGW < RT) b1 = ldrow(row + 5 * NGW);
        process(b2, row + 2 * NGW);
        if (row + 3 * NGW >= RT) break;
        if (row + 6 * NGW < RT) b2 = ldrow(row + 6 * NGW);
        process(b3, row + 3 * NGW);
    }
}

__device__ __forceinline__ void p_ctx_fix(const Frame& F, const float* gate, const float* ssq, int xin_inputs, int S) {
    const float* PART = SCR(float, S_PARTC); bf16_t* XW = WSP(bf16_t, WS_XW);
    const int gw = F.vcu * NWAVES + F.wave, NGW = F.G * NWAVES, lane = F.lane;
    for (int row = gw; row < RC; row += NGW) {
        float rs = 1.f;
        if (ssq) { const f32x4 q = *(const f32x4*)(ssq + (size_t)row * 4); rs = __builtin_amdgcn_rsqf(((q[0] + q[1]) + (q[2] + q[3])) * (1.f / 2048.f) + NORM_EPS); }
#pragma unroll
        for (int j = 0; j < 4; ++j) { const int c = 4 * lane + 256 * j; f32x4 a = (f32x4){0.f, 0.f, 0.f, 0.f};
            for (int ks = 0; ks < S; ++ks) a += *(const f32x4*)(PART + ((size_t)ks * RC + row) * DM + c);
            const f32x4 xi = xin_inputs ? *(const f32x4*)(F.in[I_CTX] + (size_t)row * DM + c) : ld_x4(XW + (size_t)row * DM + c);
            st_x4(XW + (size_t)row * DM + c, xi + *(const f32x4*)(gate + c) * a * rs); }
    }
}
__device__ __forceinline__ void moe_starts(const Frame& F, int (&ts)[NEXP]) {
    const int* CNT = WSP(int, WS_CNT); int acc = 0;
#pragma unroll
    for (int e = 0; e < NEXP; ++e) { acc += (CNT[e] + 255) >> 8; ts[e] = acc; }
}
__device__ __forceinline__ int seg_start(const int (&ts)[NEXP], int e) { int r = 0;
#pragma unroll
    for (int j = 0; j < NEXP - 1; ++j) r = (e == j + 1) ? ts[j] : r;
    return r; }
__device__ __forceinline__ void p_moe_gather(const Frame& F, int row_lo) {
    const int* SEL = WSP(int, WS_SEL); int* POS = WSP(int, WS_POS); int* CNT = WSP(int, WS_CNT); const bf16_t* H = WSP(bf16_t, WS_H); bf16_t* AG = SCR(bf16_t, S_AG);
    LAS int* red = (LAS int*)F.lds;
    const int nrows = RT - row_lo, per = (nrows + F.G - 1) / F.G, r_lo = row_lo + (int)blockIdx.x * per, r_hi = (r_lo + per < RT) ? r_lo + per : RT;
    int ct[8], cb_[8];
#pragma unroll
    for (int e = 0; e < 8; ++e) { ct[e] = 0; cb_[e] = 0; }
    for (int r = row_lo + F.tid; r < RT; r += NWAVES * 64) { const int s_ = SEL[r]; const int e0 = s_ & 255, e1 = s_ >> 8; const int before = r < r_lo ? 1 : 0;
#pragma unroll
        for (int e = 0; e < 8; ++e) { const int hit = (e0 == e) + (e1 == e); ct[e] += hit; cb_[e] += before * hit; } }
    __syncthreads();
#pragma unroll
    for (int e = 0; e < 8; ++e) { const float a = wave_sum((float)ct[e]), b = wave_sum((float)cb_[e]);
        if (F.lane == 0) { red[F.wave * 16 + e] = (int)a; red[F.wave * 16 + 8 + e] = (int)b; } }
    __syncthreads();
    if (F.tid < 16) { int a = 0;
#pragma unroll
        for (int w = 0; w < NWAVES; ++w) a += red[w * 16 + F.tid];
        red[8192 + F.tid] = a; }
    __syncthreads();
    int ts[NEXP]; { int acc = 0;
#pragma unroll
        for (int e = 0; e < NEXP; ++e) { acc += (red[8192 + e] + 255) >> 8; ts[e] = acc; } }
    if (blockIdx.x == 0 && F.tid < 8) CNT[F.tid] = red[8192 + F.tid];
    LAS int* slots = red + 8192 + 64;
    if (F.wave == 0) {
        int base[8];
#pragma unroll
        for (int e = 0; e < 8; ++e) base[e] = red[8192 + 8 + e];
        for (int ch = 0; r_lo + ch < r_hi; ch += 64) {
            const int r = r_lo + ch + F.lane; const bool valid = r < r_hi; const int s_ = valid ? SEL[r] : 0xffff; const int e0 = s_ & 255, e1 = (s_ >> 8) & 255;
            int p0 = 0, p1 = 0, g0 = 0, g1 = 0;
#pragma unroll
            for (int e = 0; e < 8; ++e) { const unsigned long long m = __ballot((e0 == e) || (e1 == e)); const int pre = base[e] + __popcll(m & ((1ull << F.lane) - 1ull));
                if (e0 == e) { p0 = pre; g0 = seg_start(ts, e); } if (e1 == e) { p1 = pre; g1 = seg_start(ts, e); } base[e] += __popcll(m); }
            if (valid) { POS[2 * r] = p0; POS[2 * r + 1] = p1; slots[2 * (ch + F.lane)] = g0 * 256 + p0; slots[2 * (ch + F.lane) + 1] = g1 * 256 + p1; }
        }
    }
    __syncthreads();
    const int nb = r_hi - r_lo;
    for (int i0 = F.wave * 4; i0 < nb; i0 += NWAVES * 4) {
        u32x4 a[4][2];
#pragma unroll
        for (int u = 0; u < 4; ++u) if (i0 + u < nb) { const u32x4* src = (const u32x4*)(H + (size_t)(r_lo + i0 + u) * DM); a[u][0] = src[F.lane]; a[u][1] = src[64 + F.lane]; }
#pragma unroll
        for (int u = 0; u < 4; ++u) if (i0 + u < nb) {
#pragma unroll
            for (int j = 0; j < 2; ++j) { u32x4* dst = (u32x4*)(AG + (size_t)slots[2 * (i0 + u) + j] * DM); dst[F.lane] = a[u][0]; dst[64 + F.lane] = a[u][1]; } }
    }
}
__device__ __forceinline__ f32x4 moe_y(const bf16_t* YS, const float* PARTM, size_t so, int nsl, int c) {
    if (so < (size_t)128 * 256 * DM) { const u32x2 y = *(const u32x2*)(YS + so + c); return (f32x4){bflo(y.x), bfhi(y.x), bflo(y.y), bfhi(y.y)}; }
    f32x4 a = (f32x4){0.f, 0.f, 0.f, 0.f}; const float* p = PARTM + (so - (size_t)128 * 256 * DM) + c;
    for (int ks = 0; ks < nsl; ++ks) a += *(const f32x4*)(p + (size_t)ks * PARTM_ROWS * 1024);
    return a;
}
template <int MODE>
__device__ __forceinline__ void p_moe_combine(const Frame& F, int layer, int row_lo) {
    const int* SEL = WSP(int, WS_SEL); const int* POS = WSP(int, WS_POS); const float* WTS = WSP(float, WS_WTS); const bf16_t* YS = SCR(bf16_t, S_YS);
    bf16_t* XW = WSP(bf16_t, WS_XW); bf16_t* H = WSP(bf16_t, WS_H);
    const float* MOD = WSP(float, WS_MOD) + (size_t)layer * 3 * 6144; const float* MODN = MOD + 3 * 6144;
    LAS float* GSw = (LAS float*)(F.lds + NL_GS); LAS float* GT = (LAS float*)(F.lds + NL_X);
    if (MODE == 0) stage_norm_params(F, F.in[I_N1G] + (layer + 1) * DM, MODN, 0);
    else { for (int i = F.tid; i < DM; i += NWAVES * 64) GSw[i] = F.in[I_FG][i]; }
    for (int i = F.tid; i < 3 * DM; i += NWAVES * 64) GT[i] = MOD[(size_t)(i >> 10) * 6144 + 5 * DM + (i & 1023)];
    __syncthreads();
    LAS const float* GS = GSw; LAS const float* SH = (LAS const float*)(F.lds + NL_SH);
    int ts[NEXP]; moe_starts(F, ts);
    const float* PARTM = SCR(float, S_PARTM);
    int nsl = 0; { const int nM = ts[NEXP - 1], tailU = (nM - 128) * 4; if (tailU > 0) { nsl = 256 / tailU; nsl = nsl > 7 ? 7 : (nsl < 1 ? 1 : nsl); } }
    const int gw = F.vcu * NWAVES + F.wave, NGW = F.G * NWAVES, lane = F.lane;
    struct CIdx { int s, p0, p1; float w0, w1; };
    struct CDat { u32x2 y0[4], y1[4], xr[4]; f32x4 fs[4]; int fast0, fast1; float w0, w1; };
    const size_t TAIL0 = (size_t)128 * 256 * DM;
    auto iload = [&](CIdx& x, int r) { x.s = SEL[r]; x.p0 = POS[2 * r]; x.p1 = POS[2 * r + 1]; x.w0 = WTS[2 * r]; x.w1 = WTS[2 * r + 1]; };
    auto dload = [&](CDat& d, const CIdx& x, int r) {
        const int e0 = x.s & 255, e1 = x.s >> 8;
        const size_t s0 = (size_t)(seg_start(ts, e0) * 256 + x.p0) * DM, s1 = (size_t)(seg_start(ts, e1) * 256 + x.p1) * DM;
        d.fast0 = s0 < TAIL0; d.fast1 = s1 < TAIL0; d.w0 = x.w0; d.w1 = x.w1;
#pragma unroll
        for (int j = 0; j < 4; ++j) { const int c = 4 * lane + 256 * j;
            d.xr[j] = *(const u32x2*)(XW + (size_t)r * DM + c);
            if (d.fast0) d.y0[j] = *(const u32x2*)(YS + s0 + c);
            if (d.fast1) d.y1[j] = *(const u32x2*)(YS + s1 + c);
            d.fs[j] = (f32x4){0.f, 0.f, 0.f, 0.f};
            if (!d.fast0) d.fs[j] += moe_y(YS, PARTM, s0, nsl, c) * x.w0;
            if (!d.fast1) d.fs[j] += moe_y(YS, PARTM, s1, nsl, c) * x.w1; }
    };
    auto process = [&](const CDat& d, int r) {
        const int sm = row_sample(r);
        f32x4 v[4]; float ss = 0.f;
#pragma unroll
        for (int j = 0; j < 4; ++j) { const int c = 4 * lane + 256 * j;
            f32x4 f = d.fs[j];
            if (d.fast0) f += (f32x4){bflo(d.y0[j].x), bfhi(d.y0[j].x), bflo(d.y0[j].y), bfhi(d.y0[j].y)} * d.w0;
            if (d.fast1) f += (f32x4){bflo(d.y1[j].x), bfhi(d.y1[j].x), bflo(d.y1[j].y), bfhi(d.y1[j].y)} * d.w1;
            v[j] = (f32x4){bflo(d.xr[j].x), bfhi(d.xr[j].x), bflo(d.xr[j].y), bfhi(d.xr[j].y)} + *(LAS const f32x4*)(GT + sm * DM + c) * f;
            if (MODE == 0) st_x4(XW + (size_t)r * DM + c, v[j]);
            ss += (v[j][0] * v[j][0] + v[j][1] * v[j][1]) + (v[j][2] * v[j][2] + v[j][3] * v[j][3]); }
        const float rstd = __builtin_amdgcn_rsqf(wave_sum(ss) * (1.f / DM) + NORM_EPS);
        if (MODE == 0) {
#pragma unroll
            for (int j = 0; j < 4; ++j) { const int c = 4 * lane + 256 * j; v[j] = v[j] * rstd * *(LAS const f32x4*)(GS + sm * DM + c) + *(LAS const f32x4*)(SH + sm * DM + c); }
            store_row_bf16(H + (size_t)r * DM, lane, v);
        } else {
#pragma unroll
            for (int j = 0; j < 4; ++j) { const int c = 4 * lane + 256 * j; *(f32x4*)(F.out + (size_t)(r - RC) * DM + c) = v[j] * rstd * *(LAS const f32x4*)(GS + c); }
        }
    };
    CIdx ia, ib; CDat da, db;
    int row = row_lo + gw;
    if (row < RT) iload(ia, row);
    if (row + NGW < RT) iload(ib, row + NGW);
    if (row < RT) dload(da, ia, row);
    for (; row < RT; row += 2 * NGW) {
        if (row + 2 * NGW < RT) iload(ia, row + 2 * NGW);
        if (row + NGW < RT) dload(db, ib, row + NGW);
        process(da, row);
        if (row + NGW >= RT) break;
        if (row + 3 * NGW < RT) iload(ib, row + 3 * NGW);
        if (row + 2 * NGW < RT) dload(da, ia, row + 2 * NGW);
        process(db, row + NGW);
    }
}

constexpr int N_PHASES = 39;
__global__ void __launch_bounds__(NWAVES * 64, 2) fwd_kernel(Args args) {
    extern __shared__ __attribute__((aligned(16))) unsigned char lds_raw[];
    Frame F;
    F.lds = (LAS unsigned char*)lds_raw; F.ws = args.ws; F.in = args.in; F.out = args.out;
    F.tid = threadIdx.x; F.lane = F.tid & 63; F.wave = __builtin_amdgcn_readfirstlane(F.tid >> 6);
    F.G = gridDim.x; { const int bx = blockIdx.x; F.vcu = (F.G % 8 == 0) ? (bx % 8) * (F.G / 8) + bx / 8 : bx; }
    volatile LAS unsigned* MISC = (volatile LAS unsigned*)(F.lds + MISC_OFF);
    for (int u = F.tid; u < (LDS_BYTES - LDSCTL_OFF) / 4; u += NWAVES * 64) ((LAS unsigned*)(F.lds + LDSCTL_OFF))[u] = 0u;
    __syncthreads();
    const int lo = args.ph_lo, hi = args.ph_hi;
    XcdBarrier bar; bar.bar = (unsigned*)(F.ws + WS_CTL) + CW_BAR + args.li * XCD_BAR_WORDS; bar.x = 0; bar.st = nullptr;
    if (hi - lo > 1) bar = xcd_barrier_post(bar.bar, MISC + 8);
#define IN(k) (lo <= (k) && (k) < hi)
#define SEAM(k) do { if (IN(k) && IN((k) + 1)) xcd_barrier(bar); } while (0)
#ifndef PROBE_MASK
#define PROBE_MASK 0ull
#endif
#define REPS(k) for (int rep_ = 0; rep_ < 1 + (int)((PROBE_MASK >> (k)) & 1ull); ++rep_)
#define REPBAR(k) if (rep_ + 1 < 1 + (int)((PROBE_MASK >> (k)) & 1ull)) xcd_barrier(bar);
    const int c_ = (int)blockIdx.x;
    LAS unsigned char* L = F.lds;
    float* MOD = WSP(float, WS_MOD);
    using namespace pg8;

    enum { P_PRO = 0, P_L0N1, P_MBIN, P_MBCONV, P_MBST, P_MBCARRY, P_MBOUT, P_MBOG, P_L0N2, P_FF0IN, P_FF0OUT, P_FIX1,
           P_L1N1, P_RWBIG, P_RWL2, P_WYPREP, P_RWSCAN, P_RWCOMB, P_RWOG, P_L1N2, P_M1GATH, P_M1IN, P_M1OUT, P_M1COMB,
           P_POOL, P_POOLG, P_L2N2, P_FF2IN, P_FF2OUT, P_L3N1, P_QKV, P_QKROPE, P_ATTN, P_ATOG, P_L3N2, P_M3GATH, P_M3IN, P_M3OUT, P_M3COMB };
    float* PARTC = SCR(float, S_PARTC); float* PARTM = SCR(float, S_PARTM);
    bf16_t* XWp = WSP(bf16_t, WS_XW);
#define PH(k, ...) if (IN(k)) REPS(k) { __VA_ARGS__ REPBAR(k) } SEAM(k);
    PH(P_PRO, p_prologue<0>(F);)
    PH(P_L0N1, p_norm<0>(F, 0, 0, 1, 0); __syncthreads(); p_prologue<1>(F);)
    PH(P_MBIN, SchedStd S{RT / 256, MB_NPAD / 256, F.G, c_, (size_t)256 * DM * 2, (size_t)256 * DM * 2, 0, 1, DM / 64};
        EpiMbIn E{SCR(bf16_t, S_Z), SCR(bf16_t, S_XBCP), SCR(float, S_DT), F.in[I_MBDTB]};
        gemm_phase<EpiMbIn, SchedStd, true>(L, WSP(bf16_t, WS_H), WSP(bf16_t, W_MBIN), DM, DM, S, E);)
    PH(P_MBCONV, p_mb_conv(F);)
    PH(P_MBST, p_mb_states(F);)
    PH(P_MBCARRY, p_mb_carry(F);)
    PH(P_MBOUT, p_mb_out(F);)
    PH(P_MBOG, SchedCtx S{F.G, c_, (size_t)256 * MB_DI * 2, (size_t)256 * MB_DI * 2, MB_DI / 64, (size_t)512};
        EpiRes E{XWp, F.in[I_X], F.in[I_CTX], MOD + 0 * 3 * 6144 + 2 * DM, SCR(float, S_SSQ), nullptr, 0, 1, PARTC};
        gemm_phase<EpiRes, SchedCtx, true>(L, SCR(bf16_t, S_YG), WSP(bf16_t, W_MBOUT), MB_DI, MB_DI, S, E);)
    PH(P_L0N2, p_norm<0>(F, 0, 1, 0, 0, CtxFix{MOD + 0 * 3 * 6144 + 2 * DM, SCR(float, S_SSQC), 1, MB_DI / 256});)
    PH(P_FF0IN, SchedStd S{RT / 256, 2 * FFD / 256, F.G, c_, (size_t)256 * DM * 2, (size_t)256 * DM * 2, 0, 1, DM / 64};
        EpiSwiglu E{SCR(bf16_t, S_HID), FFD, FFD / 64};
        gemm_phase<EpiSwiglu, SchedStd, true>(L, WSP(bf16_t, WS_H), WSP(bf16_t, W_FFIN), DM, DM, S, E);)
    PH(P_FF0OUT, SchedCtx S{F.G, c_, (size_t)256 * FFD * 2, (size_t)256 * FFD * 2, FFD / 64, (size_t)131072};
        EpiRes E{XWp, nullptr, nullptr, MOD + 0 * 3 * 6144 + 5 * DM, nullptr, nullptr, 0, 0, PARTC};
        gemm_phase<EpiRes, SchedCtx, true>(L, SCR(bf16_t, S_HID), WSP(bf16_t, W_FFOUT), 0, FFD, S, E);)
    PH(P_FIX1, p_ctx_fix(F, MOD + 0 * 3 * 6144 + 5 * DM, nullptr, 0, FFD / 256);)
    PH(P_L1N1, p_norm_rw(F, 1);)
    PH(P_RWBIG, SchedRw S{F.G, c_};
        EpiRwBig E{SCR(bf16_t, S_RKV), SCR(bf16_t, S_L1)};
        gemm_phase<EpiRwBig, SchedRw, true>(L, SCR(bf16_t, S_X6), WSP(bf16_t, W_RWBIG), DM, DM, S, E);)
    PH(P_WYPREP, p_rw_l2(F); p_wy_prep(F);)
    PH(P_RWSCAN, p_wy_seq(F);)
    PH(P_RWCOMB, p_rw_combine(F);)
    PH(P_RWOG, SchedCtx S{F.G, c_, (size_t)256 * DM * 2, (size_t)256 * DM * 2, DM / 64, (size_t)512};
        EpiRes E{XWp, nullptr, nullptr, MOD + 1 * 3 * 6144 + 2 * DM, nullptr, nullptr, 0, 0, PARTC};
        gemm_phase<EpiRes, SchedCtx, true>(L, SCR(bf16_t, S_OO), WSP(bf16_t, W_RWOUT), DM, DM, S, E);)
    PH(P_L1N2, p_norm<2>(F, 1, 1, 0, 0, CtxFix{MOD + 1 * 3 * 6144 + 2 * DM, nullptr, 0, DM / 256});)
    PH(P_M1GATH, p_moe_gather(F, 0);)
    PH(P_M1IN, SchedMoe S; moe_starts(F, S.ts); S.nM = S.ts[NEXP - 1]; S.nN = 2 * FFE / 256; S.G = F.G; S.c = c_; S.a_tile = (size_t)256 * DM * 2; S.b_tile = (size_t)256 * DM * 2; S.b_exp = (size_t)2 * FFE * DM * 2; S.nt = DM / 64; S.tail = 0; S.a_kpair = 256;
        EpiSwiglu E{SCR(bf16_t, S_HM), FFE, FFE / 64};
        gemm_phase<EpiSwiglu, SchedMoe, true>(L, SCR(bf16_t, S_AG), WSP(bf16_t, W_MOEIN), DM, DM, S, E);)
    PH(P_M1OUT, SchedMoe S; moe_starts(F, S.ts); S.nM = S.ts[NEXP - 1]; S.nN = DM / 256; S.G = F.G; S.c = c_; S.a_tile = (size_t)256 * FFE * 2; S.b_tile = (size_t)256 * FFE * 2; S.b_exp = (size_t)DM * FFE * 2; S.nt = FFE / 64; S.tail = 1; S.a_kpair = 65536;
        EpiBf16 E{SCR(bf16_t, S_YS), DM, PARTM, 128 * 256, (size_t)PARTM_ROWS * 1024};
        gemm_phase<EpiBf16, SchedMoe, true>(L, SCR(bf16_t, S_HM), WSP(bf16_t, W_MOEOUT), 0, FFE, S, E);)
    PH(P_M1COMB, p_moe_combine<0>(F, 1, 0);)
    PH(P_POOL, p_pool(F, SCR(bf16_t, S_YG));)
    PH(P_POOLG, SchedStd S{RT / 256, DM / 256, F.G, c_, (size_t)256 * DM * 2, (size_t)256 * 256 * 2, 512, 1, 256 / 64};
        EpiRes E{XWp, nullptr, nullptr, MOD + 2 * 3 * 6144 + 2 * DM, nullptr, F.in[I_PLS], 0, 0, nullptr};
        gemm_phase<EpiRes, SchedStd, true>(L, SCR(bf16_t, S_YG), WSP(bf16_t, W_POOL), DM, 256, S, E);)
    PH(P_L2N2, p_norm<0>(F, 2, 1, 0, 0);)
    PH(P_FF2IN, SchedStd S{RT / 256, 2 * FFD / 256, F.G, c_, (size_t)256 * DM * 2, (size_t)256 * DM * 2, 0, 1, DM / 64};
        EpiSwiglu E{SCR(bf16_t, S_HID), FFD, FFD / 64};
        gemm_phase<EpiSwiglu, SchedStd, true>(L, WSP(bf16_t, WS_H), WSP(bf16_t, W_FFIN) + (size_t)2 * FFD * DM, DM, DM, S, E);)
    PH(P_FF2OUT, SchedCtx S{F.G, c_, (size_t)256 * FFD * 2, (size_t)256 * FFD * 2, FFD / 64, (size_t)131072};
        EpiRes E{XWp, nullptr, nullptr, MOD + 2 * 3 * 6144 + 5 * DM, nullptr, nullptr, 0, 0, PARTC};
        gemm_phase<EpiRes, SchedCtx, true>(L, SCR(bf16_t, S_HID), WSP(bf16_t, W_FFOUT) + (size_t)DM * FFD, 0, FFD, S, E);)
    PH(P_L3N1, p_norm<0>(F, 3, 0, 0, 0, CtxFix{MOD + 2 * 3 * 6144 + 5 * DM, nullptr, 0, FFD / 256});)
    PH(P_QKV, SchedStd S{RT / 256, 1536 / 256, F.G, c_, (size_t)256 * DM * 2, (size_t)256 * DM * 2, 0, 1, DM / 64};
        EpiBf16 E{SCR(bf16_t, S_QKV), 1536, nullptr, 0, 0};
        gemm_phase<EpiBf16, SchedStd, true>(L, WSP(bf16_t, WS_H), WSP(bf16_t, W_QKV), DM, DM, S, E);)
    PH(P_QKROPE, p_qkrope(F);)
    PH(P_ATTN,
        const attn_body::bf16* Q = (const attn_body::bf16*)SCR(bf16_t, S_QKV); const attn_body::bf16* K = (const attn_body::bf16*)SCR(bf16_t, S_KB); const attn_body::bf16* V = (const attn_body::bf16*)SCR(bf16_t, S_VB);
        attn_body::bf16* O = (attn_body::bf16*)SCR(bf16_t, S_AO);
        for (int ui = F.vcu; ui < 1024; ui += F.G) { const int bh = ui >> 5, qb = ui & 31; attn_body::attn_unit<8>(bh >> 4, bh & 15, qb, Q, F.in[I_ATQG], WSP(float, WS_ROPE), K, V, O, (char*)lds_raw); })
    PH(P_ATOG, SchedStd S{RL / 256, DM / 256, F.G, c_, (size_t)256 * DM * 2, (size_t)256 * DM * 2, 0, 1, DM / 64};
        EpiRes E{XWp, nullptr, nullptr, MOD + 3 * 3 * 6144 + 2 * DM, nullptr, nullptr, RC, 0, nullptr};
        gemm_phase<EpiRes, SchedStd, true>(L, SCR(bf16_t, S_AO), WSP(bf16_t, W_ATOUT), DM, DM, S, E);)
    PH(P_L3N2, p_norm<2>(F, 3, 1, 0, RC);)
    PH(P_M3GATH, p_moe_gather(F, RC);)
    PH(P_M3IN, SchedMoe S; moe_starts(F, S.ts); S.nM = S.ts[NEXP - 1]; S.nN = 2 * FFE / 256; S.G = F.G; S.c = c_; S.a_tile = (size_t)256 * DM * 2; S.b_tile = (size_t)256 * DM * 2; S.b_exp = (size_t)2 * FFE * DM * 2; S.nt = DM / 64; S.tail = 0; S.a_kpair = 256;
        EpiSwiglu E{SCR(bf16_t, S_HM), FFE, FFE / 64};
        gemm_phase<EpiSwiglu, SchedMoe, true>(L, SCR(bf16_t, S_AG), WSP(bf16_t, W_MOEIN) + (size_t)8 * 2 * FFE * DM, DM, DM, S, E);)
    PH(P_M3OUT, SchedMoe S; moe_starts(F, S.ts); S.nM = S.ts[NEXP - 1]; S.nN = DM / 256; S.G = F.G; S.c = c_; S.a_tile = (size_t)256 * FFE * 2; S.b_tile = (size_t)256 * FFE * 2; S.b_exp = (size_t)DM * FFE * 2; S.nt = FFE / 64; S.tail = 1; S.a_kpair = 65536;
        EpiBf16 E{SCR(bf16_t, S_YS), DM, PARTM, 128 * 256, (size_t)PARTM_ROWS * 1024};
        gemm_phase<EpiBf16, SchedMoe, true>(L, SCR(bf16_t, S_HM), WSP(bf16_t, W_MOEOUT) + (size_t)8 * DM * FFE, 0, FFE, S, E);)
    if (IN(P_M3COMB)) { p_moe_combine<1>(F, 3, RC); }
#undef PH
#undef IN
#undef SEAM
}

#ifndef MK_CUTS
#define MK_CUTS 0
#endif
extern "C" void kernel_launch(void* const* d_in, const int* in_sizes, int n_in, void* d_out, int out_size, void* d_ws, size_t ws_size, hipStream_t stream) {
    static int grid = 0;
    if (grid == 0) {
        if (n_in != 44 || out_size != RL * DM || ws_size < WS_END) { fprintf(stderr, "kernel_launch: unexpected sizes (n_in %d out %d ws %zu)\n", n_in, out_size, ws_size); grid = -1; return; }
        int dev = 0, cus = 0, per_cu = 0;
        if (hipGetDevice(&dev) != hipSuccess || hipDeviceGetAttribute(&cus, hipDeviceAttributeMultiprocessorCount, dev) != hipSuccess) { grid = -1; return; }
        if (hipFuncSetAttribute((const void*)fwd_kernel, hipFuncAttributeMaxDynamicSharedMemorySize, LDS_BYTES) != hipSuccess) { fprintf(stderr, "kernel_launch: hipFuncSetAttribute failed\n"); grid = -1; return; }
        if (hipOccupancyMaxActiveBlocksPerMultiprocessor(&per_cu, (const void*)fwd_kernel, NWAVES * 64, LDS_BYTES) != hipSuccess || per_cu < 1)
            fprintf(stderr, "kernel_launch: occupancy query reports %d\n", per_cu);
        (void)hipGetLastError();
        grid = cus;
    }
    if (grid < 0) return;
    (void)hipMemsetAsync((char*)d_ws + WS_CTL + (size_t)CW_BAR * 4, 0, (size_t)XCD_BAR_WORDS * 4, stream);
    Args a{};
    for (int i = 0; i < 44; ++i) a.in[i] = (const float*)d_in[i];
    a.out = (float*)d_out; a.ws = (unsigned char*)d_ws; a.pad = 0;
#if MK_CUTS == 0
    a.ph_lo = 0; a.ph_hi = N_PHASES; a.li = 0;
    hipLaunchKernelGGL(fwd_kernel, dim3(grid), dim3(NWAVES * 64), LDS_BYTES, stream, a);
#else
    for (int p = 0; p < N_PHASES; ++p) { a.ph_lo = p; a.ph_hi = p + 1; a.li = 0; hipLaunchKernelGGL(fwd_kernel, dim3(grid), dim3(NWAVES * 64), LDS_BYTES, stream, a); }
#endif
}
```

```cpp
#include <hip/hip_runtime.h>
#include <hip/hip_bf16.h>
#include <cstdio>
#include <cstdint>
#include <cmath>

#define LAS __attribute__((address_space(3)))
#define GAS __attribute__((address_space(1)))
typedef unsigned short bf16_t;
typedef short bf16x8 __attribute__((ext_vector_type(8)));
typedef short s16x4 __attribute__((ext_vector_type(4)));
typedef float f32x4 __attribute__((ext_vector_type(4)));
typedef float f32x2 __attribute__((ext_vector_type(2)));
typedef unsigned u32x4 __attribute__((ext_vector_type(4)));
typedef unsigned u32x2 __attribute__((ext_vector_type(2)));

constexpr int DM = 1024, NB = 2, TL = 8192, TC = 256;
constexpr int RC = NB * TC, RL = NB * TL, RT = RC + RL;
constexpr float NORM_EPS = 1e-6f;
constexpr int MB_DI = 2048, MB_XBC = 3072, MB_NIN = 5184, MB_NPAD = 5376, MB_CH = 128, MB_NSC = RT / MB_CH;
constexpr int FFD = 2816, FFE = 3584, NEXP = 8;
constexpr int MOE_MAXT = 140;
constexpr int KVL = TC + TL;

constexpr size_t MiB = (size_t)1 << 20;
constexpr size_t WS_CTL = 0, CTL_ZERO_BYTES = 1 * MiB;
constexpr size_t WS_MOD = 4 * MiB;
constexpr size_t WS_ROPE = 4 * MiB + 512 * 1024;
constexpr size_t WS_SEL = 5 * MiB;
constexpr size_t WS_WTS = WS_SEL + 128 * 1024;
constexpr size_t WS_POS = WS_WTS + 256 * 1024;
constexpr size_t WS_CNT = WS_POS + 256 * 1024;
constexpr size_t W_MBIN = 8 * MiB, W_MBOUT = 19 * MiB, W_RWBIG = 23 * MiB  , W_RWL2 = 37 * MiB  , W_RWOUT = 40 * MiB, W_POOL = 42 * MiB, W_QKV = 43 * MiB, W_ATOUT = 46 * MiB;
constexpr size_t W_FFIN = 48 * MiB, W_FFOUT = 70 * MiB, W_MOEIN = 82 * MiB, W_MOEOUT = 306 * MiB;
constexpr size_t WS_XW = 420 * MiB, WS_H = 486 * MiB, WS_SCR = 552 * MiB, WS_END = 1640 * MiB;
constexpr size_t S_Z = 0, S_XBCP = 66 * MiB, S_XBC = 165 * MiB, S_DT = 264 * MiB, S_ST = 270 * MiB, S_DTOT = 402 * MiB, S_YG = 403 * MiB, S_SSQ = 469 * MiB, S_SSQC = 470 * MiB;
constexpr size_t S_HID = 0;
constexpr size_t S_RKV = 0, S_X6 = 100 * MiB, S_L1 = 300 * MiB, S_WD = 320 * MiB, S_AD = 452 * MiB  , S_BON2 = 456 * MiB, S_GG = 520 * MiB, S_YY = 555 * MiB, S_OO = 100 * MiB;
constexpr size_t S_AG = 0, S_HM = 70 * MiB, S_YS = 315 * MiB, S_PARTM = 385 * MiB;
constexpr int PARTM_ROWS = (MOE_MAXT - 128) * 256;
constexpr size_t S_WY = 704 * MiB;
constexpr size_t S_PARTC = 1036 * MiB;
constexpr size_t S_QKV = 0, S_QB = 50 * MiB, S_KB = 82 * MiB, S_VB = 91 * MiB, S_AO = 100 * MiB;
constexpr int CW_BAR = 4096;

constexpr int RING_BYTES = 143360;
constexpr int LDSCTL_OFF = RING_BYTES, MISC_OFF = LDSCTL_OFF + 320;
constexpr int LDS_BYTES = 147456;
constexpr int NWAVES = 8;

#define RLX_AGENT __ATOMIC_RELAXED, __HIP_MEMORY_SCOPE_AGENT
#define LDS_WAIT() asm volatile("s_waitcnt lgkmcnt(0)" ::: "memory")
typedef __bf16 bf16x2_hw __attribute__((ext_vector_type(2)));
__device__ __forceinline__ unsigned pk2(float lo, float hi) { const f32x2 v = {lo, hi}; const bf16x2_hw b = __builtin_convertvector(v, bf16x2_hw); return __builtin_bit_cast(unsigned, b); }
__device__ __forceinline__ unsigned f2bf(float f) { return pk2(f, f) & 0xffffu; }
__device__ __forceinline__ float bf2f(unsigned short b) { return __builtin_bit_cast(float, (unsigned)b << 16); }
__device__ __forceinline__ float bflo(unsigned w) { return __builtin_bit_cast(float, w << 16); }
__device__ __forceinline__ float bfhi(unsigned w) { return __builtin_bit_cast(float, w & 0xffff0000u); }
__device__ __forceinline__ float wave_sum(float v) {
#define WS_DPP(x, ctrl) __builtin_bit_cast(float, __builtin_amdgcn_update_dpp(0, __builtin_bit_cast(int, x), ctrl, 0xf, 0xf, false))
    v += WS_DPP(v, 0xB1); v += WS_DPP(v, 0x4E); v += WS_DPP(v, 0x141); v += WS_DPP(v, 0x140);
#undef WS_DPP
    const float a = __builtin_bit_cast(float, __builtin_amdgcn_readlane(__builtin_bit_cast(int, v), 0)), b = __builtin_bit_cast(float, __builtin_amdgcn_readlane(__builtin_bit_cast(int, v), 16)),
                c = __builtin_bit_cast(float, __builtin_amdgcn_readlane(__builtin_bit_cast(int, v), 32)), d = __builtin_bit_cast(float, __builtin_amdgcn_readlane(__builtin_bit_cast(int, v), 48));
    return (a + b) + (c + d);
}
__device__ __forceinline__ float sigmoidf_(float x) { return __builtin_amdgcn_rcpf(1.f + __expf(-x)); }
__device__ __forceinline__ float siluf_(float x) { return x * __builtin_amdgcn_rcpf(1.f + __expf(-x)); }
__device__ __forceinline__ void unpack8(const u32x4 w, float* v) {
    v[0] = bflo(w.x); v[1] = bfhi(w.x); v[2] = bflo(w.y); v[3] = bfhi(w.y); v[4] = bflo(w.z); v[5] = bfhi(w.z); v[6] = bflo(w.w); v[7] = bfhi(w.w);
}
__device__ __forceinline__ u32x4 pack8(const float* v) { u32x4 w; w.x = pk2(v[0], v[1]); w.y = pk2(v[2], v[3]); w.z = pk2(v[4], v[5]); w.w = pk2(v[6], v[7]); return w; }
__device__ __forceinline__ f32x4 ld_x4(const bf16_t* p) { const u32x2 w = *(const u32x2*)p; return (f32x4){bflo(w.x), bfhi(w.x), bflo(w.y), bfhi(w.y)}; }
__device__ __forceinline__ void st_x4(bf16_t* p, const f32x4 v) { u32x2 w; w.x = pk2(v[0], v[1]); w.y = pk2(v[2], v[3]); *(u32x2*)p = w; }
__device__ __forceinline__ int row_sample(int row) { return row < RC ? 0 : 1 + ((row - RC) >> 13); }

#define XB_TMO      128
#define XB_XCNT(j)  (256  + 64 * (j))
#define XB_XSUB(j)  (1280 + 64 * (j))
#define XB_XGEN(j)  (2304 + 64 * (j))
#define XB_TOP      3328
#define XB_TOPGEN   3392
#define XCD_BAR_WORDS 3456
#define XB_SPIN_CAP (1u << 22)
__device__ __forceinline__ unsigned xb_ld(unsigned* p)              { return __hip_atomic_load(p, __ATOMIC_RELAXED, __HIP_MEMORY_SCOPE_AGENT); }
__device__ __forceinline__ unsigned xb_add(unsigned* p, unsigned v) { return __hip_atomic_fetch_add(p, v, __ATOMIC_RELAXED, __HIP_MEMORY_SCOPE_AGENT); }
__device__ __forceinline__ unsigned xb_xcc_id() { return (unsigned)__builtin_amdgcn_s_getreg((3 << 11) | 20) & 0xFu; }
#define XB_SPIN(cond, bar) do { unsigned _sp = 0; while (cond) { __builtin_amdgcn_s_sleep(1); \
    if ((++_sp & 255u) == 0u) { if (xb_ld(&(bar)[XB_TMO])) break; if (_sp > XB_SPIN_CAP) { atomicAdd(&(bar)[XB_TMO], 1u); break; } } } } while (0)
struct XcdBarrier { unsigned* bar; unsigned x; volatile LAS unsigned* st; };
__device__ __forceinline__ XcdBarrier xcd_barrier_post(unsigned* bar, volatile LAS unsigned* st) {
    XcdBarrier b; b.bar = bar; b.x = xb_xcc_id(); b.st = st;
    if (threadIdx.x == 0) (void)xb_add(&bar[XB_XCNT(b.x)], 1u);
    return b;
}
__device__ __forceinline__ void xcd_barrier_complete(unsigned* bar, unsigned x, unsigned& nloc, unsigned& nx) {
    const unsigned G = gridDim.x * gridDim.y * gridDim.z;
    unsigned sum, cnt, mine, sp = 0u;
    for (;;) {
        sum = 0u; cnt = 0u; mine = 0u;
#pragma unroll
        for (unsigned j = 0; j < 16; ++j) { const unsigned c = xb_ld(&bar[XB_XCNT(j)]); sum += c; cnt += (c > 0u) ? 1u : 0u; mine = (j == x) ? c : mine; }
        if (sum == G) break;
        __builtin_amdgcn_s_sleep(1);
        if ((++sp & 255u) == 0u) { if (xb_ld(&bar[XB_TMO])) break; if (sp > XB_SPIN_CAP) { atomicAdd(&bar[XB_TMO], 1u); break; } }
    }
    nloc = mine > 0u ? mine : 1u; nx = cnt > 0u ? cnt : 1u;
}
__device__ __forceinline__ void xcd_barrier(const XcdBarrier& b) {
    asm volatile("s_waitcnt vmcnt(0)" ::: "memory");
    __syncthreads();
    if (threadIdx.x == 0) {
        unsigned* bar = b.bar;
        __builtin_amdgcn_s_waitcnt(0);
        unsigned nloc = b.st[0], nx = b.st[1];
        if (nloc == 0u) { xcd_barrier_complete(bar, b.x, nloc, nx); b.st[0] = nloc; b.st[1] = nx; }
        const unsigned old = xb_add(&bar[XB_XSUB(b.x)], 1u);
        const unsigned gen = old / nloc;
        if (old + 1u == (gen + 1u) * nloc) {
            __builtin_amdgcn_fence(__ATOMIC_RELEASE, "agent");
            asm volatile("s_waitcnt vmcnt(0)" ::: "memory");
            const unsigned og = xb_add(&bar[XB_TOP], 1u);
            const unsigned tg = og / nx;
            if (og + 1u == (tg + 1u) * nx) xb_add(&bar[XB_TOPGEN], 1u);
            else XB_SPIN(xb_ld(&bar[XB_TOPGEN]) == tg, bar);
            __builtin_amdgcn_fence(__ATOMIC_ACQUIRE, "agent");
            xb_add(&bar[XB_XGEN(b.x)], 1u);
            asm volatile("s_waitcnt vmcnt(0)" ::: "memory");
        } else {
            XB_SPIN(xb_ld(&bar[XB_XGEN(b.x)]) == gen, bar);
            __builtin_amdgcn_fence(__ATOMIC_ACQUIRE, "agent");
            asm volatile("s_waitcnt vmcnt(0)" ::: "memory");
        }
    }
    __syncthreads();
}

namespace pg8 {
constexpr int BM = 256, BK = 64, HALF = 128, HTB = HALF * BK * 2, STAGE_BYTES = 8 * HTB, NXCD = 8, WGM = 8;
__host__ __device__ __forceinline__ int lds_byte(int r, int c) { const int st = (r >> 4) * 2 + (c >> 5), rr = r & 15, cc = c & 31, ob = rr * 64 + cc * 2; return st * 1024 + (ob ^ (((ob >> 9) & 1) << 5)); }
__host__ __device__ __forceinline__ void stage_rc(int b, int& R, int& C) { const int st = b / 1024, sb = b % 1024, swz = sb ^ (((sb >> 9) & 1) << 5); R = (st >> 1) * 16 + swz / 64; C = (st & 1) * 32 + (swz % 64) / 2; }
__host__ __device__ __forceinline__ int perm32(int rho) { const int n = rho >> 4, i = rho & 15; return 8 * (i >> 2) + 4 * n + (i & 3); }

struct Unit { int pm, pn; size_t aoff, boff; int nt, ks; };
__device__ __forceinline__ void tile_of(int wgid, int nM, int nN, int& pm, int& pn) {
    const int nwg = nM * nN;
    { const int q = nwg / NXCD, r = nwg % NXCD, xcd = wgid % NXCD, off = wgid / NXCD; wgid = (xcd < r ? xcd * (q + 1) : r * (q + 1) + (xcd - r) * q) + off; }
    const int nig = WGM * nN, gid = wgid / nig, fm = gid * WGM, gsz = (nM - fm) < WGM ? (nM - fm) : WGM;
    pm = fm + ((wgid % nig) % gsz); pn = (wgid % nig) / gsz;
}
struct SchedStd {
    int nM, nN, G, c; size_t a_tile, b_tile, a_add; int a_div; int nt;
    __device__ __forceinline__ bool next(int i, Unit& u) const {
        const long L = (long)i * G + c; if (L >= (long)nM * nN) return false;
        tile_of((int)L, nM, nN, u.pm, u.pn); u.nt = nt; u.ks = -1;
        u.aoff = (size_t)u.pm * a_tile + (size_t)(u.pn / a_div) * a_add; u.boff = (size_t)u.pn * b_tile; return true;
    }
};
struct SchedMoe {
    int nM, nN, G, c; size_t a_tile, b_tile, b_exp; int ts[NEXP]; int nt; int tail; size_t a_kpair;
    __device__ __forceinline__ bool next(int i, Unit& u) const {
        const int L = i * G + c; size_t koff = 0, koffA = 0; u.nt = nt; u.ks = -1;
        if (!tail) { if (L >= nM * nN) return false; tile_of(L, nM, nN, u.pm, u.pn); }
        else {
            const int nFull = nM < 128 ? nM : 128, fullU = nFull * nN;
            if (L < fullU) tile_of(L, nFull, nN, u.pm, u.pn);
            else { const int tailU = (nM - nFull) * nN; if (tailU <= 0) return false; int S = 256 / tailU; S = S > 7 ? 7 : (S < 1 ? 1 : S);
                const int q = L - fullU; if (q >= tailU * S) return false;
                const int ks = q / tailU, tu = q % tailU, np = nt / 2, p0 = ks * np / S, p1 = (ks + 1) * np / S;
                u.pm = nFull + tu / nN; u.pn = tu % nN; u.ks = ks; u.nt = 2 * (p1 - p0); koff = (size_t)p0 * 256; koffA = (size_t)p0 * a_kpair; }
        }
        int e = 0;
#pragma unroll
        for (int j = 0; j < NEXP - 1; ++j) e += (u.pm >= ts[j]) ? 1 : 0;
        u.aoff = (size_t)u.pm * a_tile + koffA; u.boff = (size_t)e * b_exp + (size_t)u.pn * b_tile + koff; return true;
    }
};
struct SchedRw {
    int G, c;
    __device__ __forceinline__ bool next(int i, Unit& u) const {
        const int L = i * G + c; if (L >= (RT / 256) * 15) return false;
        tile_of(L, RT / 256, 15, u.pm, u.pn); u.nt = DM / 64; u.ks = -1;
        const int g4 = u.pn >> 2, ai = u.pn < 12 ? (g4 == 0 ? 0 : g4 + 1) : (u.pn == 12 ? 1 : u.pn - 9);
        u.aoff = (size_t)ai * RT * DM * 2 + (size_t)u.pm * 256 * DM * 2; u.boff = (size_t)u.pn * 256 * DM * 2; return true;
    }
};
struct SchedCtx {
    int G, c; size_t a_tile, b_tile; int nt; size_t a_ks;
    __device__ __forceinline__ bool next(int i, Unit& u) const {
        const int L = i * G + c;
        if (L < 256) { tile_of(L, 64, 4, u.pm, u.pn); u.pm += 2; u.nt = nt; u.ks = -1; u.aoff = (size_t)u.pm * a_tile; u.boff = (size_t)u.pn * b_tile; return true; }
        const int q = L - 256, S = nt / 4; if (q >= 8 * S) return false;
        const int ks = q >> 3, r = q & 7; u.pm = r >> 2; u.pn = r & 3; u.nt = 4; u.ks = ks;
        u.aoff = (size_t)u.pm * a_tile + (size_t)ks * a_ks; u.boff = (size_t)u.pn * b_tile + (size_t)ks * 512; return true;
    }
};

__device__ __forceinline__ unsigned cvt_pk_bf16(float lo, float hi) { unsigned r; asm volatile("v_cvt_pk_bf16_f32 %0, %1, %2" : "=v"(r) : "v"(lo), "v"(hi)); return r; }

template <class Epi, class Sched, bool ALIGN_EPI>
__device__ __forceinline__ void gemm_phase(LAS unsigned char* lds, const bf16_t* Abase, const bf16_t* Bbase, int lda  , int ldb, const Sched& S, const Epi& E) {
    const int tid = threadIdx.x, wid = __builtin_amdgcn_readfirstlane(tid >> 6), lane = tid & 63, wr = wid >> 2, wc = wid & 3, fr = lane & 15, fq = lane >> 4;
    unsigned voffA[2], voffB[2];
    const int lda_e = lda <= 0 ? BK : lda;
#pragma unroll
    for (int i = 0; i < 2; ++i) { int R, C; stage_rc(tid * 16 + i * 8192, R, C); const int Rb = (R & ~31) + perm32(R & 31);
        voffA[i] = (unsigned)(R * lda_e + C) * 2u; voffB[i] = (unsigned)(Rb * ldb + C) * 2u; }
    const bool a_blk = lda <= 0; if (a_blk) lda = BK;
    const size_t kstepA = a_blk ? (size_t)BM * BK * 2 : (size_t)(BK * 2), kstep = (size_t)(BK * 2);
    const size_t hstepA = (size_t)HALF * lda * 2, hstepB = (size_t)HALF * ldb * 2;
    const unsigned ldsw = (unsigned)wid * 1024u;
    const int aoff = lds_byte(wr * 64 + fr, fq * 8), boff = lds_byte(wc * 32 + fr, fq * 8);
#define PG8_SA(b, h) (((b) * 2 + (h)) * HTB)
#define PG8_SB(b, h) ((4 + (b) * 2 + (h)) * HTB)
#define PG8_STAGE(bufoff, gbase, voff) do { _Pragma("unroll") for (int _i = 0; _i < 2; ++_i) \
        __builtin_amdgcn_global_load_lds((const unsigned*)((const char*)(gbase) + (voff)[_i]), (LAS unsigned*)(lds + (bufoff) + ldsw + _i * 8192), 16, 0, 0); } while (0)
#define PG8_LDA(dst, b, h) do { _Pragma("unroll") for (int m = 0; m < 4; ++m) _Pragma("unroll") for (int k = 0; k < 2; ++k) dst[m][k] = *(const LAS bf16x8*)(lds + PG8_SA(b, h) + aoff + m * 2048 + k * 1024); } while (0)
#define PG8_LDB(dst, b, h) do { _Pragma("unroll") for (int n = 0; n < 2; ++n) _Pragma("unroll") for (int k = 0; k < 2; ++k) dst[n][k] = *(const LAS bf16x8*)(lds + PG8_SB(b, h) + boff + n * 2048 + k * 1024); } while (0)
#define PG8_MMA(ai, bj, At, Bt) do { __builtin_amdgcn_s_setprio(1); _Pragma("unroll") for (int m = 0; m < 4; ++m) _Pragma("unroll") for (int n = 0; n < 2; ++n) _Pragma("unroll") for (int k = 0; k < 2; ++k) \
        acc[ai][bj][m][n] = __builtin_amdgcn_mfma_f32_16x16x32_bf16(Bt[n][k], At[m][k], acc[ai][bj][m][n], 0, 0, 0); __builtin_amdgcn_s_setprio(0); } while (0)
#define PG8_WAIT_V(n) asm volatile("s_waitcnt vmcnt(" #n ")" ::: "memory")
#define PG8_WAIT_L(n) asm volatile("s_waitcnt lgkmcnt(" #n ")" ::: "memory")
#define PG8_BAR __builtin_amdgcn_s_barrier()
#define PG8_SCHED __builtin_amdgcn_sched_barrier(0)
    Unit cur, nxt; int ui = 0;
    if (!S.next(0, cur)) return;
    f32x4 acc[2][2][4][2];
#pragma unroll
    for (int a = 0; a < 2; ++a)
#pragma unroll
        for (int b = 0; b < 2; ++b)
#pragma unroll
            for (int m = 0; m < 4; ++m)
#pragma unroll
                for (int n = 0; n < 2; ++n) acc[a][b][m][n] = (f32x4){0.f, 0.f, 0.f, 0.f};
    bf16x8 At[4][2], B0[2][2], B1[2][2];
    const char* cA = (const char*)Abase + cur.aoff; const char* cB = (const char*)Bbase + cur.boff;
    PG8_STAGE(PG8_SB(0, 0), cB, voffB); PG8_STAGE(PG8_SB(0, 1), cB + hstepB, voffB); PG8_STAGE(PG8_SA(0, 0), cA, voffA); PG8_STAGE(PG8_SA(0, 1), cA + hstepA, voffA);
    if (wr == 1) PG8_BAR;
    PG8_WAIT_V(2); PG8_BAR;
    PG8_STAGE(PG8_SB(1, 0), cB + kstep, voffB); PG8_STAGE(PG8_SA(1, 0), cA + kstepA, voffA); PG8_STAGE(PG8_SB(1, 1), cB + hstepB + kstep, voffB);
    PG8_WAIT_V(6); PG8_BAR;
    for (;;) {
        const bool has_next = S.next(ui + 1, nxt);
        const char* nA = has_next ? (const char*)Abase + nxt.aoff : cA; const char* nB = has_next ? (const char*)Bbase + nxt.boff : cB;
        const int nt = cur.nt;
#pragma unroll 1
        for (int t = 0; t < nt; t += 2) {
            const bool last = (t == nt - 2);
            const char* a1 = cA + (size_t)(t + 1) * kstepA;
            const char* a2 = last ? nA : cA + (size_t)(t + 2) * kstepA; const char* b2 = last ? nB : cB + (size_t)(t + 2) * kstep;
            const char* a3 = a2 + kstepA; const char* b3 = b2 + kstep;
            PG8_LDB(B0, 0, 0); PG8_LDB(B1, 0, 1); PG8_SCHED; PG8_LDA(At, 0, 0); PG8_STAGE(PG8_SA(1, 1), a1 + hstepA, voffA);
            PG8_WAIT_V(8); PG8_WAIT_L(0); PG8_BAR; PG8_MMA(0, 0, At, B0); PG8_MMA(0, 1, At, B1); PG8_BAR; PG8_SCHED;
            PG8_LDA(At, 0, 1); PG8_STAGE(PG8_SB(0, 0), b2, voffB); PG8_STAGE(PG8_SB(0, 1), b2 + hstepB, voffB); PG8_STAGE(PG8_SA(0, 0), a2, voffA);
            PG8_WAIT_V(8); PG8_WAIT_L(0); PG8_BAR; PG8_MMA(1, 0, At, B0); PG8_MMA(1, 1, At, B1); PG8_BAR; PG8_SCHED;
            PG8_LDB(B0, 1, 0); PG8_LDB(B1, 1, 1); PG8_SCHED; PG8_LDA(At, 1, 0); PG8_STAGE(PG8_SA(0, 1), a2 + hstepA, voffA);
            PG8_WAIT_V(8); PG8_WAIT_L(0); PG8_BAR; PG8_MMA(0, 0, At, B0); PG8_MMA(0, 1, At, B1); PG8_BAR; PG8_SCHED;
            PG8_LDA(At, 1, 1); PG8_STAGE(PG8_SB(1, 0), b3, voffB); PG8_STAGE(PG8_SB(1, 1), b3 + hstepB, voffB); PG8_STAGE(PG8_SA(1, 0), a3, voffA);
            PG8_WAIT_V(8); PG8_WAIT_L(0); PG8_BAR; PG8_MMA(1, 0, At, B0); PG8_MMA(1, 1, At, B1); PG8_BAR; PG8_SCHED;
        }
        if constexpr (ALIGN_EPI) { if (wr == 0) PG8_BAR; }
        E(acc, cur, wr, wc, fr, fq);
        if (!has_next) break;
#pragma unroll
        for (int a = 0; a < 2; ++a)
#pragma unroll
            for (int b = 0; b < 2; ++b)
#pragma unroll
                for (int m = 0; m < 4; ++m)
#pragma unroll
                    for (int n = 0; n < 2; ++n) acc[a][b][m][n] = (f32x4){0.f, 0.f, 0.f, 0.f};
        cur = nxt; cA = nA; cB = nB; ++ui;
        if constexpr (ALIGN_EPI) { if (wr == 1) PG8_BAR; }
    }
    PG8_WAIT_V(0);
    if constexpr (!ALIGN_EPI) { if (wr == 0) PG8_BAR; }
    PG8_BAR;
#undef PG8_SA
#undef PG8_SB
#undef PG8_STAGE
#undef PG8_LDA
#undef PG8_LDB
#undef PG8_MMA
#undef PG8_WAIT_V
#undef PG8_WAIT_L
#undef PG8_BAR
#undef PG8_SCHED
}

#define EPI_BEGIN _Pragma("unroll") for (int ai = 0; ai < 2; ++ai) _Pragma("unroll") for (int m = 0; m < 4; ++m) { const int rl = ai * 128 + wr * 64 + m * 16 + fr; \
    _Pragma("unroll") for (int bj = 0; bj < 2; ++bj) { const int cl = bj * 128 + wc * 32 + 8 * fq; const f32x4 v0 = acc[ai][bj][m][0], v1 = acc[ai][bj][m][1];
#define EPI_END } asm volatile("" ::: "memory"); }

struct EpiBf16 {
    bf16_t* O; int ldc; bf16_t* PART; int part_row0; size_t part_stride;
    __device__ __forceinline__ void operator()(const f32x4 (&acc)[2][2][4][2], const Unit& u, int wr, int wc, int fr, int fq) const {
        if (u.ks < 0) {
        EPI_BEGIN
            u32x4 w; w.x = cvt_pk_bf16(v0[0], v0[1]); w.y = cvt_pk_bf16(v0[2], v0[3]); w.z = cvt_pk_bf16(v1[0], v1[1]); w.w = cvt_pk_bf16(v1[2], v1[3]);
            *(u32x4*)(O + (size_t)(u.pm * BM + rl) * ldc + u.pn * BM + cl) = w;
        EPI_END
        } else {
        EPI_BEGIN
            bf16_t* o = PART + (size_t)u.ks * part_stride + (size_t)(u.pm * BM + rl - part_row0) * 1024 + u.pn * BM + cl;
            u32x4 w; w.x = cvt_pk_bf16(v0[0], v0[1]); w.y = cvt_pk_bf16(v0[2], v0[3]); w.z = cvt_pk_bf16(v1[0], v1[1]); w.w = cvt_pk_bf16(v1[2], v1[3]);
            *(u32x4*)o = w;
        EPI_END
        }
    }
};
struct EpiSwiglu {
    bf16_t* O; int ldc; int nkb;
    __device__ __forceinline__ void operator()(const f32x4 (&acc)[2][2][4][2], const Unit& u, int wr, int wc, int fr, int fq) const {
        EPI_BEGIN
            u32x2 w; w.x = cvt_pk_bf16(siluf_(v0[0]) * v0[1], siluf_(v0[2]) * v0[3]); w.y = cvt_pk_bf16(siluf_(v1[0]) * v1[1], siluf_(v1[2]) * v1[3]);
            const int hc = (u.pn * BM + cl) >> 1;
            bf16_t* o = nkb ? O + ((((size_t)u.pm * nkb + (hc >> 6)) * BM + rl) << 6) + (hc & 63) : O + (size_t)(u.pm * BM + rl) * ldc + hc;
            *(u32x2*)o = w;
        EPI_END
    }
};
struct EpiRes {
    bf16_t* XW; const float* xin_x; const float* xin_c; const float* gate;
    const float* ssq; const float* colscale; int row_base; int xin_mode; bf16_t* PART;
    __device__ __forceinline__ void operator()(const f32x4 (&acc)[2][2][4][2], const Unit& u, int wr, int wc, int fr, int fq) const {
        if (u.ks >= 0) {
        EPI_BEGIN
            bf16_t* o = PART + ((size_t)u.ks * RC + (u.pm * BM + rl)) * DM + u.pn * BM + cl;
            u32x4 w; w.x = cvt_pk_bf16(v0[0], v0[1]); w.y = cvt_pk_bf16(v0[2], v0[3]); w.z = cvt_pk_bf16(v1[0], v1[1]); w.w = cvt_pk_bf16(v1[2], v1[3]);
            *(u32x4*)o = w;
        EPI_END
            return;
        }
        const float* gp = gate + (size_t)row_sample(row_base + u.pm * BM) * 6144 + u.pn * BM + wc * 32 + 8 * fq;
        f32x4 gq[2][2], cq[2][2];
#pragma unroll
        for (int bj = 0; bj < 2; ++bj) { gq[bj][0] = *(const f32x4*)(gp + bj * 128); gq[bj][1] = *(const f32x4*)(gp + bj * 128 + 4);
            if (colscale) { const float* cp = colscale + u.pn * BM + wc * 32 + 8 * fq + bj * 128; cq[bj][0] = *(const f32x4*)cp; cq[bj][1] = *(const f32x4*)(cp + 4); }
            else { cq[bj][0] = (f32x4){1.f, 1.f, 1.f, 1.f}; cq[bj][1] = cq[bj][0]; } }
        if (xin_mode == 0 && !ssq) {
#pragma unroll
            for (int ai = 0; ai < 2; ++ai) {
                u32x4 xr[4][2];
#pragma unroll
                for (int m = 0; m < 4; ++m)
#pragma unroll
                    for (int bj = 0; bj < 2; ++bj) xr[m][bj] = *(const u32x4*)(XW + (size_t)(row_base + u.pm * BM + ai * 128 + wr * 64 + m * 16 + fr) * DM + u.pn * BM + bj * 128 + wc * 32 + 8 * fq);
#pragma unroll
                for (int m = 0; m < 4; ++m)
#pragma unroll
                    for (int bj = 0; bj < 2; ++bj) {
                        bf16_t* xo = XW + (size_t)(row_base + u.pm * BM + ai * 128 + wr * 64 + m * 16 + fr) * DM + u.pn * BM + bj * 128 + wc * 32 + 8 * fq;
                        float t8[8]; unpack8(xr[m][bj], t8);
                        const f32x4 x0 = (f32x4){t8[0], t8[1], t8[2], t8[3]} + gq[bj][0] * (acc[ai][bj][m][0] * cq[bj][0]), x1 = (f32x4){t8[4], t8[5], t8[6], t8[7]} + gq[bj][1] * (acc[ai][bj][m][1] * cq[bj][1]);
                        u32x4 w_; w_.x = cvt_pk_bf16(x0[0], x0[1]); w_.y = cvt_pk_bf16(x0[2], x0[3]); w_.z = cvt_pk_bf16(x1[0], x1[1]); w_.w = cvt_pk_bf16(x1[2], x1[3]);
                        *(u32x4*)xo = w_;
                    }
                asm volatile("" ::: "memory");
            }
            return;
        }
#pragma unroll
        for (int ai = 0; ai < 2; ++ai)
#pragma unroll
            for (int m = 0; m < 4; ++m) {
                const int rl = ai * 128 + wr * 64 + m * 16 + fr, row = row_base + u.pm * BM + rl;
                float rs = 1.f;
                if (ssq) { const f32x4 q = *(const f32x4*)(ssq + (size_t)row * 4); rs = __builtin_amdgcn_rsqf(((q[0] + q[1]) + (q[2] + q[3])) * (1.f / 2048.f) + NORM_EPS); }
#pragma unroll
                for (int bj = 0; bj < 2; ++bj) {
                    const int col = u.pn * BM + bj * 128 + wc * 32 + 8 * fq;
                    const f32x4 a0 = acc[ai][bj][m][0] * rs * cq[bj][0], a1 = acc[ai][bj][m][1] * rs * cq[bj][1];
                    bf16_t* xo = XW + (size_t)row * DM + col;
                    f32x4 x0, x1;
                    if (xin_mode == 0) { float t8[8]; unpack8(*(const u32x4*)xo, t8); x0 = (f32x4){t8[0], t8[1], t8[2], t8[3]}; x1 = (f32x4){t8[4], t8[5], t8[6], t8[7]}; }
                    else { const float* xi = row < RC ? xin_c + (size_t)row * DM + col : xin_x + (size_t)(row - RC) * DM + col; x0 = *(const f32x4*)xi; x1 = *(const f32x4*)(xi + 4); }
                    x0 = x0 + gq[bj][0] * a0; x1 = x1 + gq[bj][1] * a1;
                    u32x4 w_; w_.x = cvt_pk_bf16(x0[0], x0[1]); w_.y = cvt_pk_bf16(x0[2], x0[3]); w_.z = cvt_pk_bf16(x1[0], x1[1]); w_.w = cvt_pk_bf16(x1[2], x1[3]);
                    *(u32x4*)xo = w_;
                }
                if (m & 1) asm volatile("" ::: "memory");
            }
    }
};
__device__ __forceinline__ float softplusf_(float x) { return x > 20.f ? x : log1pf(__expf(x)); }
struct EpiMbIn {
    bf16_t* Z; bf16_t* XBCP; float* DT; const float* dt_bias;
    __device__ __forceinline__ void operator()(const f32x4 (&acc)[2][2][4][2], const Unit& u, int wr, int wc, int fr, int fq) const {
        EPI_BEGIN
            const int row = u.pm * BM + rl, col = u.pn * BM + cl;
            if (col < MB_DI + MB_XBC) {
                u32x4 w; w.x = cvt_pk_bf16(v0[0], v0[1]); w.y = cvt_pk_bf16(v0[2], v0[3]); w.z = cvt_pk_bf16(v1[0], v1[1]); w.w = cvt_pk_bf16(v1[2], v1[3]);
                bf16_t* o = (col < MB_DI) ? Z + (size_t)row * MB_DI + col : XBCP + (size_t)row * MB_XBC + (col - MB_DI);
                *(u32x4*)o = w;
            } else if (col < MB_NIN) {
                const int c = col - (MB_DI + MB_XBC);
                const f32x4 b0 = *(const f32x4*)(dt_bias + c), b1 = *(const f32x4*)(dt_bias + c + 4);
                f32x4 o0, o1;
#pragma unroll
                for (int j = 0; j < 4; ++j) { o0[j] = softplusf_(v0[j] + b0[j]); o1[j] = softplusf_(v1[j] + b1[j]); }
                *(f32x4*)(DT + (size_t)row * 64 + c) = o0; *(f32x4*)(DT + (size_t)row * 64 + c + 4) = o1;
            }
        EPI_END
    }
};
struct EpiRwBig {
    bf16_t* RKV; bf16_t* L1;
    __device__ __forceinline__ void operator()(const f32x4 (&acc)[2][2][4][2], const Unit& u, int wr, int wc, int fr, int fq) const {
        EPI_BEGIN
            const int row = u.pm * BM + rl, col = u.pn * BM + cl;
            if (col < 3072) {
                bf16_t* o = RKV + (size_t)(col >> 10) * RT * DM + (size_t)row * DM + (col & 1023);
                u32x4 w; w.x = cvt_pk_bf16(v0[0], v0[1]); w.y = cvt_pk_bf16(v0[2], v0[3]); w.z = cvt_pk_bf16(v1[0], v1[1]); w.w = cvt_pk_bf16(v1[2], v1[3]);
                *(u32x4*)o = w;
            } else {
                const int c = col - 3072, tile = c >> 8, cc = c & 255;
                if (cc < 128) {
                    float t[8];
#pragma unroll
                    for (int j = 0; j < 4; ++j) { t[j] = v0[j]; t[4 + j] = v1[j]; }
                    if (tile == 0) {
#pragma unroll
                        for (int j = 0; j < 8; ++j) t[j] = tanhf(t[j]);
                    } else if (tile == 2) {
#pragma unroll
                        for (int j = 0; j < 8; ++j) t[j] = sigmoidf_(t[j]);
                    }
                    u32x4 w; w.x = cvt_pk_bf16(t[0], t[1]); w.y = cvt_pk_bf16(t[2], t[3]); w.z = cvt_pk_bf16(t[4], t[5]); w.w = cvt_pk_bf16(t[6], t[7]);
                    *(u32x4*)(L1 + (size_t)row * 384 + tile * 128 + cc) = w;
                }
            }
        EPI_END
    }
};
struct EpiRwL2 {
    float* WD; bf16_t* AD; bf16_t* GG; const float* w0; const float* a0;
    __device__ __forceinline__ void operator()(const f32x4 (&acc)[2][2][4][2], const Unit& u, int wr, int wc, int fr, int fq) const {
        EPI_BEGIN
            const int row = u.pm * BM + rl, col = u.pn * BM + cl, seg = col >> 10, c = col & 1023;
            if (seg < 4) {
                const float* bp = (seg < 2 ? w0 : a0) + (seg & 1) * DM + c;
                const f32x4 b0 = *(const f32x4*)bp, b1 = *(const f32x4*)(bp + 4); f32x4 o0, o1;
#pragma unroll
                for (int j = 0; j < 4; ++j) { const float s0 = sigmoidf_(v0[j] + b0[j]), s1 = sigmoidf_(v1[j] + b1[j]);
                    o0[j] = seg < 2 ? -0.606531f * s0 : s0; o1[j] = seg < 2 ? -0.606531f * s1 : s1; }
                if (seg < 2) { float* o = WD + (size_t)(seg & 1) * RT * DM + (size_t)row * DM + c; *(f32x4*)o = o0; *(f32x4*)(o + 4) = o1; }
                else { u32x4 w; w.x = cvt_pk_bf16(o0[0], o0[1]); w.y = cvt_pk_bf16(o0[2], o0[3]); w.z = cvt_pk_bf16(o1[0], o1[1]); w.w = cvt_pk_bf16(o1[2], o1[3]);
                    *(u32x4*)(AD + (size_t)(seg & 1) * RT * DM + (size_t)row * DM + c) = w; }
            } else {
                u32x4 w; w.x = cvt_pk_bf16(v0[0], v0[1]); w.y = cvt_pk_bf16(v0[2], v0[3]); w.z = cvt_pk_bf16(v1[0], v1[1]); w.w = cvt_pk_bf16(v1[2], v1[3]);
                *(u32x4*)(GG + (size_t)row * DM + c) = w;
            }
        EPI_END
    }
};
}

namespace attn_body {
using bf16 = __hip_bfloat16;
using f32x16 = __attribute__((ext_vector_type(16))) float;
constexpr int D = 64, DMQ = 1024, DKV = 256;
constexpr int NW = 8, QBLK = 32, QB = QBLK * NW, KVBLK = 64;
__device__ __forceinline__ int crow(int r, int hi) { return (r & 3) + 8 * (r >> 2) + 4 * hi; }
#define SBAR() __builtin_amdgcn_sched_barrier(0)
constexpr int NSLOT = 3, SLOTB = 8192;
constexpr int LDS_K = 0, LDS_V = NSLOT * SLOTB, LDS_WS = 2 * NSLOT * SLOTB, LDS_OST = LDS_WS + NW * 64 * 4, ATTN_LDS_BYTES = LDS_OST + NW * 4096;
constexpr float C2 = 0.125f * 1.4426950408889634f;
__device__ __forceinline__ void glds16(const void* gsrc, unsigned lds_dst) { unsigned keep;
    asm volatile("s_mov_b32 %0, m0\n\ts_mov_b32 m0, %2\n\ts_nop 0\n\tglobal_load_lds_dwordx4 %1, off\n\ts_mov_b32 m0, %0" : "=&s"(keep) : "v"(gsrc), "s"(lds_dst) : "memory"); }
__device__ __forceinline__ float max3f(float a, float b, float c) { float r; asm("v_max3_f32 %0, %1, %2, %3" : "=v"(r) : "v"(a), "v"(b), "v"(c)); return r; }
__device__ __forceinline__ float max2f(float a, float b) { float r; asm("v_max_f32_e32 %0, %1, %2" : "=v"(r) : "v"(a), "v"(b)); return r; }
__device__ __forceinline__ float fadd_s(float a, float b) { float r; asm("v_add_f32_e32 %0, %1, %2" : "=v"(r) : "v"(a), "v"(b)); return r; }
__device__ __forceinline__ float fsub_s(float a, float b) { float r; asm("v_sub_f32_e32 %0, %1, %2" : "=v"(r) : "v"(a), "v"(b)); return r; }
typedef float f32x2_t __attribute__((ext_vector_type(2))); typedef __bf16 bf16x2_t __attribute__((ext_vector_type(2)));
__device__ __forceinline__ unsigned cvtpk_s(float lo, float hi) { f32x2_t v = {lo, hi}; bf16x2_t b = __builtin_convertvector(v, bf16x2_t); return __builtin_bit_cast(unsigned, b); }
#define WAIT_BAR(N) asm volatile("s_waitcnt vmcnt(" #N ") lgkmcnt(0)\n\ts_barrier" ::: "memory")
__device__ __forceinline__ void qkt(f32x16& p0, f32x16& p1, const char* Kslot, const bf16x8* qr, const f32x16& negm, int r32, int hi) {
    const char* kb = Kslot + hi * 1024 + r32 * 16;
#pragma unroll
    for (int d0 = 0; d0 < 4; ++d0) {
        const bf16x8 b0 = *reinterpret_cast<const bf16x8*>(kb + d0 * 2048);
        const bf16x8 b1 = *reinterpret_cast<const bf16x8*>(kb + d0 * 2048 + 512);
        if (d0 == 0) { p0 = __builtin_amdgcn_mfma_f32_32x32x16_bf16(b0, qr[0], negm, 0, 0, 0); p1 = __builtin_amdgcn_mfma_f32_32x32x16_bf16(b1, qr[0], negm, 0, 0, 0); }
        else { p0 = __builtin_amdgcn_mfma_f32_32x32x16_bf16(b0, qr[d0], p0, 0, 0, 0); p1 = __builtin_amdgcn_mfma_f32_32x32x16_bf16(b1, qr[d0], p1, 0, 0, 0); } }
}
typedef __attribute__((address_space(3))) const char* lds_cptr;
typedef short v4i16_t __attribute__((ext_vector_type(4)));
__device__ __forceinline__ void kload8(bf16x8* kf, lds_cptr kp) {
    kf[0] = *(const LAS bf16x8*)(kp);        kf[1] = *(const LAS bf16x8*)(kp + 512);
    kf[2] = *(const LAS bf16x8*)(kp + 2048); kf[3] = *(const LAS bf16x8*)(kp + 2560);
    kf[4] = *(const LAS bf16x8*)(kp + 4096); kf[5] = *(const LAS bf16x8*)(kp + 4608);
    kf[6] = *(const LAS bf16x8*)(kp + 6144); kf[7] = *(const LAS bf16x8*)(kp + 6656);
}
__device__ __forceinline__ void kload2(bf16x8* kf, lds_cptr kp, int j) { kf[2 * j] = *(const LAS bf16x8*)(kp + j * 2048); kf[2 * j + 1] = *(const LAS bf16x8*)(kp + j * 2048 + 512); }
__device__ __forceinline__ s16x4 vtr(lds_cptr p) { return __builtin_bit_cast(s16x4, __builtin_amdgcn_ds_read_tr16_b64_v4i16((LAS v4i16_t*)p)); }
__device__ __forceinline__ float rowmax(const f32x16& p0, const f32x16& p1) {
    float a = max3f(p0[0], p0[1], p1[0]), b = max3f(p0[2], p0[3], p1[1]); a = max3f(a, p1[2], p1[3]);
#pragma unroll
    for (int r = 4; r < 16; r += 4) { a = max3f(a, p0[r], p0[r + 1]); b = max3f(b, p0[r + 2], p0[r + 3]); a = max3f(a, p1[r], p1[r + 1]); b = max3f(b, p1[r + 2], p1[r + 3]); }
    const float m = max2f(a, b);
    auto rr = __builtin_amdgcn_permlane32_swap(__float_as_uint(m), __float_as_uint(m), false, false);
    return max2f(__uint_as_float(rr[0]), __uint_as_float(rr[1]));
}
__device__ __forceinline__ void pv(f32x16* o, int vb, bf16x8 pa0, bf16x8 pa1, bf16x8 pa2, bf16x8 pa3) {
#pragma unroll
    for (int d0 = 0; d0 < 2; ++d0) { s16x4 lo[4], hi[4];
#pragma unroll
        for (int ks = 0; ks < 4; ++ks) {
            asm volatile("ds_read_b64_tr_b16 %0,%1 offset:%c2" : "=&v"(lo[ks]) : "v"(vb), "i"(d0 * 4096 + ks * 1024) : "memory");
            asm volatile("ds_read_b64_tr_b16 %0,%1 offset:%c2" : "=&v"(hi[ks]) : "v"(vb), "i"(d0 * 4096 + ks * 1024 + 512) : "memory"); }
        asm volatile("s_waitcnt lgkmcnt(0)" ::: "memory"); SBAR();
#define PK(k) (bf16x8){lo[k][0], lo[k][1], lo[k][2], lo[k][3], hi[k][0], hi[k][1], hi[k][2], hi[k][3]}
        o[d0] = __builtin_amdgcn_mfma_f32_32x32x16_bf16(pa0, PK(0), o[d0], 0, 0, 0);
        o[d0] = __builtin_amdgcn_mfma_f32_32x32x16_bf16(pa1, PK(1), o[d0], 0, 0, 0);
        o[d0] = __builtin_amdgcn_mfma_f32_32x32x16_bf16(pa2, PK(2), o[d0], 0, 0, 0);
        o[d0] = __builtin_amdgcn_mfma_f32_32x32x16_bf16(pa3, PK(3), o[d0], 0, 0, 0);
#undef PK
    }
}
template <int THRL> __device__ __forceinline__ void attn_unit(int b, int h, int qb, const bf16* Q  , const float* qgain, const float* rope, const bf16* __restrict__ K, const bf16* __restrict__ V, bf16* O, char* shm) {
    const int tid = threadIdx.x, lane = tid & 63, r32 = lane & 31, hi = lane >> 5; const int wid = __builtin_amdgcn_readfirstlane(tid >> 6);
    const long rowbase = (long)b * TL; const int q0 = qb * QB;
    const bf16* Qw = Q + ((long)RC + rowbase + q0 + wid * QBLK) * 1536 + h * D;
    const bf16* Kh = K + (long)b * KVL * DKV + (h >> 2) * D, *Vh = V + (long)b * KVL * DKV + (h >> 2) * D;
    const unsigned lds0 = (unsigned)(uintptr_t)shm;
    float* wsf = (float*)(shm + LDS_WS) + wid * 64;
    const bf16* ksrc = Kh + (long)lane * DKV + wid * 8;
    const bf16* vsrc = Vh + (long)(16 * (wid & 3) + (lane >> 2)) * DKV + (wid >> 2) * 32 + (lane & 3) * 8;
    const unsigned kdst = lds0 + LDS_K + wid * 1024, vdst = lds0 + LDS_V + wid * 1024;
#define DMA_K(t, slot) glds16(ksrc + (long)(t) * KVBLK * DKV, (unsigned)__builtin_amdgcn_readfirstlane(kdst + (slot)))
#define DMA_V(t, slot) glds16(vsrc + (long)(t) * KVBLK * DKV, (unsigned)__builtin_amdgcn_readfirstlane(vdst + (slot)))
    const int vb0 = (int)(lds0 + LDS_V) + ((lane >> 4) & 1) * 32 + (lane & 3) * 8 + (4 * hi + ((lane & 15) >> 2)) * 64;
    const char* Kbase = shm + LDS_K; bf16x8 kf[8];
    const lds_cptr shm3 = (lds_cptr)shm; const lds_cptr kp0 = shm3 + LDS_K + hi * 1024 + r32 * 16; const lds_cptr vp0 = shm3 + LDS_V + ((lane >> 4) & 1) * 32 + (lane & 3) * 8 + (4 * hi + ((lane & 15) >> 2)) * 64;
    constexpr int NT = KVL / KVBLK;
    DMA_K(0, 0); DMA_V(0, 0); DMA_K(1, SLOTB);
    bf16x8 qr[4];
#pragma unroll
    for (int d0 = 0; d0 < 4; ++d0) qr[d0] = *reinterpret_cast<const bf16x8*>(&Qw[(long)r32 * 1536 + d0 * 16 + hi * 8]);
    {
        float qf[4][8]; float ss = 0.f;
#pragma unroll
        for (int d0 = 0; d0 < 4; ++d0)
#pragma unroll
            for (int k = 0; k < 8; ++k) { qf[d0][k] = __uint_as_float(((unsigned)(unsigned short)qr[d0][k]) << 16); ss += qf[d0][k] * qf[d0][k]; }
        { auto rr = __builtin_amdgcn_permlane32_swap(__float_as_uint(ss), __float_as_uint(ss), false, false); ss = __uint_as_float(rr[0]) + __uint_as_float(rr[1]); }
        const float rstd = __builtin_amdgcn_rsqf(ss * (1.f / 64.f) + 1e-6f);
        const int tq = q0 + wid * QBLK + r32, prow = tq >> 6, pcol = tq & 63;
#pragma unroll
        for (int d0 = 0; d0 < 4; ++d0)
#pragma unroll
            for (int k = 0; k < 8; ++k) qf[d0][k] *= rstd * qgain[16 * d0 + 8 * hi + k];
#pragma unroll
        for (int hf = 0; hf < 2; ++hf) { const float* cs = rope + (hf ? pcol : prow) * 16 + 8 * hi; const float* sn = cs + 2048;
#pragma unroll
            for (int k = 0; k < 8; ++k) { const float c_ = cs[k], s_ = sn[k], x1 = qf[2 * hf][k], x2 = qf[2 * hf + 1][k];
                qf[2 * hf][k] = x1 * c_ - x2 * s_; qf[2 * hf + 1][k] = x2 * c_ + x1 * s_; } }
#pragma unroll
        for (int d0 = 0; d0 < 4; ++d0) { u32x4 pw;
            pw.x = cvtpk_s(qf[d0][0] * C2, qf[d0][1] * C2); pw.y = cvtpk_s(qf[d0][2] * C2, qf[d0][3] * C2); pw.z = cvtpk_s(qf[d0][4] * C2, qf[d0][5] * C2); pw.w = cvtpk_s(qf[d0][6] * C2, qf[d0][7] * C2);
            qr[d0] = __builtin_bit_cast(bf16x8, pw); }
    }
    constexpr float M0 = 12.f;
    float l_reg = 0.f; f32x16 o[2]; o[0] = f32x16{}; o[1] = f32x16{}; f32x16 negm;
    _Pragma("unroll") for (int r = 0; r < 16; ++r) negm[r] = -M0;
    asm volatile("" : "+v"(negm));
#define START(P0, P1) do { _Pragma("unroll") for (int r = 0; r < 16; ++r) P0[r] = __builtin_amdgcn_exp2f(P0[r]); } while (0)
#define RESC() do { } while (0)
    f32x16 pA0, pA1, pB0, pB1;
    int sl_prev = 0, sl_cur = 0, sl_next = SLOTB;
#define ROT() do { sl_prev = sl_cur; sl_cur = sl_next; sl_next = (sl_next == (NSLOT - 1) * SLOTB) ? 0 : sl_next + SLOTB; } while (0)
    DMA_K(2, 2 * SLOTB);
    WAIT_BAR(3);
    qkt(pA0, pA1, Kbase, qr, negm, r32, hi); asm volatile("s_nop 15\n\ts_nop 7" : "+v"(pA0), "+v"(pA1));
    START(pA0, pA1);
    _Pragma("unroll") for (int r = 0; r < 16; ++r) pA1[r] = __builtin_amdgcn_exp2f(pA1[r]);
    WAIT_BAR(0);
    DMA_K(3, 0); DMA_V(1, SLOTB);
    ROT();
    kload8(kf, kp0 + sl_cur);
    WAIT_BAR(2);
    s16x4 vlo[8], vhi[8]; u32x4 pw0, pw1, pw2, pw3;
#define PKW(P, B) cvtpk_s(P[B], P[B + 1])
#define PAF(k) __builtin_bit_cast(bf16x8, pw##k)
#define VFR(i) (bf16x8){vlo[i][0], vlo[i][1], vlo[i][2], vlo[i][3], vhi[i][0], vhi[i][1], vhi[i][2], vhi[i][3]}
#define PIN(x) asm volatile("" : "+v"(x))
#define MX3(a, b, c) __builtin_fmaxf(__builtin_fmaxf((a), (b)), (c))
#define GAPA(MF, A0, A1, A2, A3, W0, W1, PW) do { MF; sacc += A0; sacc += A1; sacc += A2; sacc += A3; PIN(sacc); W0; W1; PIN(PW); SBAR(); } while (0)
#define EX(v) __builtin_amdgcn_exp2f(v)
#define GAPB(MF, X, B) do { MF; X[B] = EX(X[B]); X[B + 1] = EX(X[B + 1]); X[B + 2] = EX(X[B + 2]); X[B + 3] = EX(X[B + 3]); PIN(X); SBAR(); } while (0)
#define VRD(i) do { vlo[i] = vtr(vp_ + (((i) >> 2) * 4096 + ((i) & 3) * 1024)); vhi[i] = vtr(vp_ + (((i) >> 2) * 4096 + ((i) & 3) * 1024 + 512)); } while (0)
#define KRD(G, j) do { if (G) { kload2(kf, kp0 + sl_next, j); SBAR(); } } while (0)
#define STEP(C0, C1, P0, P1, t, GK, GV, GL) do { SBAR(); \
    const lds_cptr vp_ = vp0 + sl_prev; \
    VRD(0); SBAR(); float sacc = (P0[0] + P0[1]); \
    GAPA(C0 = __builtin_amdgcn_mfma_f32_32x32x16_bf16(kf[0], qr[0], negm, 0, 0, 0), P0[2], P0[3], P0[4], P0[5],     pw0[0] = PKW(P0, 0), pw0[1] = PKW(P0, 2), pw0); \
    VRD(4); SBAR(); GAPA(C1 = __builtin_amdgcn_mfma_f32_32x32x16_bf16(kf[1], qr[0], negm, 0, 0, 0), P0[6], P0[7], P0[8], P0[9],     pw0[2] = PKW(P0, 4), pw0[3] = PKW(P0, 6), pw0); \
    VRD(1); SBAR(); GAPA(C0 = __builtin_amdgcn_mfma_f32_32x32x16_bf16(kf[2], qr[1], C0, 0, 0, 0),   P0[10], P0[11], P0[12], P0[13], pw1[0] = PKW(P0, 8), pw1[1] = PKW(P0, 10), pw1); \
    VRD(5); SBAR(); GAPA(C1 = __builtin_amdgcn_mfma_f32_32x32x16_bf16(kf[3], qr[1], C1, 0, 0, 0),   P0[14], P0[15], P1[0], P1[1],   pw1[2] = PKW(P0, 12), pw1[3] = PKW(P0, 14), pw1); \
    VRD(2); SBAR(); GAPA(C0 = __builtin_amdgcn_mfma_f32_32x32x16_bf16(kf[4], qr[2], C0, 0, 0, 0),   P1[2], P1[3], P1[4], P1[5],     pw2[0] = PKW(P1, 0), pw2[1] = PKW(P1, 2), pw2); \
    VRD(6); SBAR(); GAPA(C1 = __builtin_amdgcn_mfma_f32_32x32x16_bf16(kf[5], qr[2], C1, 0, 0, 0),   P1[6], P1[7], P1[8], P1[9],     pw2[2] = PKW(P1, 4), pw2[3] = PKW(P1, 6), pw2); \
    VRD(3); SBAR(); GAPA(C0 = __builtin_amdgcn_mfma_f32_32x32x16_bf16(kf[6], qr[3], C0, 0, 0, 0),   P1[10], P1[11], P1[12], P1[13], pw3[0] = PKW(P1, 8), pw3[1] = PKW(P1, 10), pw3); \
    VRD(7); SBAR(); GAPA(C1 = __builtin_amdgcn_mfma_f32_32x32x16_bf16(kf[7], qr[3], C1, 0, 0, 0),   P1[14], P1[15], 0.f, 0.f,       pw3[2] = PKW(P1, 12), pw3[3] = PKW(P1, 14), pw3); \
    l_reg += sacc; \
    if (GK) { DMA_K((t) + 3, sl_cur); } if (GV) { DMA_V((t) + 1, sl_next); } \
    SBAR(); \
    GAPB(o[0] = __builtin_amdgcn_mfma_f32_32x32x16_bf16(PAF(0), VFR(0), o[0], 0, 0, 0), C0, 0); \
    GAPB(o[1] = __builtin_amdgcn_mfma_f32_32x32x16_bf16(PAF(0), VFR(4), o[1], 0, 0, 0), C0, 4); \
    KRD(GL, 0); GAPB(o[0] = __builtin_amdgcn_mfma_f32_32x32x16_bf16(PAF(1), VFR(1), o[0], 0, 0, 0), C0, 8); \
    KRD(GL, 1); GAPB(o[1] = __builtin_amdgcn_mfma_f32_32x32x16_bf16(PAF(1), VFR(5), o[1], 0, 0, 0), C0, 12); \
    KRD(GL, 2); GAPB(o[0] = __builtin_amdgcn_mfma_f32_32x32x16_bf16(PAF(2), VFR(2), o[0], 0, 0, 0), C1, 0); \
    KRD(GL, 3); GAPB(o[1] = __builtin_amdgcn_mfma_f32_32x32x16_bf16(PAF(2), VFR(6), o[1], 0, 0, 0), C1, 4); \
    GAPB(o[0] = __builtin_amdgcn_mfma_f32_32x32x16_bf16(PAF(3), VFR(3), o[0], 0, 0, 0), C1, 8); \
    GAPB(o[1] = __builtin_amdgcn_mfma_f32_32x32x16_bf16(PAF(3), VFR(7), o[1], 0, 0, 0), C1, 12); \
    } while (0)
    int t = 1;
    for (; t + 5 < NT; t += 2) {
        STEP(pB0, pB1, pA0, pA1, t, true, true, true);     WAIT_BAR(2); RESC(); ROT();
        STEP(pA0, pA1, pB0, pB1, t + 1, true, true, true); WAIT_BAR(2); RESC(); ROT();
    }
#define ENDW(tt) do { if ((tt) + 3 < NT) { WAIT_BAR(2); } else if ((tt) + 2 < NT) { WAIT_BAR(1); } else { WAIT_BAR(0); } } while (0)
    for (; t + 1 < NT; t += 2) {
        STEP(pB0, pB1, pA0, pA1, t, (t + 3 < NT), (t + 1 < NT), (t + 1 < NT));         ENDW(t);     RESC(); ROT();
        STEP(pA0, pA1, pB0, pB1, t + 1, (t + 4 < NT), (t + 2 < NT), (t + 2 < NT));     ENDW(t + 1); RESC(); ROT();
    }
    STEP(pB0, pB1, pA0, pA1, NT - 1, false, false, false); RESC();
    { float sacc = pB0[0] + pB0[1]; _Pragma("unroll") for (int r = 2; r < 16; ++r) sacc += pB0[r]; _Pragma("unroll") for (int r = 0; r < 16; ++r) sacc += pB1[r]; l_reg += sacc;
      pw0 = (u32x4){PKW(pB0, 0), PKW(pB0, 2), PKW(pB0, 4), PKW(pB0, 6)}; pw1 = (u32x4){PKW(pB0, 8), PKW(pB0, 10), PKW(pB0, 12), PKW(pB0, 14)}; pw2 = (u32x4){PKW(pB1, 0), PKW(pB1, 2), PKW(pB1, 4), PKW(pB1, 6)}; pw3 = (u32x4){PKW(pB1, 8), PKW(pB1, 10), PKW(pB1, 12), PKW(pB1, 14)};
      SBAR(); pv(o, vb0 + sl_cur, PAF(0), PAF(1), PAF(2), PAF(3)); }
#undef PKW
#undef PAF
#undef VFR
#undef PIN
#undef MX3
#undef GAPA
#undef GAPB
#undef EX
#undef VRD
#undef KRD
#undef STEP
#undef ENDW
    { auto rr = __builtin_amdgcn_permlane32_swap(__float_as_uint(l_reg), __float_as_uint(l_reg), false, false); l_reg = __uint_as_float(rr[0]) + __uint_as_float(rr[1]); }
    if (hi == 0) wsf[32 + r32] = l_reg; asm volatile("s_waitcnt lgkmcnt(0)" ::: "memory");
    float rli[16];
#pragma unroll
    for (int r = 0; r < 16; ++r) rli[r] = __builtin_amdgcn_rcpf(wsf[32 + crow(r, hi)]);
    bf16* Ow = O + (rowbase + q0 + wid * QBLK) * DMQ + h * D;
    { bf16* stg = (bf16*)(shm + LDS_OST) + wid * 2048;
#pragma unroll
      for (int r = 0; r < 16; ++r) { const int orow = crow(r, hi);
#pragma unroll
          for (int d0 = 0; d0 < 2; ++d0) stg[orow * 64 + d0 * 32 + r32] = __float2bfloat16(o[d0][r] * rli[r]); }
      asm volatile("s_waitcnt lgkmcnt(0)" ::: "memory");
#pragma unroll
      for (int i = 0; i < 4; ++i) { const int row = i * 8 + (lane >> 3), ch = lane & 7; const u32x4 v = *(const u32x4*)(stg + row * 64 + ch * 8); *(u32x4*)(Ow + (long)row * DMQ + ch * 8) = v; } }
    asm volatile("s_waitcnt lgkmcnt(0)\n\ts_barrier" ::: "memory");
#undef DMA_K
#undef DMA_V
#undef START
#undef RESC
#undef ROT
}
#undef SBAR
#undef WAIT_BAR
}

struct Args { const float* in[44]; float* out; unsigned char* ws; int ph_lo, ph_hi, li, pad; };
enum { I_X = 0, I_C, I_CTX, I_CCTX, I_MODW, I_MODB, I_N1G, I_N2G, I_FG, I_MBIN, I_MBCW, I_MBCB, I_MBDTB, I_MBALOG, I_MBD, I_MBNG, I_MBOUT,
       I_RWMIX, I_RWRKV, I_RWW0, I_RWW1, I_RWW2, I_RWA0, I_RWA1, I_RWA2, I_RWG1, I_RWG2, I_RWKK, I_RWKA, I_RWRK, I_RWLNG, I_RWLNB, I_RWOUT,
       I_PLW, I_PLS, I_ATQKV, I_ATQG, I_ATKG, I_ATOUT, I_FFIN, I_FFOUT, I_MOER, I_MOEIN, I_MOEOUT };

struct Frame {
    LAS unsigned char* lds; unsigned char* ws; const float* const* in; float* out;
    int tid, lane, wave, G, vcu;
};
#define WSP(T, off) ((T*)(F.ws + (off)))
#define SCR(T, off) ((T*)(F.ws + WS_SCR + (off)))

constexpr int NL_GS = 0, NL_SH = 3 * DM * 4, NL_X = 6 * DM * 4;
__device__ __forceinline__ void stage_norm_params(const Frame& F, const float* g, const float* MOD, int which) {
    LAS float* GS = (LAS float*)(F.lds + NL_GS); LAS float* SH = (LAS float*)(F.lds + NL_SH);
    for (int i = F.tid; i < 3 * DM; i += NWAVES * 64) { const int s = i >> 10, c = i & 1023; const float* shift = MOD + (size_t)s * 6144 + (which ? 3 : 0) * DM;
        GS[i] = g[c] * (shift[DM + c] + 1.0f); SH[i] = shift[c]; }
}
struct XRow { f32x4 f[4]; u32x2 r[4]; };
__device__ __forceinline__ void xrow_load(const Frame& F, int src_inputs, int row, int lane, XRow& x) {
    if (src_inputs) { const float* xr = row < RC ? F.in[I_CTX] + (size_t)row * DM : F.in[I_X] + (size_t)(row - RC) * DM;
#pragma unroll
        for (int j = 0; j < 4; ++j) x.f[j] = *(const f32x4*)(xr + 4 * lane + 256 * j);
    } else { const bf16_t* xr = WSP(bf16_t, WS_XW) + (size_t)row * DM;
#pragma unroll
        for (int j = 0; j < 4; ++j) x.r[j] = *(const u32x2*)(xr + 4 * lane + 256 * j); }
}
__device__ __forceinline__ void xrow_get(int src_inputs, const XRow& x, f32x4 (&v)[4]) {
#pragma unroll
    for (int j = 0; j < 4; ++j) v[j] = src_inputs ? x.f[j] : (f32x4){bflo(x.r[j].x), bfhi(x.r[j].x), bflo(x.r[j].y), bfhi(x.r[j].y)};
}
__device__ __forceinline__ void norm_regs(f32x4 (&v)[4], LAS const float* GSs, LAS const float* SHs, int lane) {
    float s = 0.f;
#pragma unroll
    for (int j = 0; j < 4; ++j) s += (v[j][0] * v[j][0] + v[j][1] * v[j][1]) + (v[j][2] * v[j][2] + v[j][3] * v[j][3]);
    const float rstd = __builtin_amdgcn_rsqf(wave_sum(s) * (1.f / DM) + NORM_EPS);
#pragma unroll
    for (int j = 0; j < 4; ++j) { const int c = 4 * lane + 256 * j; v[j] = v[j] * rstd * *(LAS const f32x4*)(GSs + c) + *(LAS const f32x4*)(SHs + c); }
}
__device__ __forceinline__ void store_row_bf16(bf16_t* o, int lane, const f32x4 (&v)[4]) {
#pragma unroll
    for (int j = 0; j < 4; ++j) { u32x2 w; w.x = pk2(v[j][0], v[j][1]); w.y = pk2(v[j][2], v[j][3]); *(u32x2*)(o + 4 * lane + 256 * j) = w; }
}
__device__ __forceinline__ void route_row(const Frame& F, LAS const float* rw, int row, const f32x4 (&v)[4]) {
    float lg[8];
#pragma unroll
    for (int e = 0; e < 8; ++e) lg[e] = 0.f;
#pragma unroll
    for (int j = 0; j < 4; ++j)
#pragma unroll
        for (int i = 0; i < 4; ++i) { const f32x4 w0 = *(LAS const f32x4*)(rw + (((4 * j + i) * 2 + 0) * 64 + F.lane) * 4), w1 = *(LAS const f32x4*)(rw + (((4 * j + i) * 2 + 1) * 64 + F.lane) * 4);
#pragma unroll
            for (int e = 0; e < 4; ++e) { lg[e] += v[j][i] * w0[e]; lg[4 + e] += v[j][i] * w1[e]; } }
#pragma unroll
    for (int e = 0; e < 8; ++e) lg[e] = wave_sum(lg[e]);
    if (F.lane == 0) {
        int e0 = 0; float m0 = lg[0];
#pragma unroll
        for (int e = 1; e < 8; ++e) if (lg[e] > m0) { m0 = lg[e]; e0 = e; }
        int e1 = -1; float m1 = -INFINITY;
#pragma unroll
        for (int e = 0; e < 8; ++e) if (e != e0 && lg[e] > m1) { m1 = lg[e]; e1 = e; }
        if (e1 < 0) { e1 = (e0 == 0) ? 1 : 0; m1 = m0; }
        const float p1 = __expf(m1 - m0), inv = 1.f / (1.f + p1);
        WSP(int, WS_SEL)[row] = e0 | (e1 << 8);
        WSP(float, WS_WTS)[2 * row] = inv; WSP(float, WS_WTS)[2 * row + 1] = p1 * inv;
    }
}
struct CtxFix { const float* gate; const float* ssq; int xin_inputs; int S; };
template <int MODE>
__device__ __forceinline__ void p_norm(const Frame& F, int layer, int which, int src_inputs, int row_lo, const CtxFix fx = CtxFix{nullptr, nullptr, 0, 0}) {
    const float* g = F.in[which ? I_N2G : I_N1G] + layer * DM;
    const float* MOD = WSP(float, WS_MOD) + (size_t)layer * 3 * 6144;
    bf16_t* H = WSP(bf16_t, WS_H);
    LAS const float* GS = (LAS const float*)(F.lds + NL_GS); LAS const float* SH = (LAS const float*)(F.lds + NL_SH); LAS float* RW8 = (LAS float*)(F.lds + NL_X);
    stage_norm_params(F, g, MOD, which);
    if (MODE == 2) { const float* rw = F.in[I_MOER] + (size_t)(layer >> 1) * DM * 8;
        for (int i = F.tid; i < DM * 8; i += NWAVES * 64) { const int c = i >> 3, e8 = i & 7, j = c >> 8, l = (c & 255) >> 2, q = c & 3; RW8[(((4 * j + q) * 2 + (e8 >> 2)) * 64 + l) * 4 + (e8 & 3)] = rw[i]; } }
    __syncthreads();
    const int gw = F.vcu * NWAVES + F.wave, NGW = F.G * NWAVES;
    auto process = [&](const XRow& xr, int row) {
        const int s = row_sample(row);
        f32x4 v[4]; xrow_get(src_inputs, xr, v);
        if (fx.S > 0 && row < RC) {
            const bf16_t* PART = SCR(bf16_t, S_PARTC); bf16_t* XW = WSP(bf16_t, WS_XW);
            float rs = 1.f;
            if (fx.ssq) { f32x4 q = (f32x4){0.f, 0.f, 0.f, 0.f};
#pragma unroll
                for (int k = 0; k < 8; ++k) q += *(const f32x4*)(fx.ssq + (size_t)row * 32 + 4 * k);
                rs = __builtin_amdgcn_rsqf(((q[0] + q[1]) + (q[2] + q[3])) * (1.f / 2048.f) + NORM_EPS); }
#pragma unroll
            for (int j = 0; j < 4; ++j) { const int c = 4 * F.lane + 256 * j; f32x4 a = (f32x4){0.f, 0.f, 0.f, 0.f};
                for (int ks = 0; ks < fx.S; ++ks) a += ld_x4(PART + ((size_t)ks * RC + row) * DM + c);
                const f32x4 xi = fx.xin_inputs ? *(const f32x4*)(F.in[I_CTX] + (size_t)row * DM + c) : v[j];
                v[j] = xi + *(const f32x4*)(fx.gate + c) * a * rs; st_x4(XW + (size_t)row * DM + c, v[j]); }
        }
        norm_regs(v, GS + s * DM, SH + s * DM, F.lane);
        store_row_bf16(H + (size_t)row * DM, F.lane, v);
        if (MODE == 2) route_row(F, RW8, row, v);
    };
    XRow b0, b1, b2, b3;
    int row = row_lo + gw;
    if (row < RT) xrow_load(F, src_inputs, row, F.lane, b0);
    if (row + NGW < RT) xrow_load(F, src_inputs, row + NGW, F.lane, b1);
    if (row + 2 * NGW < RT) xrow_load(F, src_inputs, row + 2 * NGW, F.lane, b2);
    for (; row < RT; row += 4 * NGW) {
        if (row + 3 * NGW < RT) xrow_load(F, src_inputs, row + 3 * NGW, F.lane, b3);
        process(b0, row);
        if (row + NGW >= RT) break;
        if (row + 4 * NGW < RT) xrow_load(F, src_inputs, row + 4 * NGW, F.lane, b0);
        process(b1, row + NGW);
        if (row + 2 * NGW >= RT) break;
        if (row + 5 * NGW < RT) xrow_load(F, src_inputs, row + 5 * NGW, F.lane, b1);
        process(b2, row + 2 * NGW);
        if (row + 3 * NGW >= RT) break;
        if (row + 6 * NGW < RT) xrow_load(F, src_inputs, row + 6 * NGW, F.lane, b2);
        process(b3, row + 3 * NGW);
    }
}
__device__ __forceinline__ void p_norm_rw(const Frame& F, int layer) {
    const float* g = F.in[I_N1G] + layer * DM;
    const float* MOD = WSP(float, WS_MOD) + (size_t)layer * 3 * 6144;
    bf16_t* X6 = SCR(bf16_t, S_X6);
    LAS const float* GS = (LAS const float*)(F.lds + NL_GS); LAS const float* SH = (LAS const float*)(F.lds + NL_SH); LAS float* MIX = (LAS float*)(F.lds + NL_X);
    stage_norm_params(F, g, MOD, 0);
    for (int i = F.tid; i < 6 * DM; i += NWAVES * 64) MIX[i] = F.in[I_RWMIX][i];
    __syncthreads();
    const int gw = F.vcu * NWAVES + F.wave, NGW = F.G * NWAVES;
    const int n4 = ((RT / 4) / NGW) * NGW, nitems = n4 + (RT - 4 * n4);
    for (int idx = gw; idx < nitems; idx += NGW) {
        const int r0 = idx < n4 ? 4 * idx : 4 * n4 + (idx - n4), nr = idx < n4 ? 4 : 1;
        const int s_ = row_sample(r0);
        const int start = r0 < RC ? (r0 & ~(TC - 1)) : RC + ((r0 - RC) & ~(TL - 1)), len = r0 < RC ? TC : TL, t0 = r0 - start;
        XRow xr[6]; unsigned okm = 0u;
#pragma unroll
        for (int q = 0; q < 6; ++q) { const int t = t0 - 1 + q; const bool ok = (q <= nr + 1) && t >= 0 && t < len; if (ok) { okm |= 1u << q; xrow_load(F, 0, r0 - 1 + q, F.lane, xr[q]); } }
        f32x4 hp[4], hc[4], hn[4];
#define NRW_ROW(dst, q) do { if ((okm >> (q)) & 1u) { xrow_get(0, xr[q], dst); norm_regs(dst, GS + s_ * DM, SH + s_ * DM, F.lane); } \
            else { _Pragma("unroll") for (int j = 0; j < 4; ++j) dst[j] = (f32x4){0.f, 0.f, 0.f, 0.f}; } } while (0)
        NRW_ROW(hp, 0); NRW_ROW(hc, 1);
#pragma unroll
        for (int i = 0; i < 4; ++i) {
            if (i < nr) {
                NRW_ROW(hn, i + 2);
                f32x4 xx[4];
#pragma unroll
                for (int j = 0; j < 4; ++j) xx[j] = (hp[j] + hn[j]) * 0.5f - hc[j];
#pragma unroll
                for (int m = 0; m < 6; ++m) { f32x4 o[4];
#pragma unroll
                    for (int j = 0; j < 4; ++j) o[j] = hc[j] + xx[j] * *(LAS const f32x4*)(MIX + m * DM + 4 * F.lane + 256 * j);
                    store_row_bf16(X6 + (size_t)m * RT * DM + (size_t)(r0 + i) * DM, F.lane, o); }
#pragma unroll
                for (int j = 0; j < 4; ++j) { hp[j] = hc[j]; hc[j] = hn[j]; }
            }
        }
#undef NRW_ROW
    }
}

__device__ __forceinline__ void p_mb_conv(const Frame& F) {
    const bf16_t* P = SCR(bf16_t, S_XBCP); bf16_t* O = SCR(bf16_t, S_XBC);
    const float* cw = F.in[I_MBCW]; const float* cb = F.in[I_MBCB];
    constexpr int NCH = MB_XBC / 8, NSTRIP = RT / 16;
    for (int i = blockIdx.x * (NWAVES * 64) + F.tid; i < NSTRIP * NCH; i += F.G * NWAVES * 64) {
        const int strip = i / NCH, c = (i % NCH) * 8, row0 = strip * 16;
        const int start = row0 < RC ? (row0 & ~(TC - 1)) : RC + ((row0 - RC) & ~(TL - 1)), len = row0 < RC ? TC : TL, t0 = row0 - start;
        float w[5][8], bias[8];
#pragma unroll
        for (int j = 0; j < 5; ++j) { const f32x4 w0 = *(const f32x4*)(cw + j * MB_XBC + c), w1 = *(const f32x4*)(cw + j * MB_XBC + c + 4);
#pragma unroll
            for (int k = 0; k < 4; ++k) { w[j][k] = w0[k]; w[j][4 + k] = w1[k]; } }
        { const f32x4 b0 = *(const f32x4*)(cb + c), b1 = *(const f32x4*)(cb + c + 4);
#pragma unroll
          for (int k = 0; k < 4; ++k) { bias[k] = b0[k]; bias[4 + k] = b1[k]; } }
        u32x4 raw[20];
#pragma unroll
        for (int r = 0; r < 20; ++r) { const int tt = t0 + r - 2; raw[r] = (tt >= 0 && tt < len) ? *(const u32x4*)(P + (size_t)(start + tt) * MB_XBC + c) : (u32x4){0u, 0u, 0u, 0u}; }
#pragma unroll
        for (int r = 0; r < 16; ++r) {
            float acc[8];
#pragma unroll
            for (int k = 0; k < 8; ++k) acc[k] = bias[k];
#pragma unroll
            for (int j = 0; j < 5; ++j) { float x[8]; unpack8(raw[r + j], x);
#pragma unroll
                for (int k = 0; k < 8; ++k) acc[k] += w[j][k] * x[k]; }
#pragma unroll
            for (int k = 0; k < 8; ++k) acc[k] = siluf_(acc[k]);
            *(u32x4*)(O + (size_t)(row0 + r) * MB_XBC + c) = pack8(acc);
        }
    }
}
__device__ __forceinline__ int sc_row0(int sc) { return sc < 4 ? (sc >> 1) * TC + (sc & 1) * MB_CH : RC + ((sc - 4) >> 6) * TL + ((sc - 4) & 63) * MB_CH; }
__device__ __forceinline__ bf16x8 tr_frag(LAS const unsigned char* base, int ldb, int k0, int n0, int lane) {
    const int g = lane >> 4, q = (lane & 15) >> 2, p = lane & 3;
    LAS const unsigned char* a = base + (k0 + 8 * g + q) * ldb + (n0 + 4 * p) * 2;
    typedef short v4i16_t __attribute__((ext_vector_type(4)));
    const v4i16_t lo = __builtin_amdgcn_ds_read_tr16_b64_v4i16((LAS v4i16_t*)a);
    const v4i16_t hi = __builtin_amdgcn_ds_read_tr16_b64_v4i16((LAS v4i16_t*)(a + 4 * ldb));
    return (bf16x8){lo[0], lo[1], lo[2], lo[3], hi[0], hi[1], hi[2], hi[3]};
}
struct MbScanIn { float dv[4], al[2]; };
__device__ __forceinline__ void mb_scans_load(const Frame& F, int row0, int g, MbScanIn& m) {
    const float* DT = SCR(float, S_DT);
#pragma unroll
    for (int k = 0; k < 4; ++k) { const int i = F.tid + k * (NWAVES * 64), q = i >> 4, p = i & 15; m.dv[k] = DT[(size_t)(row0 + q) * 64 + (p >> 3) * 32 + g * 8 + (p & 7)]; }
#pragma unroll
    for (int pp = 0; pp < 2; ++pp) { const int p = F.wave * 2 + pp, d = p >> 3, hd = g * 8 + (p & 7); m.al[pp] = F.in[I_MBALOG][d * 32 + hd]; }
}
__device__ __forceinline__ void mb_scans(const Frame& F, const MbScanIn& m, LAS float* dts, LAS float* cum, LAS float* tot) {
#pragma unroll
    for (int k = 0; k < 4; ++k) { const int i = F.tid + k * (NWAVES * 64), q = i >> 4, p = i & 15; dts[p * 128 + q] = m.dv[k]; }
    __syncthreads();
#pragma unroll
    for (int pp = 0; pp < 2; ++pp) {
        const int p = F.wave * 2 + pp, d = p >> 3;
        const float a = -__expf(m.al[pp]);
        const float v0 = dts[p * 128 + 2 * F.lane] * a, v1 = dts[p * 128 + 2 * F.lane + 1] * a;
        float inc = v0 + v1;
#pragma unroll
        for (int o = 1; o < 64; o <<= 1) { const float t = __shfl_up(inc, o); if (F.lane >= o) inc += t; }
        const float total = __shfl(inc, 63), exc = inc - (v0 + v1);
        if (d == 0) { cum[p * 128 + 2 * F.lane] = exc + v0; cum[p * 128 + 2 * F.lane + 1] = inc; }
        else { cum[p * 128 + 2 * F.lane] = total - exc; cum[p * 128 + 2 * F.lane + 1] = total - exc - v0; }
        if (F.lane == 0) tot[p] = total;
    }
    __syncthreads();
}
__device__ __forceinline__ void p_mb_states(const Frame& F) {
    const bf16_t* XBC = SCR(bf16_t, S_XBC); bf16_t* ST = SCR(bf16_t, S_ST); float* DTOT = SCR(float, S_DTOT);
    LAS unsigned char* bmS = F.lds;
    LAS unsigned char* xwS = F.lds + 34816;
    LAS float* dts = (LAS float*)(F.lds + 34816 + 4 * 18432);
    LAS float* cum = dts + 2048; LAS float* tot = cum + 2048;
    const int lane = F.lane, fr = lane & 15, fq = lane >> 4, tid = F.tid;
    for (int u = blockIdx.x; u < 512 + 128; u += F.G) {
        int sc, g, e_lo, e_hi;
        if (u < 512) { sc = 4 + (u >> 2); g = u & 3; e_lo = 0; e_hi = 8; }
        else { const int v = u - 512; sc = v >> 5; g = (v >> 3) & 3; e_lo = v & 7; e_hi = e_lo + 1; }
        const int row0 = sc_row0(sc);
        u32x4 pX[2];
#define MBS_PREFETCH(e_) do { _Pragma("unroll") for (int i = 0; i < 2; ++i) { const int idx = tid + i * 512; pX[i] = *(const u32x4*)(XBC + (size_t)(row0 + (idx >> 3)) * MB_XBC + (g * 8 + (e_)) * 64 + (idx & 7) * 8); } } while (0)
        MbScanIn msi; mb_scans_load(F, row0, g, msi);
        u32x4 bmr[4];
#pragma unroll
        for (int k = 0; k < 4; ++k) { const int i = tid + k * (NWAVES * 64), q = i >> 4, ch = i & 15; bmr[k] = *(const u32x4*)(XBC + (size_t)(row0 + q) * MB_XBC + MB_DI + g * 128 + ch * 8); }
        MBS_PREFETCH(e_lo);
#pragma unroll
        for (int k = 0; k < 4; ++k) { const int i = tid + k * (NWAVES * 64), q = i >> 4, ch = i & 15; *(LAS u32x4*)(bmS + q * 272 + ch * 16) = bmr[k]; }
        mb_scans(F, msi, dts, cum, tot);
        if (tid < 16 && (tid & 7) >= e_lo && (tid & 7) < e_hi) DTOT[(size_t)sc * 64 + (tid >> 3) * 32 + g * 8 + (tid & 7)] = tot[tid];
        for (int i = tid; i < 2048; i += NWAVES * 64) { const int p = i >> 7; dts[i] = __expf(tot[p] - cum[i]) * dts[i]; }
        __syncthreads();
        bf16x8 af[4];
#pragma unroll
        for (int kk = 0; kk < 4; ++kk) af[kk] = tr_frag(bmS, 272, 32 * kk, 16 * F.wave, lane);
        for (int e = e_lo; e < e_hi; ++e) {
            const int hd = g * 8 + e;
            LAS unsigned char* xw = xwS + (e & 1) * 2 * 18432;
#pragma unroll
            for (int i = 0; i < 2; ++i) { const int idx = tid + i * 512, q = idx >> 3, ch = idx & 7; float x[8], y[8];
                unpack8(pX[i], x); const float wf_ = dts[e * 128 + q], wb_ = dts[(8 + e) * 128 + q];
#pragma unroll
                for (int k = 0; k < 8; ++k) { y[k] = x[k] * wb_; x[k] *= wf_; }
                *(LAS u32x4*)(xw + q * 144 + ch * 16) = pack8(x); *(LAS u32x4*)(xw + 18432 + q * 144 + ch * 16) = pack8(y); }
            __syncthreads();
            if (e + 1 < e_hi) MBS_PREFETCH(e + 1);
#pragma unroll
            for (int d = 0; d < 2; ++d) {
                bf16_t* so = ST + (((size_t)sc * 2 + d) * 32 + hd) * 8192;
#pragma unroll
                for (int pt = 0; pt < 4; ++pt) {
                    f32x4 acc = (f32x4){0.f, 0.f, 0.f, 0.f};
#pragma unroll
                    for (int kk = 0; kk < 4; ++kk) acc = __builtin_amdgcn_mfma_f32_16x16x32_bf16(af[kk], tr_frag(xw + d * 18432, 144, 32 * kk, 16 * pt, lane), acc, 0, 0, 0);
                    u32x2 w_; w_.x = pk2(acc[0], acc[1]); w_.y = pk2(acc[2], acc[3]);
                    *(u32x2*)(so + (size_t)(16 * pt + fr) * 128 + 16 * F.wave + 4 * fq) = w_;
                }
            }
        }
#undef MBS_PREFETCH
        __syncthreads();
    }
}
__device__ __forceinline__ void p_mb_carry(const Frame& F) {
    bf16_t* ST = SCR(bf16_t, S_ST); const float* DTOT = SCR(float, S_DTOT);
    for (int i = blockIdx.x * (NWAVES * 64) + F.tid; i < 2 * 2 * 32 * 1024; i += F.G * NWAVES * 64) {
        const int e8 = i & 1023, hd = (i >> 10) & 31, d = (i >> 15) & 1, b = i >> 16;
        float S[8];
#pragma unroll
        for (int k = 0; k < 8; ++k) S[k] = 0.f;
        for (int s0 = 0; s0 < 66; s0 += 6) {
            bf16_t* p[6]; u32x4 raw[6]; float dec[6];
#pragma unroll
            for (int k = 0; k < 6; ++k) { const int step = s0 + k; int sc;
                if (d == 0) sc = step < 2 ? 2 * b + step : 4 + b * 64 + (step - 2);
                else sc = step < 2 ? 2 * b + 1 - step : 4 + b * 64 + 63 - (step - 2);
                p[k] = ST + (((size_t)sc * 2 + d) * 32 + hd) * 8192 + e8 * 8; raw[k] = *(const u32x4*)p[k]; dec[k] = DTOT[(size_t)sc * 64 + d * 32 + hd]; }
#pragma unroll
            for (int k = 0; k < 6; ++k) { float st[8]; unpack8(raw[k], st); const float dd = __expf(dec[k]);
                *(u32x4*)p[k] = pack8(S);
#pragma unroll
                for (int q = 0; q < 8; ++q) S[q] = S[q] * dd + st[q]; }
        }
    }
}
__device__ __forceinline__ void p_mb_out(const Frame& F) {
    const bf16_t* XBC = SCR(bf16_t, S_XBC); const bf16_t* ST = SCR(bf16_t, S_ST); const bf16_t* Z = SCR(bf16_t, S_Z);
    bf16_t* YG = SCR(bf16_t, S_YG); float* SSQ = SCR(float, S_SSQ); float* SSQC = SCR(float, S_SSQC);
    LAS unsigned char* cmS = F.lds;
    LAS unsigned char* zS = F.lds; LAS unsigned char* ygS = F.lds + 17408;
    LAS unsigned char* bmS = F.lds + 34816;
    LAS unsigned char* sFS = bmS; LAS unsigned char* sBS = bmS + 17408;
    LAS unsigned char* WS_ = F.lds + 2 * 34816 + F.wave * 4352;
    LAS unsigned char* xS = F.lds + 3 * 34816;
    LAS float* dts = (LAS float*)(F.lds + 3 * 34816 + 18432);
    LAS float* cum = dts + 2048; LAS float* tot = cum + 2048;
    const int lane = F.lane, fr = lane & 15, fq = lane >> 4, w = F.wave, tid = F.tid;
    for (int u = blockIdx.x; u < 512 + 128; u += F.G) {
        int sc, g, e_lo, e_hi;
        if (u < 512) { sc = 4 + (u >> 2); g = u & 3; e_lo = 0; e_hi = 8; }
        else { const int v = u - 512; sc = v >> 5; g = (v >> 3) & 3; e_lo = v & 7; e_hi = e_lo + 1; }
        const int row0 = sc_row0(sc);
        __syncthreads();
        MbScanIn msi; mb_scans_load(F, row0, g, msi);
        const float Dall = F.in[I_MBD][g * 8 + (lane & 7)];
        u32x4 bmr[4], cmr[4];
#pragma unroll
        for (int k = 0; k < 4; ++k) { const int i = tid + k * (NWAVES * 64), q = i >> 4, ch = i & 15; const bf16_t* src = XBC + (size_t)(row0 + q) * MB_XBC + MB_DI + g * 128 + ch * 8;
            bmr[k] = *(const u32x4*)src; cmr[k] = *(const u32x4*)(src + 512); }
        u32x4 pS[4], pX[2], pZ[2];
#define MBO_PREFETCH(e_) do { const int hd_ = g * 8 + (e_); \
            _Pragma("unroll") for (int i = 0; i < 4; ++i) { const int idx = tid + (i & 1) * 512; pS[i] = *(const u32x4*)(ST + (((size_t)sc * 2 + (i >> 1)) * 32 + hd_) * 8192 + (size_t)idx * 8); } \
            _Pragma("unroll") for (int i = 0; i < 2; ++i) { const int idx = tid + i * 512, q = idx >> 3, ch = idx & 7; \
                pX[i] = *(const u32x4*)(XBC + (size_t)(row0 + q) * MB_XBC + hd_ * 64 + ch * 8); pZ[i] = *(const u32x4*)(Z + (size_t)(row0 + q) * MB_DI + hd_ * 64 + ch * 8); } } while (0)
        MBO_PREFETCH(e_lo);
#pragma unroll
        for (int k = 0; k < 4; ++k) { const int i = tid + k * (NWAVES * 64), q = i >> 4, ch = i & 15; *(LAS u32x4*)(bmS + q * 272 + ch * 16) = bmr[k]; *(LAS u32x4*)(cmS + q * 272 + ch * 16) = cmr[k]; }
        mb_scans(F, msi, dts, cum, tot);
        bf16x8 cf[4];
#pragma unroll
        for (int kk = 0; kk < 4; ++kk) cf[kk] = *(LAS const bf16x8*)(cmS + (16 * w + fr) * 272 + (32 * kk + 8 * fq) * 2);
        f32x4 cb[8];
#pragma unroll
        for (int jt = 0; jt < 8; ++jt) { cb[jt] = (f32x4){0.f, 0.f, 0.f, 0.f};
#pragma unroll
            for (int kk = 0; kk < 4; ++kk) cb[jt] = __builtin_amdgcn_mfma_f32_16x16x32_bf16(*(LAS const bf16x8*)(bmS + (16 * jt + fr) * 272 + (32 * kk + 8 * fq) * 2), cf[kk], cb[jt], 0, 0, 0); }
        float ssq = 0.f;
        const int irow = 16 * w + fr;
        __syncthreads();
        for (int e = e_lo; e < e_hi; ++e) {
            const int hd = g * 8 + e;
#pragma unroll
            for (int i = 0; i < 4; ++i) { const int idx = tid + (i & 1) * 512; *(LAS u32x4*)((i >> 1 ? sBS : sFS) + (idx >> 4) * 272 + (idx & 15) * 16) = pS[i]; }
#pragma unroll
            for (int i = 0; i < 2; ++i) { const int idx = tid + i * 512, q = idx >> 3, ch = idx & 7; *(LAS u32x4*)(xS + q * 144 + ch * 16) = pX[i]; *(LAS u32x4*)(zS + q * 136 + ch * 16) = pZ[i]; }
            __syncthreads();
            if (e + 1 < e_hi) MBO_PREFETCH(e + 1);
            const float Dsk = __int_as_float(__builtin_amdgcn_readlane(__float_as_int(Dall), e));
            const LAS float* cf_ = cum + e * 128; const LAS float* cr_ = cum + (8 + e) * 128; const LAS float* df_ = dts + e * 128; const LAS float* db_ = dts + (8 + e) * 128;
            const float ci_f = cf_[irow], ci_r = cr_[irow];
#pragma unroll
            for (int jt = 0; jt < 8; ++jt) { const int j4 = 16 * jt + 4 * fq;
                f32x4 val;
                if (jt != w) { const bool fwd = jt < w;
                    const f32x4 cj = *(const LAS f32x4*)((fwd ? cf_ : cr_) + j4), dj = *(const LAS f32x4*)((fwd ? df_ : db_) + j4); const float ci = fwd ? ci_f : ci_r;
#pragma unroll
                    for (int r = 0; r < 4; ++r) val[r] = cb[jt][r] * __expf(ci - cj[r]) * dj[r];
                } else { const f32x4 cjf = *(const LAS f32x4*)(cf_ + j4), cjr = *(const LAS f32x4*)(cr_ + j4), djf = *(const LAS f32x4*)(df_ + j4), djb = *(const LAS f32x4*)(db_ + j4);
#pragma unroll
                    for (int r = 0; r < 4; ++r) { const int j = j4 + r; const bool lo = j < irow;
                        val[r] = cb[jt][r] * __expf(lo ? ci_f - cjf[r] : ci_r - cjr[r]) * (lo ? djf[r] : djb[r]);
                        if (j == irow) val[r] = cb[jt][r] * (djf[r] + djb[r]) + Dsk; } }
                u32x2 w_; w_.x = pk2(val[0], val[1]); w_.y = pk2(val[2], val[3]);
                *(LAS u32x2*)(WS_ + fr * 272 + j4 * 2) = w_; }
            bf16x8 wf[4];
#pragma unroll
            for (int kk = 0; kk < 4; ++kk) wf[kk] = *(LAS const bf16x8*)(WS_ + fr * 272 + (32 * kk + 8 * fq) * 2);
            const float ef = __expf(ci_f), er = __expf(ci_r);
#pragma unroll
            for (int pt = 0; pt < 4; ++pt) {
                f32x4 y = (f32x4){0.f, 0.f, 0.f, 0.f}, t1 = y, t2 = y;
#pragma unroll
                for (int kk = 0; kk < 4; ++kk) {
                    y = __builtin_amdgcn_mfma_f32_16x16x32_bf16(tr_frag(xS, 144, 32 * kk, 16 * pt, lane), wf[kk], y, 0, 0, 0);
                    t1 = __builtin_amdgcn_mfma_f32_16x16x32_bf16(*(LAS const bf16x8*)(sFS + (16 * pt + fr) * 272 + (32 * kk + 8 * fq) * 2), cf[kk], t1, 0, 0, 0);
                    t2 = __builtin_amdgcn_mfma_f32_16x16x32_bf16(*(LAS const bf16x8*)(sBS + (16 * pt + fr) * 272 + (32 * kk + 8 * fq) * 2), cf[kk], t2, 0, 0, 0); }
                const u32x2 zz = *(LAS const u32x2*)(zS + irow * 136 + (16 * pt + 4 * fq) * 2);
                const f32x4 zf = (f32x4){bflo(zz.x), bfhi(zz.x), bflo(zz.y), bfhi(zz.y)};
                f32x4 o;
#pragma unroll
                for (int r = 0; r < 4; ++r) { o[r] = (y[r] + ef * t1[r] + er * t2[r]) * siluf_(zf[r]); ssq += o[r] * o[r]; }
                u32x2 w_; w_.x = pk2(o[0], o[1]); w_.y = pk2(o[2], o[3]);
                *(LAS u32x2*)(ygS + irow * 136 + (16 * pt + 4 * fq) * 2) = w_;
            }
            __syncthreads();
#pragma unroll
            for (int i = 0; i < 2; ++i) { const int idx = tid + i * 512, q = idx >> 3, ch = idx & 7;
                *(u32x4*)(YG + (size_t)(row0 + q) * MB_DI + hd * 64 + ch * 8) = *(LAS const u32x4*)(ygS + q * 136 + ch * 16); }
        }
#undef MBO_PREFETCH
        { float s_ = ssq; s_ += __shfl_xor(s_, 16); s_ += __shfl_xor(s_, 32);
          if (fq == 0) { if (u < 512) SSQ[(size_t)(row0 + irow) * 4 + g] = s_; else SSQC[(size_t)(row0 + irow) * 32 + g * 8 + e_lo] = s_; } }
    }
}


template <int CTRL> __device__ __forceinline__ float dpp_f(float v) { return __builtin_bit_cast(float, __builtin_amdgcn_update_dpp(0, __builtin_bit_cast(int, v), CTRL, 0xf, 0xf, false)); }
__device__ __forceinline__ float red8(float v) { v += dpp_f<0xB1>(v); v += dpp_f<0x4E>(v); v += dpp_f<0x141>(v); return v; }
__device__ __forceinline__ float red16(float v);
__device__ __forceinline__ float wave_sum_fast(float v) {
    v = red16(v);
    const float a = __builtin_bit_cast(float, __builtin_amdgcn_readlane(__builtin_bit_cast(int, v), 0)), b = __builtin_bit_cast(float, __builtin_amdgcn_readlane(__builtin_bit_cast(int, v), 16)),
                c = __builtin_bit_cast(float, __builtin_amdgcn_readlane(__builtin_bit_cast(int, v), 32)), d = __builtin_bit_cast(float, __builtin_amdgcn_readlane(__builtin_bit_cast(int, v), 48));
    return (a + b) + (c + d);
}
__device__ __forceinline__ float red16(float v) { v += dpp_f<0xB1>(v); v += dpp_f<0x4E>(v); v += dpp_f<0x141>(v); v += dpp_f<0x140>(v); return v; }
#ifndef CVT_REP
#define CVT_REP 1
#endif
constexpr int RW_TS = 32;
constexpr int N_MOEIN_IT = 16 * 224, N_MOEOUT_IT = 56 * 32;
__device__ __forceinline__ void p_rw_l2(const Frame& F) {
    const bf16_t* L1 = SCR(bf16_t, S_L1); const bf16_t* W2 = WSP(bf16_t, W_RWL2);
    float* WD = SCR(float, S_WD); bf16_t* AD = SCR(bf16_t, S_AD); bf16_t* GG = SCR(bf16_t, S_GG);
    const int gw = F.vcu * NWAVES + F.wave, NGW = F.G * NWAVES, lane = F.lane, fr = lane & 15, fq = lane >> 4;
    for (int it = gw; it < 2 * (RT / 16); it += NGW) {
        const int rt = it >> 1, nb0 = (it & 1) * 32, seg = 4, row = rt * 16 + fr;
        const int K = seg < 4 ? 64 : 128, koff = seg < 4 ? seg * 64 : 256;
        const bf16_t* Wseg = W2 + (seg < 4 ? (size_t)seg * 1024 * 64 : (size_t)4 * 1024 * 64);
        bf16x8 af[4];
#pragma unroll
        for (int kk = 0; kk < 4; ++kk) af[kk] = (kk * 32 < K) ? *(const bf16x8*)(L1 + (size_t)row * 384 + koff + 32 * kk + 8 * fq) : (bf16x8){0, 0, 0, 0, 0, 0, 0, 0};
        const float* bias = seg < 2 ? F.in[I_RWW0] + seg * DM : (seg < 4 ? F.in[I_RWA0] + (seg - 2) * DM : nullptr);
#pragma unroll 1
        for (int nb = nb0; nb < nb0 + 32; nb += 8) {
            bf16x8 wf[8][4];
#pragma unroll
            for (int u = 0; u < 8; ++u) { const bf16_t* wr = Wseg + (size_t)(16 * (nb + u) + fr) * K + 8 * fq;
                wf[u][0] = *(const bf16x8*)(wr); wf[u][1] = *(const bf16x8*)(wr + 32);
                if (seg == 4) { wf[u][2] = *(const bf16x8*)(wr + 64); wf[u][3] = *(const bf16x8*)(wr + 96); } }
#pragma unroll
            for (int u = 0; u < 8; ++u) {
                const int nt = nb + u;
                f32x4 acc = (f32x4){0.f, 0.f, 0.f, 0.f};
                acc = __builtin_amdgcn_mfma_f32_16x16x32_bf16(wf[u][0], af[0], acc, 0, 0, 0);
                acc = __builtin_amdgcn_mfma_f32_16x16x32_bf16(wf[u][1], af[1], acc, 0, 0, 0);
                if (seg == 4) { acc = __builtin_amdgcn_mfma_f32_16x16x32_bf16(wf[u][2], af[2], acc, 0, 0, 0); acc = __builtin_amdgcn_mfma_f32_16x16x32_bf16(wf[u][3], af[3], acc, 0, 0, 0); }
                const int c = 16 * nt + 4 * fq;
                if (seg < 4) { const f32x4 bb = *(const f32x4*)(bias + c); f32x4 o;
#pragma unroll
                    for (int i = 0; i < 4; ++i) { const float sg = sigmoidf_(acc[i] + bb[i]); o[i] = seg < 2 ? -0.606531f * sg : sg; }
                    if (seg < 2) *(f32x4*)(WD + (size_t)seg * RT * DM + (size_t)row * DM + c) = o;
                    else { u32x2 w_; w_.x = pk2(o[0], o[1]); w_.y = pk2(o[2], o[3]); *(u32x2*)(AD + (size_t)(seg - 2) * RT * DM + (size_t)row * DM + c) = w_; }
                } else { u32x2 w_; w_.x = pk2(acc[0], acc[1]); w_.y = pk2(acc[2], acc[3]); *(u32x2*)(GG + (size_t)row * DM + c) = w_; }
            }
        }
    }
}

constexpr int WY_C = 64, WY_NCH = (TC + TL) / WY_C, WY_LD = 144, WY_IMG = 64 * WY_LD, WY_FRAGS = 32, WY_ITEM = WY_FRAGS * 1024;
__device__ __forceinline__ int wy_row0(int b, int d, int c) {
    return c < TC / WY_C ? b * TC + (d ? TC - 1 - c * WY_C : c * WY_C) : RC + b * TL + (d ? TL - 1 - (c - TC / WY_C) * WY_C : (c - TC / WY_C) * WY_C);
}
template <int CTRL> __device__ __forceinline__ float dpp0_f(float v) { return __builtin_bit_cast(float, __builtin_amdgcn_update_dpp(0, __builtin_bit_cast(int, v), CTRL, 0xf, 0xf, true)); }
template <bool ATR, bool BTR>
__device__ __forceinline__ void wy_mm2(f32x4 (&acc)[2], LAS const unsigned char* X, LAS const unsigned char* Y, int mt, int nt0, int lane) {
    const int fr = lane & 15, fq = lane >> 4;
#pragma unroll
    for (int kk = 0; kk < 2; ++kk) {
        const bf16x8 a = ATR ? tr_frag(X, WY_LD, 32 * kk, 16 * mt, lane) : *(LAS const bf16x8*)(X + (16 * mt + fr) * WY_LD + (32 * kk + 8 * fq) * 2);
#pragma unroll
        for (int q = 0; q < 2; ++q) {
            const bf16x8 bb = BTR ? tr_frag(Y, WY_LD, 32 * kk, 16 * (nt0 + q), lane) : *(LAS const bf16x8*)(Y + (16 * (nt0 + q) + fr) * WY_LD + (32 * kk + 8 * fq) * 2);
            acc[q] = __builtin_amdgcn_mfma_f32_16x16x32_bf16(a, bb, acc[q], 0, 0, 0);
        }
    }
}
__device__ __forceinline__ void wy_put2(LAS unsigned char* img, const f32x4 (&acc)[2], int mt, int nt0, int lane) {
    const int fr = lane & 15, fq = lane >> 4;
#pragma unroll
    for (int q = 0; q < 2; ++q) { u32x2 w_; w_.x = pk2(acc[q][0], acc[q][1]); w_.y = pk2(acc[q][2], acc[q][3]);
        *(LAS u32x2*)(img + (16 * (nt0 + q) + fr) * WY_LD + (16 * mt + 4 * fq) * 2) = w_; }
}
struct CvtJob { const float* W; bf16_t* WT; int ldw, ldt, k0, n0, inter_half, drow0; const float* ksc; };
__device__ __forceinline__ CvtJob moe_cvt_job(const Frame& F, int it) {
    const int per = N_MOEIN_IT + N_MOEOUT_IT, le = it / per, r = it % per; CvtJob j; j.drow0 = 0; j.ksc = nullptr;
    if (r < N_MOEIN_IT) { j.W = F.in[I_MOEIN] + (size_t)le * DM * 2 * FFE; j.ldw = 2 * FFE; j.k0 = 64 * (r / 224); j.n0 = 32 * (r % 224); j.WT = WSP(bf16_t, W_MOEIN) + (size_t)le * 2 * FFE * DM; j.ldt = DM; j.inter_half = FFE; }
    else { const int rr = r - N_MOEIN_IT; j.W = F.in[I_MOEOUT] + (size_t)le * FFE * DM; j.ldw = DM; j.k0 = 64 * (rr / 32); j.n0 = 32 * (rr % 32); j.WT = WSP(bf16_t, W_MOEOUT) + (size_t)le * DM * FFE; j.ldt = FFE; j.inter_half = 0; }
    return j;
}
__device__ __forceinline__ void cvt_load(const CvtJob& j, float (&tv)[32], int lane) {
#pragma unroll
    for (int i = 0; i < 32; ++i) { const int kk = 2 * i + (lane >> 5); tv[i] = __builtin_nontemporal_load(j.W + (size_t)(j.k0 + kk) * j.ldw + j.n0 + (lane & 31)); }
}
__device__ __forceinline__ void cvt_finish(const CvtJob& j, const float (&tv)[32], LAS unsigned char* img, int lane) {
#pragma unroll
    for (int i = 0; i < 32; ++i) { const int kk = 2 * i + (lane >> 5); float v = tv[i]; if (j.ksc) v *= j.ksc[j.k0 + kk]; *(LAS bf16_t*)(img + kk * 72 + (lane & 31) * 2) = (bf16_t)f2bf(v); }
    LDS_WAIT(); asm volatile("" ::: "memory");
    const int fr = lane & 15, fq = lane >> 4;
#pragma unroll
    for (int c = 0; c < 2; ++c) { const int gn = j.n0 + 16 * c + fr; const int drow = j.drow0 + (j.inter_half ? (gn < j.inter_half ? 2 * gn : 2 * (gn - j.inter_half) + 1) : gn);
#pragma unroll
        for (int kk = 0; kk < 2; ++kk) { const bf16x8 v = tr_frag(img, 72, 32 * kk, 16 * c, lane);
            *(bf16x8*)(j.WT + (size_t)drow * j.ldt + j.k0 + 32 * kk + 8 * fq) = v; } }
    LDS_WAIT(); asm volatile("" ::: "memory");
}
namespace pro {
constexpr int N_MBIN = 16 * 162, N_MBOUT = 32 * 32, N_RKV = 16 * 32, N_W1 = 16 * 2, N_G1 = 16 * 4, N_SQ = 16 * 32, N_PL = 4 * 8, N_QKV = 16 * 48, N_FFIN = 16 * 176, N_FFOUT = 44 * 32;
constexpr int NITEMS = N_MBIN + N_MBOUT + 3 * N_RKV + 4 * N_W1 + N_G1 + 4 * 32 + 2 * 32 + N_SQ + 4 * N_PL + N_QKV + N_SQ + 2 * N_FFIN + 2 * N_FFOUT;
}
__device__ __forceinline__ CvtJob pro_cvt_job(const Frame& F, int r) {
    using namespace pro;
    const float* const* in = F.in; CvtJob j; j.inter_half = 0; j.drow0 = 0; j.ksc = nullptr;
#define PSET(Wp, LDW, K0, N0, WTp, LDT) do { j.W = (Wp); j.ldw = (LDW); j.k0 = (K0); j.n0 = (N0); j.WT = (WTp); j.ldt = (LDT); } while (0)
#define PJ(cnt, ...) if (r < (cnt)) { __VA_ARGS__; return j; } r -= (cnt);
    PJ(N_MBIN, PSET(in[I_MBIN], MB_NIN, 64 * (r / 162), 32 * (r % 162), WSP(bf16_t, W_MBIN), DM))
    PJ(N_MBOUT, PSET(in[I_MBOUT], DM, 64 * (r / 32), 32 * (r % 32), WSP(bf16_t, W_MBOUT), MB_DI); j.ksc = in[I_MBNG])
    PJ(3 * N_RKV, { const int q = r / N_RKV, rr = r % N_RKV; PSET(in[I_RWRKV] + (size_t)q * DM * DM, DM, 64 * (rr / 32), 32 * (rr % 32), WSP(bf16_t, W_RWBIG), DM); j.drow0 = q * 1024; })
    PJ(4 * N_W1, { const int q = r / N_W1, rr = r % N_W1; const int isa = q >> 1, d = q & 1;
        PSET(in[isa ? I_RWA1 : I_RWW1] + (size_t)d * DM * 64, 64, 64 * (rr / 2), 32 * (rr % 2), WSP(bf16_t, W_RWBIG), DM); j.drow0 = 3072 + isa * 256 + d * 64; })
    PJ(N_G1, PSET(in[I_RWG1], 128, 64 * (r / 4), 32 * (r % 4), WSP(bf16_t, W_RWBIG), DM); j.drow0 = 3584)
    PJ(4 * 32, { const int seg = r / 32, nb = r % 32; PSET(in[seg < 2 ? I_RWW2 : I_RWA2] + (size_t)(seg & 1) * 64 * DM, DM, 0, 32 * nb, WSP(bf16_t, W_RWL2) + (size_t)seg * 1024 * 64, 64); })
    PJ(2 * 32, PSET(in[I_RWG2], DM, 64 * (r / 32), 32 * (r % 32), WSP(bf16_t, W_RWL2) + (size_t)4 * 1024 * 64, 128))
    PJ(N_SQ, PSET(in[I_RWOUT], DM, 64 * (r / 32), 32 * (r % 32), WSP(bf16_t, W_RWOUT), DM))
    PJ(4 * N_PL, { const int gi = r / N_PL, rr = r % N_PL; PSET(in[I_PLW] + (size_t)gi * 65536, 256, 64 * (rr / 8), 32 * (rr % 8), WSP(bf16_t, W_POOL), 256); j.drow0 = gi * 256; })
    PJ(N_QKV, PSET(in[I_ATQKV], 1536, 64 * (r / 48), 32 * (r % 48), WSP(bf16_t, W_QKV), DM))
    PJ(N_SQ, PSET(in[I_ATOUT], DM, 64 * (r / 32), 32 * (r % 32), WSP(bf16_t, W_ATOUT), DM))
    PJ(2 * N_FFIN, { const int l = r / N_FFIN, rr = r % N_FFIN; PSET(in[I_FFIN] + (size_t)l * DM * 2 * FFD, 2 * FFD, 64 * (rr / 176), 32 * (rr % 176), WSP(bf16_t, W_FFIN) + (size_t)l * 2 * FFD * DM, DM); j.inter_half = FFD; })
    { const int l = r / N_FFOUT, rr = r % N_FFOUT; PSET(in[I_FFOUT] + (size_t)l * FFD * DM, DM, 64 * (rr / 32), 32 * (rr % 32), WSP(bf16_t, W_FFOUT) + (size_t)l * DM * FFD, FFD); }
    return j;
#undef PJ
#undef PSET
}
template <int PART>
__device__ __forceinline__ void p_prologue(const Frame& F) {
    const float* const* in = F.in;
    if (PART == 0) {
    {
        LAS float* sv = (LAS float*)F.lds;
        LAS float* part = (LAS float*)(F.lds + 16384);
        for (int i = F.tid; i < 3 * DM; i += NWAVES * 64) { const int s = i >> 10, k = i & 1023; const float cv = (s == 0) ? in[I_CCTX][k] : in[I_C][(s - 1) * DM + k]; sv[i] = siluf_(cv); }
        __syncthreads();
        float* MOD = WSP(float, WS_MOD);
        const int c4 = F.lane & 7, kb = F.wave * 128 + (F.lane >> 3);
        f32x4 w[16], wn[16];
        int it = blockIdx.x;
#define MOD_LOAD(dst, item) do { const float* W_ = in[I_MODW] + (size_t)((item) / 192) * DM * 6144 + ((item) % 192) * 32 + 4 * c4; \
        _Pragma("unroll") for (int i = 0; i < 16; ++i) dst[i] = __builtin_nontemporal_load((const f32x4*)(W_ + (size_t)(kb + 8 * i) * 6144)); } while (0)
        if (it < 4 * 192) MOD_LOAD(w, it);
        for (; it < 4 * 192; it += F.G) {
            const int layer = it / 192, cg = it % 192; const bool hn = it + F.G < 4 * 192;
            if (hn) MOD_LOAD(wn, it + F.G);
            f32x4 a0 = (f32x4){0.f, 0.f, 0.f, 0.f}, a1 = a0, a2 = a0;
#pragma unroll
            for (int i = 0; i < 16; ++i) { const int k = kb + 8 * i; a0 += w[i] * sv[k]; a1 += w[i] * sv[DM + k]; a2 += w[i] * sv[2 * DM + k]; }
#pragma unroll
            for (int m = 8; m < 64; m <<= 1)
#pragma unroll
                for (int q = 0; q < 4; ++q) { a0[q] += __shfl_xor(a0[q], m); a1[q] += __shfl_xor(a1[q], m); a2[q] += __shfl_xor(a2[q], m); }
            if (F.lane < 8) { *(LAS f32x4*)(part + (F.wave * 3 + 0) * 32 + 4 * c4) = a0; *(LAS f32x4*)(part + (F.wave * 3 + 1) * 32 + 4 * c4) = a1; *(LAS f32x4*)(part + (F.wave * 3 + 2) * 32 + 4 * c4) = a2; }
            __syncthreads();
            if (F.tid < 96) { const int s = F.tid >> 5, col = F.tid & 31; float sum = in[I_MODB][layer * 6144 + cg * 32 + col];
#pragma unroll
                for (int wv = 0; wv < 8; ++wv) sum += part[(wv * 3 + s) * 32 + col];
                MOD[((size_t)layer * 3 + s) * 6144 + cg * 32 + col] = sum; }
            __syncthreads();
            if (hn) {
#pragma unroll
                for (int i = 0; i < 16; ++i) w[i] = wn[i]; }
        }
#undef MOD_LOAD
    }
    {
        float* RP = WSP(float, WS_ROPE);
        for (int i = blockIdx.x * (NWAVES * 64) + F.tid; i < 2048; i += F.G * NWAVES * 64) {
            const int pos = i >> 4, f = i & 15; const float inv = powf(10000.f, -(float)f / 16.f); const float ang = (float)pos * inv;
            RP[i] = (float)cos((double)ang); RP[2048 + i] = (float)sin((double)ang); }
    }
    }
    if (PART == 1)
    {
        LAS unsigned char* img = F.lds + F.wave * 16384;
        const int gw = F.vcu * NWAVES + F.wave, NGW = F.G * NWAVES, lane = F.lane;
        float ta[32], tb[32];
        int it = gw;
        if (it < pro::NITEMS) {
            CvtJob ja = pro_cvt_job(F, it), jb = ja; cvt_load(ja, ta, lane);
            for (;;) {
                const int i1 = it + NGW; const bool h1 = i1 < pro::NITEMS;
                if (h1) { jb = pro_cvt_job(F, i1); cvt_load(jb, tb, lane); }
                cvt_finish(ja, ta, img, lane);
                if (!h1) break;
                const int i2 = i1 + NGW; const bool h2 = i2 < pro::NITEMS;
                if (h2) { ja = pro_cvt_job(F, i2); cvt_load(ja, ta, lane); }
                cvt_finish(jb, tb, img, lane);
                if (!h2) break;
                it = i2;
            }
        }
    }
}

constexpr int WY_PREP_CVT = 64 * WY_NCH * 8;
#define WY_BAR() asm volatile("s_waitcnt lgkmcnt(0)\n\ts_barrier" ::: "memory")
__device__ __forceinline__ void p_wy_prep(const Frame& F) {
    const bf16_t* RKV = SCR(bf16_t, S_RKV);
    unsigned char* WYB = SCR(unsigned char, S_WY);
#define WIMG(i) (F.lds + (i) * WY_IMG)
    LAS float* lwS = (LAS float*)(F.lds + 11 * WY_IMG);
    LAS float* gCs = lwS + 64 * 65;
    const int tid = F.tid, lane = F.lane, w = F.wave, fr = lane & 15, fq = lane >> 4;
    const int t = tid >> 3, cc = tid & 7;
    const int mt = w >> 1, nt0 = 2 * (w & 1);
    const size_t PL = (size_t)RT * DM;
    const bf16_t* L1 = SCR(bf16_t, S_L1); const bf16_t* W2 = WSP(bf16_t, W_RWL2);
    LAS float* aS = gCs + 64;
    LAS float* hpS = aS + 64 * 65; LAS f32x4* hpS4 = (LAS f32x4*)hpS;
    u32x4 pfb[7];
#define WY_PREFETCH(item_) do { const int ch_ = (item_) / WY_NCH, c_ = (item_) % WY_NCH, b_ = ch_ >> 5, h_ = (ch_ >> 1) & 15, d_ = ch_ & 1; \
        const size_t row_ = (size_t)(wy_row0(b_, d_, c_) + (d_ ? -t : t)), o_ = row_ * DM + h_ * 64 + 8 * cc; \
        pfb[0] = *(const u32x4*)(RKV + o_); pfb[1] = *(const u32x4*)(RKV + PL + o_); pfb[2] = *(const u32x4*)(RKV + 2 * PL + o_); \
        pfb[3] = *(const u32x4*)(L1 + row_ * 384 + d_ * 64 + 8 * cc); pfb[4] = *(const u32x4*)(L1 + row_ * 384 + 128 + d_ * 64 + 8 * cc); \
        pfb[5] = *(const u32x4*)(W2 + ((size_t)d_ * 1024 + h_ * 64 + t) * 64 + 8 * cc); pfb[6] = *(const u32x4*)(W2 + ((size_t)(2 + d_) * 1024 + h_ * 64 + t) * 64 + 8 * cc); } while (0)
    auto item_of = [&](int L) { const int P = L >> 1, side = L & 1, bh = P / WY_NCH, c0 = P % WY_NCH; return (bh * 2 + side) * WY_NCH + (side ? WY_NCH - 1 - c0 : c0); };
    if (F.vcu < 64 * WY_NCH) WY_PREFETCH(item_of(F.vcu));
    for (int L_ = F.vcu; L_ < 64 * WY_NCH; L_ += F.G) {
        const int item = item_of(L_);
        const int chain = item / WY_NCH, c = item % WY_NCH, b = chain >> 5, h = (chain >> 1) & 15, d = chain & 1;
        unsigned char* ob = WYB + (size_t)item * WY_ITEM;
        float wbv[2], abv[2];
#pragma unroll
        for (int q = 0; q < 2; ++q) { const int ch = 16 * (nt0 + q) + fr; wbv[q] = F.in[I_RWW0][d * DM + h * 64 + ch]; abv[q] = F.in[I_RWA0][d * DM + h * 64 + ch]; }
        if (tid < 48) { const int q_ = tid >> 4; hpS4[tid] = *(const f32x4*)(F.in[q_ == 0 ? I_RWKK : (q_ == 1 ? I_RWKA : I_RWRK)] + h * 64 + 4 * (tid & 15)); }
        const CvtJob cj = moe_cvt_job(F, item * 8 + w); float ctv[32];
        cvt_load(cj, ctv, lane);
        WY_BAR();
        float r8[8], k8[8], v8[8], lw8[8], a8[8];
        unpack8(pfb[0], r8); unpack8(pfb[1], k8); unpack8(pfb[2], v8);
        *(LAS u32x4*)(WIMG(6) + t * WY_LD + cc * 16) = pfb[3]; *(LAS u32x4*)(WIMG(7) + t * WY_LD + cc * 16) = pfb[4];
        *(LAS u32x4*)(WIMG(8) + t * WY_LD + cc * 16) = pfb[5]; *(LAS u32x4*)(WIMG(9) + t * WY_LD + cc * 16) = pfb[6];
        WY_BAR();
        { f32x4 la[2] = {(f32x4){0.f, 0.f, 0.f, 0.f}, (f32x4){0.f, 0.f, 0.f, 0.f}}, aa[2] = {(f32x4){0.f, 0.f, 0.f, 0.f}, (f32x4){0.f, 0.f, 0.f, 0.f}};
          wy_mm2<false, false>(la, WIMG(6), WIMG(8), mt, nt0, lane); wy_mm2<false, false>(aa, WIMG(7), WIMG(9), mt, nt0, lane);
#pragma unroll
          for (int q = 0; q < 2; ++q) { const int ch = 16 * (nt0 + q) + fr; const float wb = wbv[q], ab = abv[q];
#pragma unroll
              for (int i = 0; i < 4; ++i) { const int tt = 16 * mt + 4 * fq + i; lwS[tt * 65 + ch] = -0.606531f * sigmoidf_(la[q][i] + wb); aS[tt * 65 + ch] = sigmoidf_(aa[q][i] + ab); } } }
        WY_BAR();
#pragma unroll
        for (int q = 0; q < 8; ++q) { lw8[q] = lwS[t * 65 + 8 * cc + q]; a8[q] = aS[t * 65 + 8 * cc + q]; }
        { const int row = wy_row0(b, d, c) + (d ? -t : t);
          float p1 = 0.f, p2 = 0.f;
#pragma unroll
          for (int q = 0; q < 8; ++q) { const float rkk = r8[q] * hpS[128 + 8 * cc + q] * k8[q]; p1 += rkk; p2 += rkk * hpS[64 + 8 * cc + q] * (a8[q] - 1.f); }
          p1 = red8(p1); p2 = red8(p2);
          if (cc == 0) { SCR(float, S_BON2)[((size_t)d * RT + row) * 16 + h] = p2; if (d == 0) SCR(float, S_AD)[(size_t)row * 16 + h] = p1; } }
        WY_BAR();
#pragma unroll
        for (int q = 0; q < 8; ++q) { const int ch = 8 * w + q; float x = lwS[lane * 65 + ch];
            x += dpp0_f<0x111>(x); x += dpp0_f<0x112>(x); x += dpp0_f<0x114>(x); x += dpp0_f<0x118>(x);
            const float t0 = __builtin_bit_cast(float, __builtin_amdgcn_readlane(__builtin_bit_cast(int, x), 15)), t1 = __builtin_bit_cast(float, __builtin_amdgcn_readlane(__builtin_bit_cast(int, x), 31)),
                        t2 = __builtin_bit_cast(float, __builtin_amdgcn_readlane(__builtin_bit_cast(int, x), 47));
            x += (fq == 1) ? t0 : (fq == 2) ? (t0 + t1) : (fq == 3) ? ((t0 + t1) + t2) : 0.f;
            lwS[lane * 65 + ch] = x; }
        WY_BAR();
        {
            float kx[8], ss = 0.f;
#pragma unroll
            for (int q = 0; q < 8; ++q) { kx[q] = k8[q] * hpS[8 * cc + q]; ss += kx[q] * kx[q]; }
            const float inv = 1.0f / fmaxf(sqrtf(red8(ss)), 1e-12f);
            float oA[8], oBt[8], oKt[8], oRt[8], oBc[8], oKc[8];
#pragma unroll
            for (int q = 0; q < 8; ++q) { const float lg = lwS[t * 65 + 8 * cc + q], lgC = lwS[63 * 65 + 8 * cc + q];
                const float kkv = kx[q] * inv, bv = kkv * a8[q], kd = k8[q] * (1.f + (a8[q] - 1.f) * hpS[64 + 8 * cc + q]);
                const float ginv = __expf(-lg), gc = __expf(lgC - lg);
                oA[q] = __expf(lg - lw8[q]) * kkv; oBt[q] = bv * ginv; oKt[q] = kd * ginv; oRt[q] = __expf(lg) * r8[q]; oBc[q] = bv * gc; oKc[q] = kd * gc;
                if (t == 63) gCs[8 * cc + q] = __expf(lgC); }
            *(LAS u32x4*)(WIMG(0) + t * WY_LD + cc * 16) = pack8(oA);  *(LAS u32x4*)(WIMG(1) + t * WY_LD + cc * 16) = pack8(oBt);
            *(LAS u32x4*)(WIMG(2) + t * WY_LD + cc * 16) = pack8(oKt); *(LAS u32x4*)(WIMG(3) + t * WY_LD + cc * 16) = pack8(oRt);
            *(LAS u32x4*)(WIMG(4) + t * WY_LD + cc * 16) = pack8(oBc); *(LAS u32x4*)(WIMG(5) + t * WY_LD + cc * 16) = pack8(oKc);
            *(LAS u32x4*)((LAS unsigned char*)aS + t * WY_LD + cc * 16) = pack8(v8);
        }
        WY_BAR();
        if (L_ + F.G < 64 * WY_NCH) WY_PREFETCH(item_of(L_ + F.G));
        f32x4 nb[2], nk[2], mbr[2], mkr[2], Treg[2];
#pragma unroll
        for (int q = 0; q < 2; ++q) { nb[q] = (f32x4){0.f, 0.f, 0.f, 0.f}; nk[q] = nb[q]; mbr[q] = nb[q]; mkr[q] = nb[q]; }
        wy_mm2<false, false>(nb, WIMG(1), WIMG(0), mt, nt0, lane); wy_mm2<false, false>(nk, WIMG(2), WIMG(0), mt, nt0, lane);
        wy_mm2<false, false>(mbr, WIMG(1), WIMG(3), mt, nt0, lane); wy_mm2<false, false>(mkr, WIMG(2), WIMG(3), mt, nt0, lane);
#pragma unroll
        for (int q = 0; q < 2; ++q)
#pragma unroll
            for (int i = 0; i < 4; ++i) { const int j = 16 * mt + 4 * fq + i, tt = 16 * (nt0 + q) + fr;
                nb[q][i] = (j < tt) ? -nb[q][i] : 0.f; nk[q][i] = (j < tt) ? nk[q][i] : 0.f; mbr[q][i] = (j <= tt) ? mbr[q][i] : 0.f; mkr[q][i] = (j <= tt) ? mkr[q][i] : 0.f;
                Treg[q][i] = nb[q][i] + ((j == tt) ? 1.f : 0.f); }
        WY_BAR();
        wy_put2(WIMG(8), nb, mt, nt0, lane); wy_put2(WIMG(6), nk, mt, nt0, lane); wy_put2(WIMG(7), mbr, mt, nt0, lane); wy_put2(WIMG(2), Treg, mt, nt0, lane);
        WY_BAR();
        { f32x4 p2[2] = {(f32x4){0.f, 0.f, 0.f, 0.f}, (f32x4){0.f, 0.f, 0.f, 0.f}};
          wy_mm2<true, false>(p2, WIMG(8), WIMG(8), mt, nt0, lane); wy_put2(WIMG(9), p2, mt, nt0, lane); }
        WY_BAR();
        int ts_ = 2, ps_ = 9, td_ = 1, pd_ = 8;
#pragma unroll 1
        for (int it = 1; it <= 5; ++it) {
            f32x4 tp[2] = {(f32x4){0.f, 0.f, 0.f, 0.f}, (f32x4){0.f, 0.f, 0.f, 0.f}}, pp[2] = {(f32x4){0.f, 0.f, 0.f, 0.f}, (f32x4){0.f, 0.f, 0.f, 0.f}};
            wy_mm2<true, false>(tp, WIMG(ts_), WIMG(ps_), mt, nt0, lane);
            if (it < 5) wy_mm2<true, false>(pp, WIMG(ps_), WIMG(ps_), mt, nt0, lane);
            Treg[0] += tp[0]; Treg[1] += tp[1];
            wy_put2(WIMG(td_), Treg, mt, nt0, lane);
            if (it < 5) wy_put2(WIMG(pd_), pp, mt, nt0, lane);
            WY_BAR();
            int tmp = ts_; ts_ = td_; td_ = tmp; tmp = ps_; ps_ = pd_; pd_ = tmp;
        }
        { f32x4 p1[2] = {(f32x4){0.f, 0.f, 0.f, 0.f}, (f32x4){0.f, 0.f, 0.f, 0.f}}, p2_[2] = {(f32x4){0.f, 0.f, 0.f, 0.f}, (f32x4){0.f, 0.f, 0.f, 0.f}};
          wy_mm2<true, false>(p1, WIMG(0), WIMG(1), mt, nt0, lane); wy_mm2<true, false>(p2_, WIMG(6), WIMG(1), mt, nt0, lane);
          wy_put2(WIMG(9), p1, mt, nt0, lane); wy_put2(WIMG(10), p2_, mt, nt0, lane); }
        WY_BAR();
        {
            f32x4 q1[2] = {(f32x4){0.f, 0.f, 0.f, 0.f}, (f32x4){0.f, 0.f, 0.f, 0.f}}, q2[2] = {q1[0], q1[0]}, e1[2] = {q1[0], q1[0]}, e2[2] = {q1[0], q1[0]};
            wy_mm2<true, false>(q1, WIMG(9), WIMG(7), mt, nt0, lane); wy_mm2<true, false>(q2, WIMG(10), WIMG(7), mt, nt0, lane);
            wy_mm2<true, true>(e1, WIMG(9), WIMG(4), mt, nt0, lane); wy_mm2<true, true>(e2, WIMG(10), WIMG(4), mt, nt0, lane);
            f32x4 q2t[2], e2t[2];
#pragma unroll
            for (int q = 0; q < 2; ++q) {
                const int nt = nt0 + q, n = 16 * nt + fr;
                float o1[4], o3[4];
#pragma unroll
                for (int i = 0; i < 4; ++i) { const int m = 16 * mt + 4 * fq + i;
                    o1[i] = bf2f(*(LAS const bf16_t*)(WIMG(3) + n * WY_LD + m * 2)) - q1[q][i];
                    q2t[q][i] = mkr[q][i] - q2[q][i];
                    o3[i] = ((m == n) ? gCs[m] : 0.f) - e1[q][i];
                    e2t[q][i] = bf2f(*(LAS const bf16_t*)(WIMG(5) + m * WY_LD + n * 2)) - e2[q][i]; }
                const int offS = (2 * nt + (mt >> 1)) * 1024 + (fq * 16 + fr) * 16 + (mt & 1) * 8;
                u32x2 w1, w3; w1.x = pk2(o1[0], o1[1]); w1.y = pk2(o1[2], o1[3]); w3.x = pk2(o3[0], o3[1]); w3.y = pk2(o3[2], o3[3]);
                *(u32x2*)(ob + offS) = w1; *(u32x2*)(ob + 8 * 1024 + offS) = w3;
            }
            wy_put2(WIMG(8), q2t, mt, nt0, lane); wy_put2((LAS unsigned char*)lwS, e2t, mt, nt0, lane);
        }
        WY_BAR();
        {
            f32x4 yvt[2] = {(f32x4){0.f, 0.f, 0.f, 0.f}, (f32x4){0.f, 0.f, 0.f, 0.f}}, svt[2] = {yvt[0], yvt[0]};
            wy_mm2<false, true>(yvt, WIMG(8), (LAS const unsigned char*)aS, mt, nt0, lane); wy_mm2<false, true>(svt, (LAS const unsigned char*)lwS, (LAS const unsigned char*)aS, mt, nt0, lane);
#pragma unroll
            for (int q = 0; q < 2; ++q) { const int vbk = nt0 + q; unsigned char* fo = ob + (16 + 4 * vbk + (mt >> 1)) * 1024 + lane * 16 + (mt & 1) * 8;
                u32x2 wy_, ws_; wy_.x = pk2(yvt[q][0], yvt[q][1]); wy_.y = pk2(yvt[q][2], yvt[q][3]); ws_.x = pk2(svt[q][0], svt[q][1]); ws_.y = pk2(svt[q][2], svt[q][3]);
                *(u32x2*)fo = wy_; *(u32x2*)(fo + 2 * 1024) = ws_; }
        }
        { LAS unsigned char* cimg = F.lds + (w < 6 ? w * 4608 : 6 * WY_IMG + (w - 6) * 4608);
          cvt_finish(cj, ctv, cimg, lane);
          const int extra = WY_PREP_CVT + item * 8 + w;
          if (extra < 16 * (N_MOEIN_IT + N_MOEOUT_IT)) { const CvtJob cj2 = moe_cvt_job(F, extra); cvt_load(cj2, ctv, lane); cvt_finish(cj2, ctv, cimg, lane); } }
    }
#undef WIMG
#undef WY_PREFETCH
}
__device__ __forceinline__ unsigned lds_ld_u32(unsigned addr) { unsigned v; asm volatile("ds_read_b32 %0, %1\n\ts_waitcnt lgkmcnt(0)" : "=v"(v) : "v"(addr) : "memory"); return v; }
__device__ __forceinline__ void lds_st_u32(unsigned addr, unsigned val) { asm volatile("ds_write_b32 %0, %1" :: "v"(addr), "v"(val) : "memory"); }
__device__ __forceinline__ void p_wy_seq(const Frame& F) {
    volatile LAS unsigned* flg = (volatile LAS unsigned*)(F.lds + LDSCTL_OFF + 128);
    if (F.tid < 8) flg[F.tid] = 0u;
    __syncthreads();
    const unsigned fa = (unsigned)(uintptr_t)(F.lds + LDSCTL_OFF + 128);
    const unsigned char* WYB = SCR(unsigned char, S_WY); bf16_t* YY = SCR(bf16_t, S_YY);
    const int lane = F.lane, fr = lane & 15, fq = lane >> 4;
    int gbase = 0;
    for (int unit = F.vcu; unit < 256; unit += F.G, gbase += WY_NCH) {
        const int chain = unit >> 2, vb = unit & 3, b = chain >> 5, h = (chain >> 1) & 15, d = chain & 1;
        const unsigned char* ib = WYB + (size_t)chain * WY_NCH * WY_ITEM + lane * 16;
        if (F.wave >= 1) {
            const int lw = F.wave - 1;
            for (int c = lw; c < WY_NCH; c += 7) {
                const int gc = gbase + c;
                const unsigned char* g_ = ib + (size_t)c * WY_ITEM; LAS unsigned char* l_ = F.lds + (gc % 6) * 20480 + lane * 16;
                u32x4 rg[20];
#pragma unroll
                for (int f = 0; f < 16; ++f) rg[f] = *(const u32x4*)(g_ + f * 1024);
#pragma unroll
                for (int f = 0; f < 4; ++f) rg[16 + f] = *(const u32x4*)(g_ + (16 + 4 * vb + f) * 1024);
                for (unsigned sp = 0; (int)lds_ld_u32(fa + 28) < gc - 5 && sp < (1u << 22); ++sp) __builtin_amdgcn_s_sleep(1);
#pragma unroll
                for (int f = 0; f < 20; ++f) *(LAS u32x4*)(l_ + f * 1024) = rg[f];
                asm volatile("s_waitcnt lgkmcnt(0)" ::: "memory");
                if (lane == 0) lds_st_u32(fa + 4 * (gc % 6), (unsigned)(gc + 1));
            }
            continue;
        }
        bf16_t* yP = YY + (size_t)d * RT * DM + h * 64 + vb * 16 + fr;
        f32x4 S[4];
#pragma unroll
        for (int k = 0; k < 4; ++k) S[k] = (f32x4){0.f, 0.f, 0.f, 0.f};
        for (int c = 0; c < WY_NCH; ++c) {
            const int gc = gbase + c;
            for (unsigned sp = 0; lds_ld_u32(fa + 4 * (gc % 6)) != (unsigned)(gc + 1) && sp < (1u << 24); ++sp) __builtin_amdgcn_s_sleep(0);
            asm volatile("" ::: "memory");
            LAS const unsigned char* lb = F.lds + (gc % 6) * 20480 + lane * 16;
            bf16x8 sf[2];
#pragma unroll
            for (int kk = 0; kk < 2; ++kk) { u32x4 pw; pw.x = pk2(S[2 * kk][0], S[2 * kk][1]); pw.y = pk2(S[2 * kk][2], S[2 * kk][3]); pw.z = pk2(S[2 * kk + 1][0], S[2 * kk + 1][1]); pw.w = pk2(S[2 * kk + 1][2], S[2 * kk + 1][3]);
                sf[kk] = __builtin_bit_cast(bf16x8, pw); }
            const int row0 = wy_row0(b, d, c), dir = d ? -1 : 1;
            bf16x8 fg[16]; u32x4 iv[4];
#pragma unroll
            for (int f = 0; f < 16; ++f) fg[f] = *(LAS const bf16x8*)(lb + f * 1024);
#pragma unroll
            for (int f = 0; f < 4; ++f) iv[f] = *(LAS const u32x4*)(lb + (16 + f) * 1024);
            asm volatile("s_waitcnt lgkmcnt(0)" ::: "memory");
            if (lane == 0) lds_st_u32(fa + 28, (unsigned)(gc + 1));
            __builtin_amdgcn_sched_barrier(0);
            f32x4 Sn[4], yv[4];
#pragma unroll
            for (int p = 0; p < 2; ++p) {
                yv[2 * p] = (f32x4){bflo(iv[p].x), bfhi(iv[p].x), bflo(iv[p].y), bfhi(iv[p].y)}; yv[2 * p + 1] = (f32x4){bflo(iv[p].z), bfhi(iv[p].z), bflo(iv[p].w), bfhi(iv[p].w)};
                Sn[2 * p] = (f32x4){bflo(iv[2 + p].x), bfhi(iv[2 + p].x), bflo(iv[2 + p].y), bfhi(iv[2 + p].y)}; Sn[2 * p + 1] = (f32x4){bflo(iv[2 + p].z), bfhi(iv[2 + p].z), bflo(iv[2 + p].w), bfhi(iv[2 + p].w)}; }
#pragma unroll
            for (int kk = 0; kk < 2; ++kk) {
#pragma unroll
                for (int kt = 0; kt < 4; ++kt) Sn[kt] = __builtin_amdgcn_mfma_f32_16x16x32_bf16(fg[8 + 2 * kt + kk], sf[kk], Sn[kt], 0, 0, 0);
#pragma unroll
                for (int mt = 0; mt < 4; ++mt) yv[mt] = __builtin_amdgcn_mfma_f32_16x16x32_bf16(fg[2 * mt + kk], sf[kk], yv[mt], 0, 0, 0);
            }
#pragma unroll
            for (int mt = 0; mt < 4; ++mt)
#pragma unroll
                for (int i = 0; i < 4; ++i) yP[(size_t)(row0 + dir * (16 * mt + 4 * fq + i)) * DM] = (bf16_t)f2bf(yv[mt][i]);
#pragma unroll
            for (int kt = 0; kt < 4; ++kt) S[kt] = Sn[kt];
        }
    }
}

__device__ __forceinline__ float sum4(const f32x4 v) { return (v[0] + v[1]) + (v[2] + v[3]); }
__device__ __forceinline__ f32x4 ld_bf4(const bf16_t* p) { const u32x2 w = *(const u32x2*)p; return (f32x4){bflo(w.x), bfhi(w.x), bflo(w.y), bfhi(w.y)}; }
__device__ __forceinline__ void p_rw_combine(const Frame& F) {
    const bf16_t* RKV = SCR(bf16_t, S_RKV); const float* BON1 = SCR(float, S_AD); const float* BON2 = SCR(float, S_BON2); const bf16_t* YY = SCR(bf16_t, S_YY); const bf16_t* GG = SCR(bf16_t, S_GG); bf16_t* OO = SCR(bf16_t, S_OO);
    const int gw = F.vcu * NWAVES + F.wave, NGW = F.G * NWAVES, lane = F.lane;
    const size_t PL = (size_t)RT * DM;
    LAS float* PR = (LAS float*)F.lds;
    for (int i = F.tid; i < 4 * DM; i += NWAVES * 64) { const int q = i >> 10, c = i & 1023; PR[i] = F.in[q == 0 ? I_RWKA : (q == 1 ? I_RWRK : (q == 2 ? I_RWLNG : I_RWLNB))][c]; }
    __syncthreads();
    auto bf4 = [](const u32x2 w) { return (f32x4){bflo(w.x), bfhi(w.x), bflo(w.y), bfhi(w.y)}; };
    struct RowIn { u32x2 y0[4], y1[4]; u32x2 v_[4], gg[4]; float b1[4], b20[4], b21[4]; };
    auto rload = [&](RowIn& x, int row) {
#pragma unroll
        for (int j = 0; j < 4; ++j) {
            const size_t o = (size_t)row * DM + 256 * j + 4 * lane; const int hd = 4 * j + (lane >> 4);
            x.y0[j] = __builtin_nontemporal_load((const u32x2*)(YY + o)); x.y1[j] = __builtin_nontemporal_load((const u32x2*)(YY + PL + o));
            x.v_[j] = __builtin_nontemporal_load((const u32x2*)(RKV + 2 * PL + o));
            x.gg[j] = __builtin_nontemporal_load((const u32x2*)(GG + o));
            x.b1[j] = BON1[(size_t)row * 16 + hd]; x.b20[j] = BON2[(size_t)row * 16 + hd]; x.b21[j] = BON2[((size_t)RT + row) * 16 + hd]; }
    };
    auto process = [&](const RowIn& x, int row) {
#pragma unroll
        for (int j = 0; j < 4; ++j) {
            const int c = 256 * j + 4 * lane; const size_t o = (size_t)row * DM + c;
            const f32x4 y = bf4(x.y0[j]) + bf4(x.y1[j]);
            const f32x4 v = bf4(x.v_[j]);
            const f32x4 lg = *(LAS const f32x4*)(PR + 2 * DM + c), lb = *(LAS const f32x4*)(PR + 3 * DM + c);
            const float mu = red16(sum4(y)) * (1.f / 64.f); const f32x4 dy = y - mu;
            const float var = red16(sum4(dy * dy)) * (1.f / 64.f);
            const float bon = x.b1[j] + 0.5f * (x.b20[j] + x.b21[j]);
            const float rs = __builtin_amdgcn_rsqf(var + 64e-5f);
            const f32x4 res = dy * rs * lg + lb + v * bon;
            u32x2 w_; w_.x = pk2(res[0] * bflo(x.gg[j].x), res[1] * bfhi(x.gg[j].x)); w_.y = pk2(res[2] * bflo(x.gg[j].y), res[3] * bfhi(x.gg[j].y));
            *(u32x2*)(OO + o) = w_;
        }
    };
    RowIn ra, rb;
    int row = gw;
    if (row < RT) rload(ra, row);
    for (; row < RT; row += 2 * NGW) {
        if (row + NGW < RT) rload(rb, row + NGW);
        process(ra, row);
        if (row + NGW >= RT) break;
        if (row + 2 * NGW < RT) rload(ra, row + 2 * NGW);
        process(rb, row + NGW);
    }
}

__device__ __forceinline__ void p_pool(const Frame& F, bf16_t* Pout) {
    const bf16_t* H = WSP(bf16_t, WS_H);
    constexpr int SR = 22, HALO = 8, TR = SR + 2 * HALO, NSTRIP = RT / SR, NLD = (TR * 128 + NWAVES * 64 - 1) / (NWAVES * 64);
    static_assert(RT % SR == 0, "strip rows");
    LAS unsigned char* tile = F.lds;
    const int tid = F.tid, cg = tid & 127, rq = tid >> 7, c = cg * 8, hw = 1 << (cg >> 5);
    u32x4 pf[NLD];
#define POOL_LOAD(strip_) do { const int rb_ = (strip_) * SR - HALO; _Pragma("unroll") for (int k = 0; k < NLD; ++k) { const int idx = tid + k * (NWAVES * 64), j = idx >> 7, ab = rb_ + j; \
        pf[k] = (j < TR && ab >= 0 && ab < RT) ? *(const u32x4*)(H + (size_t)ab * DM + (idx & 127) * 8) : (u32x4){0u, 0u, 0u, 0u}; } } while (0)
    int strip = blockIdx.x;
    if (strip < NSTRIP) POOL_LOAD(strip);
    for (; strip < NSTRIP; strip += F.G) {
        __syncthreads();
#pragma unroll
        for (int k = 0; k < NLD; ++k) { const int idx = tid + k * (NWAVES * 64); if ((idx >> 7) < TR) *(LAS u32x4*)(tile + (size_t)idx * 16) = pf[k]; }
        __syncthreads();
        if (strip + F.G < NSTRIP) POOL_LOAD(strip + F.G);
        const int r0 = strip * SR, rb = r0 - HALO;
        for (int r = rq * 6; r < (rq * 6 + 6 < SR ? rq * 6 + 6 : SR); ++r) {
            const int row = r0 + r;
            const int start = row < RC ? (row & ~(TC - 1)) : RC + ((row - RC) & ~(TL - 1)), len = row < RC ? TC : TL, t = row - start;
            int lo = t - hw; lo = lo < 0 ? 0 : lo; int hi = t + hw; hi = hi > len ? len : hi;
            float acc[8], x[8];
#pragma unroll
            for (int k = 0; k < 8; ++k) acc[k] = 0.f;
            for (int tt = lo; tt < hi; ++tt) { unpack8(*(LAS const u32x4*)(tile + (size_t)(start + tt - rb) * 2048 + cg * 16), x);
#pragma unroll
                for (int k = 0; k < 8; ++k) acc[k] += x[k]; }
            const float inv = 1.f / (float)(hi - lo);
            unpack8(*(LAS const u32x4*)(tile + (size_t)(row - rb) * 2048 + cg * 16), x);
            float o[8];
#pragma unroll
            for (int k = 0; k < 8; ++k) o[k] = acc[k] * inv - x[k];
            *(u32x4*)(Pout + (size_t)row * DM + c) = pack8(o);
        }
    }
#undef POOL_LOAD
}

__device__ __forceinline__ void qk_head8(float (&x)[8], const f32x4 g0, const f32x4 g1, LAS const float* RP, int cc, bool lat, int t, float outscale) {
    float ss = 0.f;
#pragma unroll
    for (int k = 0; k < 8; ++k) ss += x[k] * x[k];
    const float rstd = __builtin_amdgcn_rsqf(red8(ss) * (1.f / 64.f) + NORM_EPS);
#pragma unroll
    for (int k = 0; k < 4; ++k) { x[k] *= rstd * g0[k]; x[4 + k] *= rstd * g1[k]; }
    if (lat) {
        const int pos = (cc < 4) ? (t >> 6) : (t & 63); const int f0 = (cc & 1) * 8;
        const f32x4 c0 = *(LAS const f32x4*)(RP + pos * 16 + f0), c1 = *(LAS const f32x4*)(RP + pos * 16 + f0 + 4), s0 = *(LAS const f32x4*)(RP + 2048 + pos * 16 + f0), s1 = *(LAS const f32x4*)(RP + 2048 + pos * 16 + f0 + 4);
        const bool firsthalf = ((cc >> 1) & 1) == 0;
#pragma unroll
        for (int k = 0; k < 8; ++k) { const float other = dpp_f<0x4E>(x[k]); const float cs = k < 4 ? c0[k] : c1[k - 4], sn = k < 4 ? s0[k] : s1[k - 4];
            x[k] = firsthalf ? x[k] * cs - other * sn : x[k] * cs + other * sn; }
    }
#pragma unroll
    for (int k = 0; k < 8; ++k) x[k] *= outscale;
}
__device__ __forceinline__ void p_qkrope(const Frame& F) {
    const bf16_t* QKV = SCR(bf16_t, S_QKV); bf16_t* KB_ = SCR(bf16_t, S_KB); bf16_t* VB_ = SCR(bf16_t, S_VB);
    LAS float* RPl = (LAS float*)F.lds;
    for (int i = F.tid; i < 4096; i += NWAVES * 64) RPl[i] = WSP(float, WS_ROPE)[i];
    const int gw = F.vcu * NWAVES + F.wave, NGW = F.G * NWAVES, lane = F.lane, cc = lane & 7;
    const f32x4 g0 = *(const f32x4*)(F.in[I_ATKG] + 8 * cc), g1 = *(const f32x4*)(F.in[I_ATKG] + 8 * cc + 4);
    __syncthreads();
    auto ldrow = [&](int row) { return __builtin_nontemporal_load((const u32x4*)(QKV + (size_t)row * 1536) + 128 + lane); };
    auto process = [&](const u32x4 raw, int row) {
        const bool lat = row >= RC; const int b = lat ? (row - RC) >> 13 : row >> 8, t = lat ? (row - RC) & (TL - 1) : row & (TC - 1);
        const size_t kvrow = (size_t)b * KVL + (lat ? TC + t : t);
        float x[8]; unpack8(raw, x);
        qk_head8(x, g0, g1, RPl, cc, lat, t, 1.0f);
        if (lane < 32) *(u32x4*)(KB_ + kvrow * 256 + lane * 8) = pack8(x);
        else *(u32x4*)(VB_ + kvrow * 256 + (lane - 32) * 8) = raw;
    };
    u32x4 b0 = (u32x4){0u, 0u, 0u, 0u}, b1 = b0, b2 = b0, b3 = b0;
    int row = gw;
    if (row < RT) b0 = ldrow(row);
    if (row + NGW < RT) b1 = ldrow(row + NGW);
    if (row + 2 * NGW < RT) b2 = ldrow(row + 2 * NGW);
    for (; row < RT; row += 4 * NGW) {
        if (row + 3 * NGW < RT) b3 = ldrow(row + 3 * NGW);
        process(b0, row);
        if (row + NGW >= RT) break;
        if (row + 4 * NGW < RT) b0 = ldrow(row + 4 * NGW);
        process(b1, row + NGW);
        if (row + 2 * NGW >= RT) break;
        if (row + 5 * NGW < RT) b1 = ldrow(row + 5 * NGW);
        process(b2, row + 2 * NGW);
        if (row + 3 * NGW >= RT) break;
        if (row + 6 * NGW < RT) b2 = ldrow(row + 6 * NGW);
        process(b3, row + 3 * NGW);
    }
}

__device__ __forceinline__ void p_ctx_fix(const Frame& F, const float* gate, const float* ssq, int xin_inputs, int S) {
    const bf16_t* PART = SCR(bf16_t, S_PARTC); bf16_t* XW = WSP(bf16_t, WS_XW);
    const int gw = F.vcu * NWAVES + F.wave, NGW = F.G * NWAVES, lane = F.lane;
    for (int row = gw; row < RC; row += NGW) {
        float rs = 1.f;
        if (ssq) { const f32x4 q = *(const f32x4*)(ssq + (size_t)row * 4); rs = __builtin_amdgcn_rsqf(((q[0] + q[1]) + (q[2] + q[3])) * (1.f / 2048.f) + NORM_EPS); }
#pragma unroll
        for (int j = 0; j < 4; ++j) { const int c = 4 * lane + 256 * j; f32x4 a = (f32x4){0.f, 0.f, 0.f, 0.f};
            for (int ks = 0; ks < S; ++ks) a += ld_x4(PART + ((size_t)ks * RC + row) * DM + c);
            const f32x4 xi = xin_inputs ? *(const f32x4*)(F.in[I_CTX] + (size_t)row * DM + c) : ld_x4(XW + (size_t)row * DM + c);
            st_x4(XW + (size_t)row * DM + c, xi + *(const f32x4*)(gate + c) * a * rs); }
    }
}
__device__ __forceinline__ void moe_starts(const Frame& F, int (&ts)[NEXP]) {
    const int* CNT = WSP(int, WS_CNT); int acc = 0;
#pragma unroll
    for (int e = 0; e < NEXP; ++e) { acc += (CNT[e] + 255) >> 8; ts[e] = acc; }
}
__device__ __forceinline__ int seg_start(const int (&ts)[NEXP], int e) { int r = 0;
#pragma unroll
    for (int j = 0; j < NEXP - 1; ++j) r = (e == j + 1) ? ts[j] : r;
    return r; }
__device__ __forceinline__ void p_moe_gather(const Frame& F, int row_lo) {
    const int* SEL = WSP(int, WS_SEL); int* POS = WSP(int, WS_POS); int* CNT = WSP(int, WS_CNT); const bf16_t* H = WSP(bf16_t, WS_H); bf16_t* AG = SCR(bf16_t, S_AG);
    LAS int* red = (LAS int*)F.lds;
    const int nrows = RT - row_lo, per = (nrows + F.G - 1) / F.G, r_lo = row_lo + (int)blockIdx.x * per, r_hi = (r_lo + per < RT) ? r_lo + per : RT;
    int ct[8], cb_[8];
#pragma unroll
    for (int e = 0; e < 8; ++e) { ct[e] = 0; cb_[e] = 0; }
    for (int r = row_lo + F.tid; r < RT; r += NWAVES * 64) { const int s_ = SEL[r]; const int e0 = s_ & 255, e1 = s_ >> 8; const int before = r < r_lo ? 1 : 0;
#pragma unroll
        for (int e = 0; e < 8; ++e) { const int hit = (e0 == e) + (e1 == e); ct[e] += hit; cb_[e] += before * hit; } }
    __syncthreads();
#pragma unroll
    for (int e = 0; e < 8; ++e) { const float a = wave_sum((float)ct[e]), b = wave_sum((float)cb_[e]);
        if (F.lane == 0) { red[F.wave * 16 + e] = (int)a; red[F.wave * 16 + 8 + e] = (int)b; } }
    __syncthreads();
    if (F.tid < 16) { int a = 0;
#pragma unroll
        for (int w = 0; w < NWAVES; ++w) a += red[w * 16 + F.tid];
        red[8192 + F.tid] = a; }
    __syncthreads();
    int ts[NEXP]; { int acc = 0;
#pragma unroll
        for (int e = 0; e < NEXP; ++e) { acc += (red[8192 + e] + 255) >> 8; ts[e] = acc; } }
    if (blockIdx.x == 0 && F.tid < 8) CNT[F.tid] = red[8192 + F.tid];
    LAS int* slots = red + 8192 + 64;
    if (F.wave == 0) {
        int base[8];
#pragma unroll
        for (int e = 0; e < 8; ++e) base[e] = red[8192 + 8 + e];
        for (int ch = 0; r_lo + ch < r_hi; ch += 64) {
            const int r = r_lo + ch + F.lane; const bool valid = r < r_hi; const int s_ = valid ? SEL[r] : 0xffff; const int e0 = s_ & 255, e1 = (s_ >> 8) & 255;
            int p0 = 0, p1 = 0, g0 = 0, g1 = 0;
#pragma unroll
            for (int e = 0; e < 8; ++e) { const unsigned long long m = __ballot((e0 == e) || (e1 == e)); const int pre = base[e] + __popcll(m & ((1ull << F.lane) - 1ull));
                if (e0 == e) { p0 = pre; g0 = seg_start(ts, e); } if (e1 == e) { p1 = pre; g1 = seg_start(ts, e); } base[e] += __popcll(m); }
            if (valid) { POS[2 * r] = p0; POS[2 * r + 1] = p1; slots[2 * (ch + F.lane)] = g0 * 256 + p0; slots[2 * (ch + F.lane) + 1] = g1 * 256 + p1; }
        }
    }
    __syncthreads();
    const int nb = r_hi - r_lo;
    for (int i0 = F.wave * 4; i0 < nb; i0 += NWAVES * 4) {
        u32x4 a[4][2];
#pragma unroll
        for (int u = 0; u < 4; ++u) if (i0 + u < nb) { const u32x4* src = (const u32x4*)(H + (size_t)(r_lo + i0 + u) * DM); a[u][0] = src[F.lane]; a[u][1] = src[64 + F.lane]; }
#pragma unroll
        for (int u = 0; u < 4; ++u) if (i0 + u < nb) {
#pragma unroll
            for (int j = 0; j < 2; ++j) { u32x4* dst = (u32x4*)(AG + (size_t)slots[2 * (i0 + u) + j] * DM); dst[F.lane] = a[u][0]; dst[64 + F.lane] = a[u][1]; } }
    }
}
__device__ __forceinline__ f32x4 moe_y(const bf16_t* YS, const bf16_t* PARTM, size_t so, int nsl, int c) {
    if (so < (size_t)128 * 256 * DM) { const u32x2 y = *(const u32x2*)(YS + so + c); return (f32x4){bflo(y.x), bfhi(y.x), bflo(y.y), bfhi(y.y)}; }
    f32x4 a = (f32x4){0.f, 0.f, 0.f, 0.f}; const bf16_t* p = PARTM + (so - (size_t)128 * 256 * DM) + c;
    for (int ks = 0; ks < nsl; ++ks) a += ld_x4(p + (size_t)ks * PARTM_ROWS * 1024);
    return a;
}
template <int MODE>
__device__ __forceinline__ void p_moe_combine(const Frame& F, int layer, int row_lo) {
    const int* SEL = WSP(int, WS_SEL); const int* POS = WSP(int, WS_POS); const float* WTS = WSP(float, WS_WTS); const bf16_t* YS = SCR(bf16_t, S_YS);
    bf16_t* XW = WSP(bf16_t, WS_XW); bf16_t* H = WSP(bf16_t, WS_H);
    const float* MOD = WSP(float, WS_MOD) + (size_t)layer * 3 * 6144; const float* MODN = MOD + 3 * 6144;
    LAS float* GSw = (LAS float*)(F.lds + NL_GS); LAS float* GT = (LAS float*)(F.lds + NL_X);
    if (MODE == 0) stage_norm_params(F, F.in[I_N1G] + (layer + 1) * DM, MODN, 0);
    else { for (int i = F.tid; i < DM; i += NWAVES * 64) GSw[i] = F.in[I_FG][i]; }
    for (int i = F.tid; i < 3 * DM; i += NWAVES * 64) GT[i] = MOD[(size_t)(i >> 10) * 6144 + 5 * DM + (i & 1023)];
    __syncthreads();
    LAS const float* GS = GSw; LAS const float* SH = (LAS const float*)(F.lds + NL_SH);
    int ts[NEXP]; moe_starts(F, ts);
    const bf16_t* PARTM = SCR(bf16_t, S_PARTM);
    int nsl = 0; { const int nM = ts[NEXP - 1], tailU = (nM - 128) * 4; if (tailU > 0) { nsl = 256 / tailU; nsl = nsl > 7 ? 7 : (nsl < 1 ? 1 : nsl); } }
    const int gw = F.vcu * NWAVES + F.wave, NGW = F.G * NWAVES, lane = F.lane;
    struct CIdx { int s, p0, p1; float w0, w1; };
    struct CDat { u32x2 y0[4], y1[4], xr[4]; f32x4 fs[4]; int fast0, fast1; float w0, w1; };
    const size_t TAIL0 = (size_t)128 * 256 * DM;
    auto iload = [&](CIdx& x, int r) { x.s = SEL[r]; x.p0 = POS[2 * r]; x.p1 = POS[2 * r + 1]; x.w0 = WTS[2 * r]; x.w1 = WTS[2 * r + 1]; };
    auto dload = [&](CDat& d, const CIdx& x, int r) {
        const int e0 = x.s & 255, e1 = x.s >> 8;
        const size_t s0 = (size_t)(seg_start(ts, e0) * 256 + x.p0) * DM, s1 = (size_t)(seg_start(ts, e1) * 256 + x.p1) * DM;
        d.fast0 = s0 < TAIL0; d.fast1 = s1 < TAIL0; d.w0 = x.w0; d.w1 = x.w1;
#pragma unroll
        for (int j = 0; j < 4; ++j) { const int c = 4 * lane + 256 * j;
            d.xr[j] = *(const u32x2*)(XW + (size_t)r * DM + c);
            if (d.fast0) d.y0[j] = *(const u32x2*)(YS + s0 + c);
            if (d.fast1) d.y1[j] = *(const u32x2*)(YS + s1 + c);
            d.fs[j] = (f32x4){0.f, 0.f, 0.f, 0.f};
            if (!d.fast0) d.fs[j] += moe_y(YS, PARTM, s0, nsl, c) * x.w0;
            if (!d.fast1) d.fs[j] += moe_y(YS, PARTM, s1, nsl, c) * x.w1; }
    };
    auto process = [&](const CDat& d, int r) {
        const int sm = row_sample(r);
        f32x4 v[4]; float ss = 0.f;
#pragma unroll
        for (int j = 0; j < 4; ++j) { const int c = 4 * lane + 256 * j;
            f32x4 f = d.fs[j];
            if (d.fast0) f += (f32x4){bflo(d.y0[j].x), bfhi(d.y0[j].x), bflo(d.y0[j].y), bfhi(d.y0[j].y)} * d.w0;
            if (d.fast1) f += (f32x4){bflo(d.y1[j].x), bfhi(d.y1[j].x), bflo(d.y1[j].y), bfhi(d.y1[j].y)} * d.w1;
            v[j] = (f32x4){bflo(d.xr[j].x), bfhi(d.xr[j].x), bflo(d.xr[j].y), bfhi(d.xr[j].y)} + *(LAS const f32x4*)(GT + sm * DM + c) * f;
            if (MODE == 0) st_x4(XW + (size_t)r * DM + c, v[j]);
            ss += (v[j][0] * v[j][0] + v[j][1] * v[j][1]) + (v[j][2] * v[j][2] + v[j][3] * v[j][3]); }
        const float rstd = __builtin_amdgcn_rsqf(wave_sum(ss) * (1.f / DM) + NORM_EPS);
        if (MODE == 0) {
#pragma unroll
            for (int j = 0; j < 4; ++j) { const int c = 4 * lane + 256 * j; v[j] = v[j] * rstd * *(LAS const f32x4*)(GS + sm * DM + c) + *(LAS const f32x4*)(SH + sm * DM + c); }
            store_row_bf16(H + (size_t)r * DM, lane, v);
        } else {
#pragma unroll
            for (int j = 0; j < 4; ++j) { const int c = 4 * lane + 256 * j; *(f32x4*)(F.out + (size_t)(r - RC) * DM + c) = v[j] * rstd * *(LAS const f32x4*)(GS + c); }
        }
    };
    CIdx ia, ib; CDat da, db;
    int row = row_lo + gw;
    if (row < RT) iload(ia, row);
    if (row + NGW < RT) iload(ib, row + NGW);
    if (row < RT) dload(da, ia, row);
    for (; row < RT; row += 2 * NGW) {
        if (row + 2 * NGW < RT) iload(ia, row + 2 * NGW);
        if (row + NGW < RT) dload(db, ib, row + NGW);
        process(da, row);
        if (row + NGW >= RT) break;
        if (row + 3 * NGW < RT) iload(ib, row + 3 * NGW);
        if (row + 2 * NGW < RT) dload(da, ia, row + 2 * NGW);
        process(db, row + NGW);
    }
}

constexpr int N_PHASES = 39;
__global__ void __launch_bounds__(NWAVES * 64, 2) fwd_kernel(Args args) {
    extern __shared__ __attribute__((aligned(16))) unsigned char lds_raw[];
    Frame F;
    F.lds = (LAS unsigned char*)lds_raw; F.ws = args.ws; F.in = args.in; F.out = args.out;
    F.tid = threadIdx.x; F.lane = F.tid & 63; F.wave = __builtin_amdgcn_readfirstlane(F.tid >> 6);
    F.G = gridDim.x; { const int bx = blockIdx.x; F.vcu = (F.G % 8 == 0) ? (bx % 8) * (F.G / 8) + bx / 8 : bx; }
    volatile LAS unsigned* MISC = (volatile LAS unsigned*)(F.lds + MISC_OFF);
    for (int u = F.tid; u < (LDS_BYTES - LDSCTL_OFF) / 4; u += NWAVES * 64) ((LAS unsigned*)(F.lds + LDSCTL_OFF))[u] = 0u;
    __syncthreads();
    const int lo = args.ph_lo, hi = args.ph_hi;
    XcdBarrier bar; bar.bar = (unsigned*)(F.ws + WS_CTL) + CW_BAR + args.li * XCD_BAR_WORDS; bar.x = 0; bar.st = nullptr;
    if (hi - lo > 1) bar = xcd_barrier_post(bar.bar, MISC + 8);
#define IN(k) (lo <= (k) && (k) < hi)
#define SEAM(k) do { if (IN(k) && IN((k) + 1)) xcd_barrier(bar); } while (0)
#ifndef PROBE_MASK
#define PROBE_MASK 0ull
#endif
#define REPS(k) for (int rep_ = 0; rep_ < 1 + (int)((PROBE_MASK >> (k)) & 1ull); ++rep_)
#define REPBAR(k) if (rep_ + 1 < 1 + (int)((PROBE_MASK >> (k)) & 1ull)) xcd_barrier(bar);
    const int c_ = (int)blockIdx.x;
    LAS unsigned char* L = F.lds;
    float* MOD = WSP(float, WS_MOD);
    using namespace pg8;

    enum { P_PRO = 0, P_L0N1, P_MBIN, P_MBCONV, P_MBST, P_MBCARRY, P_MBOUT, P_MBOG, P_L0N2, P_FF0IN, P_FF0OUT, P_FIX1,
           P_L1N1, P_RWBIG, P_RWL2, P_WYPREP, P_RWSCAN, P_RWCOMB, P_RWOG, P_L1N2, P_M1GATH, P_M1IN, P_M1OUT, P_M1COMB,
           P_POOL, P_POOLG, P_L2N2, P_FF2IN, P_FF2OUT, P_L3N1, P_QKV, P_QKROPE, P_ATTN, P_ATOG, P_L3N2, P_M3GATH, P_M3IN, P_M3OUT, P_M3COMB };
    bf16_t* PARTC = SCR(bf16_t, S_PARTC); bf16_t* PARTM = SCR(bf16_t, S_PARTM);
    bf16_t* XWp = WSP(bf16_t, WS_XW);
#define PH(k, ...) if (IN(k)) REPS(k) { __VA_ARGS__ REPBAR(k) } SEAM(k);
    PH(P_PRO, p_prologue<0>(F);)
    PH(P_L0N1, p_norm<0>(F, 0, 0, 1, 0); __syncthreads(); p_prologue<1>(F);)
    PH(P_MBIN, SchedStd S{RT / 256, MB_NPAD / 256, F.G, c_, (size_t)256 * DM * 2, (size_t)256 * DM * 2, 0, 1, DM / 64};
        EpiMbIn E{SCR(bf16_t, S_Z), SCR(bf16_t, S_XBCP), SCR(float, S_DT), F.in[I_MBDTB]};
        gemm_phase<EpiMbIn, SchedStd, true>(L, WSP(bf16_t, WS_H), WSP(bf16_t, W_MBIN), DM, DM, S, E);)
    PH(P_MBCONV, p_mb_conv(F);)
    PH(P_MBST, p_mb_states(F);)
    PH(P_MBCARRY, p_mb_carry(F);)
    PH(P_MBOUT, p_mb_out(F);)
    PH(P_MBOG, SchedCtx S{F.G, c_, (size_t)256 * MB_DI * 2, (size_t)256 * MB_DI * 2, MB_DI / 64, (size_t)512};
        EpiRes E{XWp, F.in[I_X], F.in[I_CTX], MOD + 0 * 3 * 6144 + 2 * DM, SCR(float, S_SSQ), nullptr, 0, 1, PARTC};
        gemm_phase<EpiRes, SchedCtx, true>(L, SCR(bf16_t, S_YG), WSP(bf16_t, W_MBOUT), MB_DI, MB_DI, S, E);)
    PH(P_L0N2, p_norm<0>(F, 0, 1, 0, 0, CtxFix{MOD + 0 * 3 * 6144 + 2 * DM, SCR(float, S_SSQC), 1, MB_DI / 256});)
    PH(P_FF0IN, SchedStd S{RT / 256, 2 * FFD / 256, F.G, c_, (size_t)256 * DM * 2, (size_t)256 * DM * 2, 0, 1, DM / 64};
        EpiSwiglu E{SCR(bf16_t, S_HID), FFD, FFD / 64};
        gemm_phase<EpiSwiglu, SchedStd, true>(L, WSP(bf16_t, WS_H), WSP(bf16_t, W_FFIN), DM, DM, S, E);)
    PH(P_FF0OUT, SchedCtx S{F.G, c_, (size_t)256 * FFD * 2, (size_t)256 * FFD * 2, FFD / 64, (size_t)131072};
        EpiRes E{XWp, nullptr, nullptr, MOD + 0 * 3 * 6144 + 5 * DM, nullptr, nullptr, 0, 0, PARTC};
        gemm_phase<EpiRes, SchedCtx, true>(L, SCR(bf16_t, S_HID), WSP(bf16_t, W_FFOUT), 0, FFD, S, E);)
    PH(P_FIX1, p_ctx_fix(F, MOD + 0 * 3 * 6144 + 5 * DM, nullptr, 0, FFD / 256);)
    PH(P_L1N1, p_norm_rw(F, 1);)
    PH(P_RWBIG, SchedRw S{F.G, c_};
        EpiRwBig E{SCR(bf16_t, S_RKV), SCR(bf16_t, S_L1)};
        gemm_phase<EpiRwBig, SchedRw, true>(L, SCR(bf16_t, S_X6), WSP(bf16_t, W_RWBIG), DM, DM, S, E);)
    PH(P_WYPREP, p_rw_l2(F); p_wy_prep(F);)
    PH(P_RWSCAN, p_wy_seq(F);)
    PH(P_RWCOMB, p_rw_combine(F);)
    PH(P_RWOG, SchedCtx S{F.G, c_, (size_t)256 * DM * 2, (size_t)256 * DM * 2, DM / 64, (size_t)512};
        EpiRes E{XWp, nullptr, nullptr, MOD + 1 * 3 * 6144 + 2 * DM, nullptr, nullptr, 0, 0, PARTC};
        gemm_phase<EpiRes, SchedCtx, true>(L, SCR(bf16_t, S_OO), WSP(bf16_t, W_RWOUT), DM, DM, S, E);)
    PH(P_L1N2, p_norm<2>(F, 1, 1, 0, 0, CtxFix{MOD + 1 * 3 * 6144 + 2 * DM, nullptr, 0, DM / 256});)
    PH(P_M1GATH, p_moe_gather(F, 0);)
    PH(P_M1IN, SchedMoe S; moe_starts(F, S.ts); S.nM = S.ts[NEXP - 1]; S.nN = 2 * FFE / 256; S.G = F.G; S.c = c_; S.a_tile = (size_t)256 * DM * 2; S.b_tile = (size_t)256 * DM * 2; S.b_exp = (size_t)2 * FFE * DM * 2; S.nt = DM / 64; S.tail = 0; S.a_kpair = 256;
        EpiSwiglu E{SCR(bf16_t, S_HM), FFE, FFE / 64};
        gemm_phase<EpiSwiglu, SchedMoe, true>(L, SCR(bf16_t, S_AG), WSP(bf16_t, W_MOEIN), DM, DM, S, E);)
    PH(P_M1OUT, SchedMoe S; moe_starts(F, S.ts); S.nM = S.ts[NEXP - 1]; S.nN = DM / 256; S.G = F.G; S.c = c_; S.a_tile = (size_t)256 * FFE * 2; S.b_tile = (size_t)256 * FFE * 2; S.b_exp = (size_t)DM * FFE * 2; S.nt = FFE / 64; S.tail = 1; S.a_kpair = 65536;
        EpiBf16 E{SCR(bf16_t, S_YS), DM, PARTM, 128 * 256, (size_t)PARTM_ROWS * 1024};
        gemm_phase<EpiBf16, SchedMoe, true>(L, SCR(bf16_t, S_HM), WSP(bf16_t, W_MOEOUT), 0, FFE, S, E);)
    PH(P_M1COMB, p_moe_combine<0>(F, 1, 0);)
    PH(P_POOL, p_pool(F, SCR(bf16_t, S_YG));)
    PH(P_POOLG, SchedStd S{RT / 256, DM / 256, F.G, c_, (size_t)256 * DM * 2, (size_t)256 * 256 * 2, 512, 1, 256 / 64};
        EpiRes E{XWp, nullptr, nullptr, MOD + 2 * 3 * 6144 + 2 * DM, nullptr, F.in[I_PLS], 0, 0, nullptr};
        gemm_phase<EpiRes, SchedStd, true>(L, SCR(bf16_t, S_YG), WSP(bf16_t, W_POOL), DM, 256, S, E);)
    PH(P_L2N2, p_norm<0>(F, 2, 1, 0, 0);)
    PH(P_FF2IN, SchedStd S{RT / 256, 2 * FFD / 256, F.G, c_, (size_t)256 * DM * 2, (size_t)256 * DM * 2, 0, 1, DM / 64};
        EpiSwiglu E{SCR(bf16_t, S_HID), FFD, FFD / 64};
        gemm_phase<EpiSwiglu, SchedStd, true>(L, WSP(bf16_t, WS_H), WSP(bf16_t, W_FFIN) + (size_t)2 * FFD * DM, DM, DM, S, E);)
    PH(P_FF2OUT, SchedCtx S{F.G, c_, (size_t)256 * FFD * 2, (size_t)256 * FFD * 2, FFD / 64, (size_t)131072};
        EpiRes E{XWp, nullptr, nullptr, MOD + 2 * 3 * 6144 + 5 * DM, nullptr, nullptr, 0, 0, PARTC};
        gemm_phase<EpiRes, SchedCtx, true>(L, SCR(bf16_t, S_HID), WSP(bf16_t, W_FFOUT) + (size_t)DM * FFD, 0, FFD, S, E);)
    PH(P_L3N1, p_norm<0>(F, 3, 0, 0, 0, CtxFix{MOD + 2 * 3 * 6144 + 5 * DM, nullptr, 0, FFD / 256});)
    PH(P_QKV, SchedStd S{RT / 256, 1536 / 256, F.G, c_, (size_t)256 * DM * 2, (size_t)256 * DM * 2, 0, 1, DM / 64};
        EpiBf16 E{SCR(bf16_t, S_QKV), 1536, nullptr, 0, 0};
        gemm_phase<EpiBf16, SchedStd, true>(L, WSP(bf16_t, WS_H), WSP(bf16_t, W_QKV), DM, DM, S, E);)
    PH(P_QKROPE, p_qkrope(F);)
    PH(P_ATTN,
        const attn_body::bf16* Q = (const attn_body::bf16*)SCR(bf16_t, S_QKV); const attn_body::bf16* K = (const attn_body::bf16*)SCR(bf16_t, S_KB); const attn_body::bf16* V = (const attn_body::bf16*)SCR(bf16_t, S_VB);
        attn_body::bf16* O = (attn_body::bf16*)SCR(bf16_t, S_AO);
        for (int ui = F.vcu; ui < 1024; ui += F.G) { const int bh = ui >> 5, qb = ui & 31; attn_body::attn_unit<8>(bh >> 4, bh & 15, qb, Q, F.in[I_ATQG], WSP(float, WS_ROPE), K, V, O, (char*)lds_raw); })
    PH(P_ATOG, SchedStd S{RL / 256, DM / 256, F.G, c_, (size_t)256 * DM * 2, (size_t)256 * DM * 2, 0, 1, DM / 64};
        EpiRes E{XWp, nullptr, nullptr, MOD + 3 * 3 * 6144 + 2 * DM, nullptr, nullptr, RC, 0, nullptr};
        gemm_phase<EpiRes, SchedStd, true>(L, SCR(bf16_t, S_AO), WSP(bf16_t, W_ATOUT), DM, DM, S, E);)
    PH(P_L3N2, p_norm<2>(F, 3, 1, 0, RC);)
    PH(P_M3GATH, p_moe_gather(F, RC);)
    PH(P_M3IN, SchedMoe S; moe_starts(F, S.ts); S.nM = S.ts[NEXP - 1]; S.nN = 2 * FFE / 256; S.G = F.G; S.c = c_; S.a_tile = (size_t)256 * DM * 2; S.b_tile = (size_t)256 * DM * 2; S.b_exp = (size_t)2 * FFE * DM * 2; S.nt = DM / 64; S.tail = 0; S.a_kpair = 256;
        EpiSwiglu E{SCR(bf16_t, S_HM), FFE, FFE / 64};
        gemm_phase<EpiSwiglu, SchedMoe, true>(L, SCR(bf16_t, S_AG), WSP(bf16_t, W_MOEIN) + (size_t)8 * 2 * FFE * DM, DM, DM, S, E);)
    PH(P_M3OUT, SchedMoe S; moe_starts(F, S.ts); S.nM = S.ts[NEXP - 1]; S.nN = DM / 256; S.G = F.G; S.c = c_; S.a_tile = (size_t)256 * FFE * 2; S.b_tile = (size_t)256 * FFE * 2; S.b_exp = (size_t)DM * FFE * 2; S.nt = FFE / 64; S.tail = 1; S.a_kpair = 65536;
        EpiBf16 E{SCR(bf16_t, S_YS), DM, PARTM, 128 * 256, (size_t)PARTM_ROWS * 1024};
        gemm_phase<EpiBf16, SchedMoe, true>(L, SCR(bf16_t, S_HM), WSP(bf16_t, W_MOEOUT) + (size_t)8 * DM * FFE, 0, FFE, S, E);)
    if (IN(P_M3COMB)) { p_moe_combine<1>(F, 3, RC); }
#undef PH
#undef IN
#undef SEAM
}

#ifndef MK_CUTS
#define MK_CUTS 0
#endif
extern "C" void kernel_launch(void* const* d_in, const int* in_sizes, int n_in, void* d_out, int out_size, void* d_ws, size_t ws_size, hipStream_t stream) {
    static int grid = 0;
    if (grid == 0) {
        if (n_in != 44 || out_size != RL * DM || ws_size < WS_END) { fprintf(stderr, "kernel_launch: unexpected sizes (n_in %d out %d ws %zu)\n", n_in, out_size, ws_size); grid = -1; return; }
        int dev = 0, cus = 0, per_cu = 0;
        if (hipGetDevice(&dev) != hipSuccess || hipDeviceGetAttribute(&cus, hipDeviceAttributeMultiprocessorCount, dev) != hipSuccess) { grid = -1; return; }
        if (hipFuncSetAttribute((const void*)fwd_kernel, hipFuncAttributeMaxDynamicSharedMemorySize, LDS_BYTES) != hipSuccess) { fprintf(stderr, "kernel_launch: hipFuncSetAttribute failed\n"); grid = -1; return; }
        if (hipOccupancyMaxActiveBlocksPerMultiprocessor(&per_cu, (const void*)fwd_kernel, NWAVES * 64, LDS_BYTES) != hipSuccess || per_cu < 1)
            fprintf(stderr, "kernel_launch: occupancy query reports %d\n", per_cu);
        (void)hipGetLastError();
        grid = cus;
    }
    if (grid < 0) return;
    (void)hipMemsetAsync((char*)d_ws + WS_CTL + (size_t)CW_BAR * 4, 0, (size_t)XCD_BAR_WORDS * 4, stream);
    Args a{};
    for (int i = 0; i < 44; ++i) a.in[i] = (const float*)d_in[i];
    a.out = (float*)d_out; a.ws = (unsigned char*)d_ws; a.pad = 0;
#if MK_CUTS == 0
    a.ph_lo = 0; a.ph_hi = N_PHASES; a.li = 0;
    hipLaunchKernelGGL(fwd_kernel, dim3(grid), dim3(NWAVES * 64), LDS_BYTES, stream, a);
#else
    for (int p = 0; p < N_PHASES; ++p) { a.ph_lo = p; a.ph_hi = p + 1; a.li = 0; hipLaunchKernelGGL(fwd_kernel, dim3(grid), dim3(NWAVES * 64), LDS_BYTES, stream, a); }
#endif
}
```
